# Optimizing an MI355X kernel written in HIP

```python
import math
import jax, jax.numpy as jnp
from jax import lax
import numpy as np

D_MODEL = 2048
BATCH = 2
SEQ = 4096
DEPTH = 2

MEM_LEN = 256
N_HEADS = 12
MIX_WIDTH = 3 * D_MODEL // 4
HEAD_DIM = MIX_WIDTH // N_HEADS
DIFF_QK_DIM = HEAD_DIM // 2
N_KV_HEADS = 4
GQA_GROUP = N_HEADS // N_KV_HEADS
KV_WIDTH = N_KV_HEADS * HEAD_DIM
WINDOW = 128
BLOCK = 128
N_MEM_HEADS = 4
MEM_WIDTH = D_MODEL - MIX_WIDTH
MEM_HEAD_DIM = MEM_WIDTH // N_MEM_HEADS
D_FF = 4 * D_MODEL
N_BUCKETS = 32
MAX_DISTANCE = 128
RMS_EPS = 1e-6
NEG_INF = -1e30
N_LAYERS_A = (DEPTH + 1) // 2
N_LAYERS_B = DEPTH // 2
IN_A = 3 * MIX_WIDTH + MEM_WIDTH
IN_B = MIX_WIDTH + 2 * KV_WIDTH + MEM_WIDTH

kernel_name = "hybrid_diffattn_swa_sink_memxattn_encoder"


def rms_norm(x, gain):
    x32 = x.astype(jnp.float32)
    y = x32 * lax.rsqrt(jnp.mean(x32 * x32, axis=-1, keepdims=True) + RMS_EPS)
    return (y * gain.astype(jnp.float32)).astype(x.dtype)


def t5_bucket(rel):
    half = N_BUCKETS // 2
    max_exact = half // 2
    side = jnp.where(rel > 0, half, 0)
    n = jnp.abs(rel)
    n_f = jnp.maximum(n, 1).astype(jnp.float32)
    large = max_exact + (jnp.log(n_f / max_exact) / math.log(MAX_DISTANCE / max_exact)
                         * (half - max_exact)).astype(jnp.int32)
    large = jnp.minimum(large, half - 1)
    return side + jnp.where(n < max_exact, n, large)


def rel_bias_lookup(rel_bias, rel):
    return jnp.take(rel_bias, t5_bucket(rel), axis=0)


def diff_attention(q, k, v, positions, rel_bias, lam, scale):
    B, S = v.shape[:2]
    nb = S // BLOCK
    q_blocks = q.reshape(B, nb, BLOCK, N_HEADS, 2, DIFF_QK_DIM).transpose(1, 0, 2, 3, 4, 5)
    pos_blocks = positions.reshape(B, nb, BLOCK).transpose(1, 0, 2)

    def one_block(args):
        qb, pb = args
        s = jnp.einsum('bqhcd,bkhcd->bhcqk', qb, k).astype(jnp.float32) * scale
        bias = rel_bias_lookup(rel_bias, positions[:, None, :] - pb[:, :, None])
        s = s + jnp.transpose(bias, (0, 3, 1, 2))[:, :, None].astype(jnp.float32)
        p = jax.nn.softmax(s, axis=-1)
        a = p[:, :, 0] - lam * p[:, :, 1]
        return jnp.einsum('bhqk,bkhe->bqhe', a.astype(v.dtype), v)

    out = lax.map(one_block, (q_blocks, pos_blocks))
    return out.transpose(1, 0, 2, 3, 4).reshape(B, S, N_HEADS, HEAD_DIM)


def windowed_gqa_sink(q, k, v, positions, rel_bias, sink, scale):
    B, S = q.shape[:2]
    nb = S // BLOCK

    def neighbourhood(t):
        pad = [(0, 0), (BLOCK, BLOCK)] + [(0, 0)] * (t.ndim - 2)
        tp = jnp.pad(t, pad).reshape((B, nb + 2, BLOCK) + t.shape[2:])
        return jnp.concatenate([tp[:, :-2], tp[:, 1:-1], tp[:, 2:]], axis=2)

    kn, vn, pn = neighbourhood(k), neighbourhood(v), neighbourhood(positions)
    qb = q.reshape(B, nb, BLOCK, N_KV_HEADS, GQA_GROUP, HEAD_DIM)
    s = jnp.einsum('bnqkgd,bnckd->bnkgqc', qb, kn).astype(jnp.float32) * scale
    pq = positions.reshape(B, nb, BLOCK)
    bias = rel_bias_lookup(rel_bias, pn[:, :, None, :] - pq[:, :, :, None])
    bias = bias.reshape(B, nb, BLOCK, 3 * BLOCK, N_KV_HEADS, GQA_GROUP).transpose(0, 1, 4, 5, 2, 3)
    qi = jnp.arange(S).reshape(nb, BLOCK)
    ki = (jnp.arange(nb)[:, None] - 1) * BLOCK + jnp.arange(3 * BLOCK)[None, :]
    valid = ((jnp.abs(ki[:, None, :] - qi[:, :, None]) <= WINDOW)
             & (ki[:, None, :] >= 0) & (ki[:, None, :] < S))
    s = jnp.where(valid[None, :, None, None], s + bias.astype(jnp.float32), NEG_INF)
    sink_col = jnp.broadcast_to(
        sink.astype(jnp.float32).reshape(1, 1, N_KV_HEADS, GQA_GROUP, 1, 1), s.shape[:-1] + (1,))
    p = jax.nn.softmax(jnp.concatenate([s, sink_col], axis=-1), axis=-1)[..., :-1]
    out = jnp.einsum('bnkgqc,bnckd->bnqkgd', p.astype(v.dtype), vn)
    return out.reshape(B, S, N_HEADS, HEAD_DIM)


def memory_attention(q_m, k_m, v_m, scale):
    s = jnp.einsum('bshd,bmhd->bhsm', q_m, k_m).astype(jnp.float32) * scale
    p = jax.nn.softmax(s, axis=-1)
    return jnp.einsum('bhsm,bmhd->bshd', p.astype(v_m.dtype), v_m)


def setup_inputs(seed: int = 0) -> dict:
    key = jax.random.key(seed)
    ks = jax.random.split(key, 26)
    f32 = jnp.float32

    def w(k, shape, fan_in):
        return jax.random.normal(k, shape, f32) * fan_in ** -0.5

    def gain(k, shape):
        return 1.0 + 0.05 * jax.random.normal(k, shape, f32)

    x = jax.random.normal(ks[0], (BATCH, SEQ, D_MODEL), f32)
    mem = jax.random.normal(ks[1], (BATCH, MEM_LEN, D_MODEL), f32)
    offset = jax.random.randint(ks[2], (BATCH, 1), 0, 1024, dtype=jnp.int32)
    positions = offset + jnp.arange(SEQ, dtype=jnp.int32)[None, :]
    return {
        "x": x,
        "mem": mem,
        "positions": positions,
        "rel_bias": 0.5 * jax.random.normal(ks[3], (N_BUCKETS, N_HEADS), f32),
        "norm_attn": gain(ks[4], (DEPTH, D_MODEL)),
        "norm_mem": gain(ks[5], (DEPTH, D_MODEL)),
        "norm_mlp": gain(ks[6], (DEPTH, D_MODEL)),
        "w_in_a": w(ks[7], (N_LAYERS_A, D_MODEL, IN_A), D_MODEL),
        "a_q_norm": gain(ks[8], (N_LAYERS_A, DIFF_QK_DIM)),
        "a_k_norm": gain(ks[9], (N_LAYERS_A, DIFF_QK_DIM)),
        "a_lambda_q1": 0.1 * jax.random.normal(ks[10], (N_LAYERS_A, DIFF_QK_DIM), f32),
        "a_lambda_k1": 0.1 * jax.random.normal(ks[11], (N_LAYERS_A, DIFF_QK_DIM), f32),
        "a_lambda_q2": 0.1 * jax.random.normal(ks[12], (N_LAYERS_A, DIFF_QK_DIM), f32),
        "a_lambda_k2": 0.1 * jax.random.normal(ks[13], (N_LAYERS_A, DIFF_QK_DIM), f32),
        "a_subln": gain(ks[14], (N_LAYERS_A, HEAD_DIM)),
        "w_in_b": w(ks[15], (N_LAYERS_B, D_MODEL, IN_B), D_MODEL),
        "b_q_norm": gain(ks[16], (N_LAYERS_B, HEAD_DIM)),
        "b_k_norm": gain(ks[17], (N_LAYERS_B, HEAD_DIM)),
        "b_sink": 0.5 * jax.random.normal(ks[18], (N_LAYERS_B, N_HEADS), f32),
        "w_mem_kv": w(ks[19], (DEPTH, D_MODEL, 2 * MEM_WIDTH), D_MODEL),
        "m_q_norm": gain(ks[20], (DEPTH, MEM_HEAD_DIM)),
        "m_k_norm": gain(ks[21], (DEPTH, MEM_HEAD_DIM)),
        "w_out": w(ks[22], (DEPTH, MIX_WIDTH + MEM_WIDTH, D_MODEL), MIX_WIDTH + MEM_WIDTH),
        "w_up": w(ks[23], (DEPTH, D_MODEL, D_FF), D_MODEL),
        "w_down": w(ks[24], (DEPTH, D_FF, D_MODEL), D_FF),
    }


def reference(x, mem, positions, rel_bias, norm_attn, norm_mem, norm_mlp, w_in_a, a_q_norm, a_k_norm,
              a_lambda_q1, a_lambda_k1, a_lambda_q2, a_lambda_k2, a_subln, w_in_b, b_q_norm, b_k_norm,
              b_sink, w_mem_kv, m_q_norm, m_k_norm, w_out, w_up, w_down):
    B, S, _ = x.shape
    for i in range(DEPTH):
        h = rms_norm(x, norm_attn[i])
        mn = rms_norm(mem, norm_mem[i])
        mkv = (mn @ w_mem_kv[i]).reshape(B, MEM_LEN, 2, N_MEM_HEADS, MEM_HEAD_DIM)
        k_m = rms_norm(mkv[:, :, 0], m_k_norm[i])
        v_m = mkv[:, :, 1]
        if i % 2 == 0:
            j = i // 2
            proj = h @ w_in_a[j]
            q, k, v, q_m = jnp.split(proj, [MIX_WIDTH, 2 * MIX_WIDTH, 3 * MIX_WIDTH], axis=-1)
            q = rms_norm(q.reshape(B, S, N_HEADS, 2, DIFF_QK_DIM), a_q_norm[j])
            k = rms_norm(k.reshape(B, S, N_HEADS, 2, DIFF_QK_DIM), a_k_norm[j])
            v = v.reshape(B, S, N_HEADS, HEAD_DIM)
            lam_init = 0.8 - 0.6 * math.exp(-0.3 * i)
            lam = (jnp.exp(jnp.sum(a_lambda_q1[j].astype(jnp.float32) * a_lambda_k1[j].astype(jnp.float32)))
                   - jnp.exp(jnp.sum(a_lambda_q2[j].astype(jnp.float32) * a_lambda_k2[j].astype(jnp.float32)))
                   + lam_init)
            o = diff_attention(q, k, v, positions, rel_bias, lam, DIFF_QK_DIM ** -0.5)
            o = rms_norm(o, a_subln[j]) * (1.0 - lam_init)
        else:
            j = i // 2
            proj = h @ w_in_b[j]
            q, k, v, q_m = jnp.split(proj, [MIX_WIDTH, MIX_WIDTH + KV_WIDTH, MIX_WIDTH + 2 * KV_WIDTH], axis=-1)
            q = rms_norm(q.reshape(B, S, N_HEADS, HEAD_DIM), b_q_norm[j])
            k = rms_norm(k.reshape(B, S, N_KV_HEADS, HEAD_DIM), b_k_norm[j])
            v = v.reshape(B, S, N_KV_HEADS, HEAD_DIM)
            o = windowed_gqa_sink(q, k, v, positions, rel_bias, b_sink[j], HEAD_DIM ** -0.5)
        q_m = rms_norm(q_m.reshape(B, S, N_MEM_HEADS, MEM_HEAD_DIM), m_q_norm[i])
        o_m = memory_attention(q_m, k_m, v_m, MEM_HEAD_DIM ** -0.5)
        heads = jnp.concatenate([o.reshape(B, S, MIX_WIDTH), o_m.reshape(B, S, MEM_WIDTH)], axis=-1)
        x = x + heads @ w_out[i]
        h = rms_norm(x, norm_mlp[i])
        x = x + jnp.square(jax.nn.relu(h @ w_up[i])) @ w_down[i]
    return x
```

```cpp
#include <hip/hip_runtime.h>
#include <cstdio>
#include <cstdint>
namespace pg8 {
#define PG8_LAS __attribute__((address_space(3)))
typedef unsigned short bf16_t;
typedef short bf16x8 __attribute__((ext_vector_type(8)));
typedef float f32x4 __attribute__((ext_vector_type(4)));
typedef unsigned u32x4 __attribute__((ext_vector_type(4)));
constexpr int BM = 256, BK = 64, HALF = 128, HTB = HALF * BK * 2  , STAGE_BYTES = 8 * HTB, NXCD = 8, WGM = 8;

__host__ __device__ __forceinline__ int lds_byte(int r, int c) { const int st = (r >> 4) * 2 + (c >> 5), rr = r & 15, cc = c & 31, ob = rr * 64 + cc * 2; return st * 1024 + (ob ^ (((ob >> 9) & 1) << 5)); }
__host__ __device__ __forceinline__ void stage_rc(int b, int& R, int& C) { const int st = b / 1024, sb = b % 1024, swz = sb ^ (((sb >> 9) & 1) << 5); R = (st >> 1) * 16 + swz / 64; C = (st & 1) * 32 + (swz % 64) / 2; }
__host__ __device__ __forceinline__ int perm32(int rho) { const int n = rho >> 4, i = rho & 15; return 8 * (i >> 2) + 4 * n + (i & 3); }

struct Unit { int pm, pn; };
struct Gemm { const bf16_t* A; const bf16_t* Bt; int M, N, K; };

struct StaticOrder {
    int nM, nN, nwg, G, c;
    __host__ __device__ void init(int M, int N, int G_, int c_) { nM = M / BM; nN = N / BM; nwg = nM * nN; G = G_; c = c_; }
    __host__ __device__ bool next(int i, Unit& u) const {
        const long L = (long)i * G + c; if (L >= nwg) return false;
        int wgid = (int)L; { const int q = nwg / NXCD, r = nwg % NXCD, xcd = wgid % NXCD, off = wgid / NXCD; wgid = (xcd < r ? xcd * (q + 1) : r * (q + 1) + (xcd - r) * q) + off; }
        const int nig = WGM * nN, gid = wgid / nig, fm = gid * WGM, gsz = (nM - fm) < WGM ? (nM - fm) : WGM;
        u.pm = fm + ((wgid % nig) % gsz); u.pn = (wgid % nig) / gsz; return true;
    }
    __device__ __forceinline__ void a_ready(const Unit&) const {}
    __device__ __forceinline__ void done(const Unit&) const {}
};


__device__ __forceinline__ unsigned cvt_pk_bf16(float lo, float hi) { unsigned r; asm volatile("v_cvt_pk_bf16_f32 %0, %1, %2" : "=v"(r) : "v"(lo), "v"(hi)); return r; }

template <int ACT  > struct EpiBf16 {
    static constexpr bool PERM = true, AFTER_DRAIN = false;
    bf16_t* O; int ldc;
    __device__ __forceinline__ void operator()(const f32x4 (&acc)[2][2][4][2], const Unit& u, int wr, int wc, int fr, int fq) const {
        const int row0 = u.pm * BM + wr * 64 + fr; const int col0 = u.pn * BM + wc * 32 + 8 * fq;
#pragma unroll
        for (int ai = 0; ai < 2; ++ai)
#pragma unroll
            for (int m = 0; m < 4; ++m) { bf16_t* rowp = O + (size_t)(row0 + ai * HALF + m * 16) * ldc + col0;
#pragma unroll
                for (int bj = 0; bj < 2; ++bj) { f32x4 v0 = acc[ai][bj][m][0], v1 = acc[ai][bj][m][1];
                    if (ACT == 1) {
#pragma unroll
                        for (int j = 0; j < 4; ++j) { const float a = fmaxf(v0[j], 0.f), b = fmaxf(v1[j], 0.f); v0[j] = a * a; v1[j] = b * b; } }
                    u32x4 w; w.x = cvt_pk_bf16(v0[0], v0[1]); w.y = cvt_pk_bf16(v0[2], v0[3]); w.z = cvt_pk_bf16(v1[0], v1[1]); w.w = cvt_pk_bf16(v1[2], v1[3]);
                    *(u32x4*)(rowp + bj * HALF) = w; } }
    }
};
struct EpiF32 {
    static constexpr bool PERM = false, AFTER_DRAIN = false;
    float* C; int ldc;
    __device__ __forceinline__ void operator()(const f32x4 (&acc)[2][2][4][2], const Unit& u, int wr, int wc, int fr, int fq) const {
        const int row0 = u.pm * BM + wr * 64 + fr, col0 = u.pn * BM + wc * 32 + 4 * fq;
#pragma unroll
        for (int ai = 0; ai < 2; ++ai)
#pragma unroll
            for (int m = 0; m < 4; ++m) { float* rowp = C + (size_t)(row0 + ai * HALF + m * 16) * ldc + col0;
#pragma unroll
                for (int bj = 0; bj < 2; ++bj)
#pragma unroll
                    for (int n = 0; n < 2; ++n) *(f32x4*)(rowp + bj * HALF + n * 16) = acc[ai][bj][m][n]; }
    }
};
struct EpiResF32 {
    static constexpr bool PERM = false, AFTER_DRAIN = false;
    const float* base; float* out; int ldc;
    __device__ __forceinline__ void operator()(const f32x4 (&acc)[2][2][4][2], const Unit& u, int wr, int wc, int fr, int fq) const {
        const int row0 = u.pm * BM + wr * 64 + fr, col0 = u.pn * BM + wc * 32 + 4 * fq;
#pragma unroll
        for (int ai = 0; ai < 2; ++ai)
#pragma unroll
            for (int m = 0; m < 4; ++m) { const size_t off = (size_t)(row0 + ai * HALF + m * 16) * ldc + col0;
#pragma unroll
                for (int bj = 0; bj < 2; ++bj)
#pragma unroll
                    for (int n = 0; n < 2; ++n) { const f32x4 b = *(const f32x4*)(base + off + bj * HALF + n * 16); *(f32x4*)(out + off + bj * HALF + n * 16) = b + acc[ai][bj][m][n]; } }
    }
};

template <class Epi, class Sched, bool ALIGN_EPI = false, bool SP2 = false>
__device__ __forceinline__ void gemm_phase(PG8_LAS unsigned char* lds, const Gemm g, const Sched& S, const Epi& E) {
    const int tid = threadIdx.x, wid = __builtin_amdgcn_readfirstlane(tid >> 6), lane = tid & 63, wr = wid >> 2, wc = wid & 3, fr = lane & 15, fq = lane >> 4;
    const int K = g.K, nt = K / BK;
    unsigned voffA[2], voffB[2];
#pragma unroll
    for (int i = 0; i < 2; ++i) { int R, C; stage_rc(tid * 16 + i * 8192, R, C); const int Rb = Epi::PERM ? ((R & ~31) + perm32(R & 31)) : R;
        voffA[i] = (unsigned)(R * K + C) * 2u; voffB[i] = (unsigned)(Rb * K + C) * 2u; }
    const size_t kstep = (size_t)(BK * 2);
    const size_t hstep = (size_t)HALF * K * 2;
    const size_t tstep = 2 * hstep;
    const unsigned ldsw = (unsigned)wid * 1024u;
    const int aoff = lds_byte(wr * 64 + fr, fq * 8), boff = lds_byte(wc * 32 + fr, fq * 8);
#define PG8_SA(b, h) (((b) * 2 + (h)) * HTB)
#define PG8_SB(b, h) ((4 + (b) * 2 + (h)) * HTB)
#define PG8_STAGE(bufoff, gbase, voff) do { _Pragma("unroll") for (int _i = 0; _i < 2; ++_i) \
        __builtin_amdgcn_global_load_lds((const unsigned*)((const char*)(gbase) + (voff)[_i]), (PG8_LAS unsigned*)(lds + (bufoff) + ldsw + _i * 8192), 16, 0, 0); } while (0)
#define PG8_LDA(dst, b, h) do { _Pragma("unroll") for (int m = 0; m < 4; ++m) _Pragma("unroll") for (int k = 0; k < 2; ++k) dst[m][k] = *(const PG8_LAS bf16x8*)(lds + PG8_SA(b, h) + aoff + m * 2048 + k * 1024); } while (0)
#define PG8_LDB(dst, b, h) do { _Pragma("unroll") for (int n = 0; n < 2; ++n) _Pragma("unroll") for (int k = 0; k < 2; ++k) dst[n][k] = *(const PG8_LAS bf16x8*)(lds + PG8_SB(b, h) + boff + n * 2048 + k * 1024); } while (0)
#define PG8_MMA(ai, bj, At, Bt) do { __builtin_amdgcn_s_setprio(1); _Pragma("unroll") for (int m = 0; m < 4; ++m) _Pragma("unroll") for (int n = 0; n < 2; ++n) _Pragma("unroll") for (int k = 0; k < 2; ++k) \
        acc[ai][bj][m][n] = __builtin_amdgcn_mfma_f32_16x16x32_bf16(Bt[n][k], At[m][k], acc[ai][bj][m][n], 0, 0, 0); __builtin_amdgcn_s_setprio(0); } while (0)
#define PG8_WAIT_V(n) asm volatile("s_waitcnt vmcnt(" #n ")" ::: "memory")
#define PG8_WAIT_L(n) asm volatile("s_waitcnt lgkmcnt(" #n ")" ::: "memory")
#define PG8_BAR __builtin_amdgcn_s_barrier()
#define PG8_SCHED __builtin_amdgcn_sched_barrier(0)
    Unit cur, nxt; int ui = 0;
    if (!S.next(0, cur)) return;
    f32x4 acc[2][2][4][2];
#pragma unroll
    for (int a = 0; a < 2; ++a)
#pragma unroll
        for (int b = 0; b < 2; ++b)
#pragma unroll
            for (int m = 0; m < 4; ++m)
#pragma unroll
                for (int n = 0; n < 2; ++n) acc[a][b][m][n] = (f32x4){0.f, 0.f, 0.f, 0.f};
    bf16x8 At[4][2], B0[2][2], B1[2][2];
    const char* cA = (const char*)g.A + (size_t)cur.pm * tstep; const char* cB = (const char*)g.Bt + (size_t)cur.pn * tstep;
    S.a_ready(cur);
    if constexpr (SP2) {
        PG8_STAGE(PG8_SB(0, 0), cB, voffB); PG8_STAGE(PG8_SB(0, 1), cB + hstep, voffB); PG8_STAGE(PG8_SA(0, 0), cA, voffA); PG8_STAGE(PG8_SA(0, 1), cA + hstep, voffA);
        if (wr == 1) PG8_BAR;
        PG8_WAIT_V(2); PG8_BAR;
        PG8_STAGE(PG8_SB(1, 0), cB + kstep, voffB); PG8_STAGE(PG8_SA(1, 0), cA + kstep, voffA); PG8_STAGE(PG8_SB(1, 1), cB + hstep + kstep, voffB);
        PG8_WAIT_V(6); PG8_BAR;
    } else {
        PG8_STAGE(PG8_SB(0, 0), cB, voffB); PG8_STAGE(PG8_SA(0, 0), cA, voffA); PG8_STAGE(PG8_SB(0, 1), cB + hstep, voffB); PG8_STAGE(PG8_SA(0, 1), cA + hstep, voffA);
        if (wr == 1) PG8_BAR;
        PG8_WAIT_V(4); PG8_BAR;
        PG8_STAGE(PG8_SB(1, 0), cB + kstep, voffB); PG8_STAGE(PG8_SA(1, 0), cA + kstep, voffA); PG8_STAGE(PG8_SB(1, 1), cB + hstep + kstep, voffB);
        PG8_WAIT_V(6); PG8_BAR;
    }
    for (;;) {
        const bool has_next = S.next(ui + 1, nxt);
        const char* nA = has_next ? (const char*)g.A + (size_t)nxt.pm * tstep : cA; const char* nB = has_next ? (const char*)g.Bt + (size_t)nxt.pn * tstep : cB;
        for (int t = 0; t < nt; t += 2) {
            const bool last = (t == nt - 2);
            const char* a1 = cA + (size_t)(t + 1) * kstep;
            const char* a2 = last ? nA : cA + (size_t)(t + 2) * kstep; const char* b2 = last ? nB : cB + (size_t)(t + 2) * kstep;
            const char* a3 = a2 + kstep; const char* b3 = b2 + kstep;
            if (last && has_next) S.a_ready(nxt);
            if constexpr (SP2) {
            PG8_LDB(B0, 0, 0); PG8_LDB(B1, 0, 1); PG8_SCHED; PG8_LDA(At, 0, 0); PG8_STAGE(PG8_SA(1, 1), a1 + hstep, voffA);
            PG8_WAIT_V(8); PG8_WAIT_L(0); PG8_BAR; PG8_MMA(0, 0, At, B0); PG8_MMA(0, 1, At, B1); PG8_BAR; PG8_SCHED;
            PG8_LDA(At, 0, 1); PG8_STAGE(PG8_SB(0, 0), b2, voffB); PG8_STAGE(PG8_SB(0, 1), b2 + hstep, voffB); PG8_STAGE(PG8_SA(0, 0), a2, voffA);
            PG8_WAIT_V(8); PG8_WAIT_L(0); PG8_BAR; PG8_MMA(1, 0, At, B0); PG8_MMA(1, 1, At, B1); PG8_BAR; PG8_SCHED;
            PG8_LDB(B0, 1, 0); PG8_LDB(B1, 1, 1); PG8_SCHED; PG8_LDA(At, 1, 0); PG8_STAGE(PG8_SA(0, 1), a2 + hstep, voffA);
            PG8_WAIT_V(8); PG8_WAIT_L(0); PG8_BAR; PG8_MMA(0, 0, At, B0); PG8_MMA(0, 1, At, B1); PG8_BAR; PG8_SCHED;
            PG8_LDA(At, 1, 1); PG8_STAGE(PG8_SB(1, 0), b3, voffB); PG8_STAGE(PG8_SB(1, 1), b3 + hstep, voffB); PG8_STAGE(PG8_SA(1, 0), a3, voffA);
            PG8_WAIT_V(8); PG8_WAIT_L(0); PG8_BAR; PG8_MMA(1, 0, At, B0); PG8_MMA(1, 1, At, B1); PG8_BAR; PG8_SCHED;
            } else {
            PG8_LDB(B0, 0, 0); PG8_SCHED; PG8_LDA(At, 0, 0); PG8_STAGE(PG8_SA(1, 1), a1 + hstep, voffA);
            PG8_WAIT_L(8); PG8_BAR; PG8_WAIT_L(0); PG8_MMA(0, 0, At, B0); PG8_BAR; PG8_SCHED;
            PG8_LDB(B1, 0, 1); PG8_STAGE(PG8_SB(0, 0), b2, voffB);
            PG8_BAR; PG8_WAIT_L(0); PG8_MMA(0, 1, At, B1); PG8_BAR;
            PG8_LDA(At, 0, 1); PG8_STAGE(PG8_SA(0, 0), a2, voffA);
            PG8_BAR; PG8_WAIT_L(0); PG8_MMA(1, 0, At, B0); PG8_BAR; PG8_SCHED;
            PG8_STAGE(PG8_SB(0, 1), b2 + hstep, voffB);
            PG8_WAIT_V(6); PG8_BAR; PG8_MMA(1, 1, At, B1); PG8_BAR;
            PG8_LDB(B0, 1, 0); PG8_SCHED; PG8_LDA(At, 1, 0); PG8_STAGE(PG8_SA(0, 1), a2 + hstep, voffA);
            PG8_WAIT_L(8); PG8_BAR; PG8_WAIT_L(0); PG8_MMA(0, 0, At, B0); PG8_BAR; PG8_SCHED;
            PG8_LDB(B1, 1, 1); PG8_STAGE(PG8_SB(1, 0), b3, voffB);
            PG8_BAR; PG8_WAIT_L(0); PG8_MMA(0, 1, At, B1); PG8_BAR;
            PG8_LDA(At, 1, 1); PG8_STAGE(PG8_SA(1, 0), a3, voffA);
            PG8_BAR; PG8_WAIT_L(0); PG8_MMA(1, 0, At, B0); PG8_BAR; PG8_SCHED;
            PG8_STAGE(PG8_SB(1, 1), b3 + hstep, voffB);
            PG8_WAIT_V(6); PG8_BAR; PG8_MMA(1, 1, At, B1); PG8_BAR;
            }
        }
        if constexpr (ALIGN_EPI) { if (wr == 0) PG8_BAR; }
        if constexpr (!Epi::AFTER_DRAIN) { E(acc, cur, wr, wc, fr, fq); S.done(cur); }
        if (!has_next) break;
#pragma unroll
        for (int a = 0; a < 2; ++a)
#pragma unroll
            for (int b = 0; b < 2; ++b)
#pragma unroll
                for (int m = 0; m < 4; ++m)
#pragma unroll
                    for (int n = 0; n < 2; ++n) acc[a][b][m][n] = (f32x4){0.f, 0.f, 0.f, 0.f};
        cur = nxt; cA = nA; cB = nB; ++ui;
        if constexpr (ALIGN_EPI) { if (wr == 1) PG8_BAR; }
    }
    PG8_WAIT_V(0);
    if constexpr (!ALIGN_EPI) { if (wr == 0) PG8_BAR; }
    PG8_BAR;
    if constexpr (Epi::AFTER_DRAIN) { E.fused(acc, cur, wr, wc, fr, fq, lds, wid, lane); S.done(cur); }
#undef PG8_SA
#undef PG8_SB
#undef PG8_STAGE
#undef PG8_LDA
#undef PG8_LDB
#undef PG8_MMA
#undef PG8_WAIT_V
#undef PG8_WAIT_L
#undef PG8_BAR
#undef PG8_SCHED
}
}
#define GAS __attribute__((address_space(1)))
#define LAS __attribute__((address_space(3)))
typedef unsigned short bf16;
typedef unsigned v4u __attribute__((ext_vector_type(4)));
typedef float f32x4 __attribute__((ext_vector_type(4)));
typedef short bf16x8 __attribute__((ext_vector_type(8)));
typedef GAS unsigned gu32;
typedef GAS unsigned long long gu64;
#define RLX_AGENT __ATOMIC_RELAXED, __HIP_MEMORY_SCOPE_AGENT
#define LDS_WAIT() asm volatile("s_waitcnt lgkmcnt(0)" ::: "memory")
#define VM_WAIT() asm volatile("s_waitcnt vmcnt(0)" ::: "memory")
__device__ __forceinline__ unsigned long long rt() { return __builtin_amdgcn_s_memrealtime(); }
__device__ __forceinline__ unsigned f2bf(float f) { unsigned u = __builtin_bit_cast(unsigned, f); return (u + 0x7fffu + ((u >> 16) & 1u)) >> 16; }
__device__ __forceinline__ unsigned pk2(float lo, float hi) { return f2bf(lo) | (f2bf(hi) << 16); }

#define XB_TMO      128
#define XB_XCNT(j)  (256  + 64 * (j))
#define XB_XSUB(j)  (1280 + 64 * (j))
#define XB_XGEN(j)  (2304 + 64 * (j))
#define XB_TOP      3328
#define XB_TOPGEN   3392
#define XCD_BAR_WORDS 3456
#define XB_SPIN_CAP (1u << 18)

__device__ __forceinline__ unsigned xb_ld(unsigned* p)              { return __hip_atomic_load(p, __ATOMIC_RELAXED, __HIP_MEMORY_SCOPE_AGENT); }
__device__ __forceinline__ unsigned xb_add(unsigned* p, unsigned v) { return __hip_atomic_fetch_add(p, v, __ATOMIC_RELAXED, __HIP_MEMORY_SCOPE_AGENT); }
__device__ __forceinline__ unsigned xb_xcc_id() { return (unsigned)__builtin_amdgcn_s_getreg((3 << 11) | 20) & 0xFu; }
#define XB_SPIN(cond, bar) do { unsigned _sp = 0; while (cond) { __builtin_amdgcn_s_sleep(1); \
    if ((++_sp & 255u) == 0u) { if (xb_ld(&(bar)[XB_TMO])) break; if (_sp > XB_SPIN_CAP) { atomicAdd(&(bar)[XB_TMO], 1u); break; } } } } while (0)

struct XcdBarrier {
    unsigned* bar; unsigned x;
    volatile LAS unsigned* st;
};

__device__ __forceinline__ XcdBarrier xcd_barrier_post(unsigned* bar, volatile LAS unsigned* st) {
    XcdBarrier b; b.bar = bar; b.x = xb_xcc_id(); b.st = st;
    if (threadIdx.x == 0) (void)xb_add(&bar[XB_XCNT(b.x)], 1u);
    return b;
}
__device__ __forceinline__ void xcd_barrier_complete(unsigned* bar, unsigned x, unsigned& nloc, unsigned& nx) {
    const unsigned G = gridDim.x * gridDim.y * gridDim.z;
    unsigned sum, cnt, mine, sp = 0u;
    for (;;) {
        sum = 0u; cnt = 0u; mine = 0u;
#pragma unroll
        for (unsigned j = 0; j < 16; ++j) { const unsigned c = xb_ld(&bar[XB_XCNT(j)]); sum += c; cnt += (c > 0u) ? 1u : 0u; mine = (j == x) ? c : mine; }
        if (sum == G) break;
        __builtin_amdgcn_s_sleep(1);
        if ((++sp & 255u) == 0u) { if (xb_ld(&bar[XB_TMO])) break; if (sp > XB_SPIN_CAP) { atomicAdd(&bar[XB_TMO], 1u); break; } }
    }
    nloc = mine > 0u ? mine : 1u; nx = cnt > 0u ? cnt : 1u;
}

__device__ __forceinline__ void xcd_barrier(const XcdBarrier& b) {
    asm volatile("s_waitcnt vmcnt(0)" ::: "memory");
    __syncthreads();
    if (threadIdx.x == 0) {
        unsigned* bar = b.bar;
        __builtin_amdgcn_s_waitcnt(0);
        unsigned nloc = b.st[0], nx = b.st[1];
        if (nloc == 0u) { xcd_barrier_complete(bar, b.x, nloc, nx); b.st[0] = nloc; b.st[1] = nx; }
        const unsigned old = xb_add(&bar[XB_XSUB(b.x)], 1u);
        const unsigned gen = old / nloc;
        if (old + 1u == (gen + 1u) * nloc) {
            __builtin_amdgcn_fence(__ATOMIC_RELEASE, "agent");
            asm volatile("s_waitcnt vmcnt(0)" ::: "memory");
            const unsigned og = xb_add(&bar[XB_TOP], 1u);
            const unsigned tg = og / nx;
            if (og + 1u == (tg + 1u) * nx) xb_add(&bar[XB_TOPGEN], 1u);
            else XB_SPIN(xb_ld(&bar[XB_TOPGEN]) == tg, bar);
            __builtin_amdgcn_fence(__ATOMIC_ACQUIRE, "agent");
            xb_add(&bar[XB_XGEN(b.x)], 1u);
            asm volatile("s_waitcnt vmcnt(0)" ::: "memory");
        } else {
            XB_SPIN(xb_ld(&bar[XB_XGEN(b.x)]) == gen, bar);
            __builtin_amdgcn_fence(__ATOMIC_ACQUIRE, "agent");
            asm volatile("s_waitcnt vmcnt(0)" ::: "memory");
        }
    }
    __syncthreads();
}

constexpr int NWAVES = 8;
constexpr int NB = 2, SEQ = 4096, NTOK = NB * SEQ, DM = 2048, INA = 5120, INB = 3072, DFF = 8192, MEML = 256, MEMR = NB * MEML;
constexpr int NH = 12, NMH = 4, MIXW = 1536, MEMW = 512, KVW = 512;
constexpr int A_K = 1536, A_V = 3072, A_QM = 4608;
constexpr int B_K = 1536, B_V = 2048, B_QM = 2560;
constexpr float RMS_EPS = 1e-6f;
constexpr float LOG2E = 1.4426950408889634f;
constexpr float QS64 = 0.125f * LOG2E;
constexpr float QS128 = 0.08838834764831845f * LOG2E;
constexpr float LAM_INIT0 = 0.2f;
constexpr int N_PHASES = 17;

constexpr size_t MiB = 1u << 20;
constexpr size_t WS_CTL = 0, CTL_ZERO_BYTES = 1 * MiB;
constexpr size_t WS_WA = 2 * MiB, WS_WB = 22 * MiB, WS_WMKV = 34 * MiB, WS_WOUT = 42 * MiB, WS_WUP = 58 * MiB, WS_WDN = 122 * MiB;
constexpr size_t WS_HN = 186 * MiB;
constexpr size_t WS_PROJ = 218 * MiB;
constexpr size_t WS_HEADS = 298 * MiB;
constexpr size_t WS_U = 330 * MiB;
constexpr size_t WS_MN = 458 * MiB;
constexpr size_t WS_MKVRAW = 462 * MiB;
constexpr size_t WS_KM = 466 * MiB;
constexpr size_t WS_VM = 467 * MiB;
constexpr size_t WS_END = 468 * MiB;
constexpr int CW_TMO = 0, CW_CODE = 1, CW_BAR = 4096;

constexpr int RING_OFF = 0, RING_BYTES = 131072;
constexpr int EXTRA_OFF = RING_BYTES, EXTRA_BYTES = 12288;
constexpr int LDSCTL_OFF = EXTRA_OFF + EXTRA_BYTES, MISC_OFF = LDSCTL_OFF + 320;
constexpr int LDS_BYTES = 147456;
static_assert(MISC_OFF + 128 <= LDS_BYTES, "LDS map");

struct Frame {
    LAS unsigned char* lds;
    volatile LAS unsigned* MISC;
    gu32* ctl;
    int tid, lane, wave;
    int vcu, G;
    const float* in[25]; float* out; unsigned char* ws;
};
__device__ __forceinline__ float wave_sum(float v) {
#pragma unroll
    for (int o = 1; o < 64; o <<= 1) v += __shfl_xor(v, o);
    return v;
}
__device__ __forceinline__ float wave_max(float v) {
#pragma unroll
    for (int o = 1; o < 64; o <<= 1) v = fmaxf(v, __shfl_xor(v, o));
    return v;
}
__device__ __forceinline__ float bf_lo(unsigned u) { return __uint_as_float(u << 16); }
__device__ __forceinline__ float bf_hi(unsigned u) { return __uint_as_float(u & 0xffff0000u); }

__device__ __forceinline__ void p0_transpose_item(const float* W, int K, int N, bf16* WT, LAS float* scr, int item, int lane) {
    const int nblk = N / 32, kb = item / nblk, nb = item % nblk, k0 = 64 * kb, n0 = 32 * nb;
#pragma unroll 8
    for (int i = 0; i < 32; ++i) { const int kk = 2 * i + (lane >> 5); scr[kk * 33 + (lane & 31)] = W[(size_t)(k0 + kk) * N + n0 + (lane & 31)]; }
    LDS_WAIT(); asm volatile("" ::: "memory");
    const int c = lane & 7;
#pragma unroll
    for (int j = 0; j < 4; ++j) { const int n = (lane >> 3) + 8 * j; const LAS float* s = scr + (8 * c) * 33 + n;
        v4u o; o.x = pk2(s[0 * 33], s[1 * 33]); o.y = pk2(s[2 * 33], s[3 * 33]); o.z = pk2(s[4 * 33], s[5 * 33]); o.w = pk2(s[6 * 33], s[7 * 33]);
        *(GAS v4u*)(WT + (size_t)(n0 + n) * K + k0 + 8 * c) = o; }
    LDS_WAIT(); asm volatile("" ::: "memory");
}
__device__ __forceinline__ void rms_row_to_bf16(const float* xrow, const float* gain, bf16* orow, int lane) {
    const GAS f32x4* xr = (const GAS f32x4*)xrow + lane; const GAS f32x4* gr = (const GAS f32x4*)gain + lane;
    f32x4 v[8]; float s = 0.f;
#pragma unroll
    for (int j = 0; j < 8; ++j) { v[j] = xr[64 * j]; s += (v[j].x * v[j].x + v[j].y * v[j].y) + (v[j].z * v[j].z + v[j].w * v[j].w); }
    const float r = 1.0f / sqrtf(wave_sum(s) * (1.f / DM) + RMS_EPS);
    GAS unsigned long long* o8 = (GAS unsigned long long*)orow + lane;
#pragma unroll
    for (int j = 0; j < 8; ++j) { const f32x4 g = gr[64 * j];
        o8[64 * j] = (unsigned long long)pk2(v[j].x * r * g.x, v[j].y * r * g.y) | ((unsigned long long)pk2(v[j].z * r * g.z, v[j].w * r * g.w) << 32); }
}
__device__ __forceinline__ void phase_rms_rows(Frame& F, const float* x, const float* gain, bf16* out, int nrows) {
    const int gw = F.vcu * NWAVES + F.wave, NGW = F.G * NWAVES;
    for (int m = gw; m < nrows; m += NGW) rms_row_to_bf16(x + (size_t)m * DM, gain, out + (size_t)m * DM, F.lane);
}
__device__ __forceinline__ void p0_prologue(Frame& F) {
    LAS float* scr = (LAS float*)(F.lds + RING_OFF + F.wave * 16384);
    const int gw = F.vcu * NWAVES + F.wave, NGW = F.G * NWAVES;
    bf16* const wa = (bf16*)(F.ws + WS_WA); bf16* const wb = (bf16*)(F.ws + WS_WB); bf16* const wm = (bf16*)(F.ws + WS_WMKV);
    bf16* const wo = (bf16*)(F.ws + WS_WOUT); bf16* const wu = (bf16*)(F.ws + WS_WUP); bf16* const wd = (bf16*)(F.ws + WS_WDN);
    constexpr int I_A = (DM / 64) * (INA / 32), I_B = (DM / 64) * (INB / 32), I_M = (DM / 64) * (1024 / 32), I_O = (DM / 64) * (DM / 32), I_U = (DM / 64) * (DFF / 32), I_D = (DFF / 64) * (DM / 32);
    constexpr int NITEMS = I_A + I_B + 2 * I_M + 2 * I_O + 2 * I_U + 2 * I_D;
    for (int it = gw; it < NITEMS; it += NGW) {
        int r = it;
        if (r < I_A) { p0_transpose_item(F.in[7], DM, INA, wa, scr, r, F.lane); continue; } r -= I_A;
        if (r < I_B) { p0_transpose_item(F.in[15], DM, INB, wb, scr, r, F.lane); continue; } r -= I_B;
        if (r < 2 * I_M) { const int l = r / I_M; p0_transpose_item(F.in[19] + (size_t)l * DM * 1024, DM, 1024, wm + (size_t)l * 1024 * DM, scr, r % I_M, F.lane); continue; } r -= 2 * I_M;
        if (r < 2 * I_O) { const int l = r / I_O; p0_transpose_item(F.in[22] + (size_t)l * DM * DM, DM, DM, wo + (size_t)l * DM * DM, scr, r % I_O, F.lane); continue; } r -= 2 * I_O;
        if (r < 2 * I_U) { const int l = r / I_U; p0_transpose_item(F.in[23] + (size_t)l * DM * DFF, DM, DFF, wu + (size_t)l * DFF * DM, scr, r % I_U, F.lane); continue; } r -= 2 * I_U;
        { const int l = r / I_D; p0_transpose_item(F.in[24] + (size_t)l * DFF * DM, DFF, DM, wd + (size_t)l * DM * DFF, scr, r % I_D, F.lane); }
    }
    phase_rms_rows(F, F.in[0], F.in[4], (bf16*)(F.ws + WS_HN), NTOK);
    phase_rms_rows(F, F.in[1], F.in[5], (bf16*)(F.ws + WS_MN), MEMR);
    phase_rms_rows(F, F.in[1], F.in[5] + DM, (bf16*)(F.ws + WS_MN) + (size_t)MEMR * DM, MEMR);
}

template <int SEGL> __device__ __forceinline__ void norm_chunk(bf16* p, const float* gain, float mult, int lane) {
    const v4u w = *(const GAS v4u*)(p + lane * 8);
    float f[8] = {bf_lo(w.x), bf_hi(w.x), bf_lo(w.y), bf_hi(w.y), bf_lo(w.z), bf_hi(w.z), bf_lo(w.w), bf_hi(w.w)};
    float s = 0.f;
#pragma unroll
    for (int i = 0; i < 8; ++i) s += f[i] * f[i];
#pragma unroll
    for (int o = 1; o < SEGL; o <<= 1) s += __shfl_xor(s, o);
    const float r = mult / sqrtf(s * (1.f / (SEGL * 8)) + RMS_EPS);
    const float* g = gain + (lane % SEGL) * 8;
    v4u o; o.x = pk2(f[0] * r * g[0], f[1] * r * g[1]); o.y = pk2(f[2] * r * g[2], f[3] * r * g[3]); o.z = pk2(f[4] * r * g[4], f[5] * r * g[5]); o.w = pk2(f[6] * r * g[6], f[7] * r * g[7]);
    *(GAS v4u*)(p + lane * 8) = o;
}
__device__ __forceinline__ void phase_qknorm_a(Frame& F) {
    const int gw = F.vcu * NWAVES + F.wave, NGW = F.G * NWAVES; bf16* proj = (bf16*)(F.ws + WS_PROJ);
    for (int m = gw; m < NTOK; m += NGW) { bf16* row = proj + (size_t)m * INA;
#pragma unroll
        for (int c = 0; c < 3; ++c) { norm_chunk<8>(row + c * 512, F.in[8], QS64, F.lane); norm_chunk<8>(row + A_K + c * 512, F.in[9], 1.f, F.lane); }
        norm_chunk<16>(row + A_QM, F.in[20], QS128, F.lane);
    }
    for (int m = gw; m < 2 * MEMR; m += NGW) { const int l = m / MEMR; const float* src = (const float*)(F.ws + WS_MKVRAW) + (size_t)m * 1024;
        const f32x4 a = *(const GAS f32x4*)(src + F.lane * 8), b = *(const GAS f32x4*)(src + F.lane * 8 + 4);
        float s = (a.x * a.x + a.y * a.y) + (a.z * a.z + a.w * a.w) + (b.x * b.x + b.y * b.y) + (b.z * b.z + b.w * b.w);
#pragma unroll
        for (int o = 1; o < 16; o <<= 1) s += __shfl_xor(s, o);
        const float r = 1.0f / sqrtf(s * (1.f / 128.f) + RMS_EPS); const float* g = F.in[21] + l * 128 + (F.lane % 16) * 8;
        v4u o; o.x = pk2(a.x * r * g[0], a.y * r * g[1]); o.y = pk2(a.z * r * g[2], a.w * r * g[3]); o.z = pk2(b.x * r * g[4], b.y * r * g[5]); o.w = pk2(b.z * r * g[6], b.w * r * g[7]);
        *(GAS v4u*)((bf16*)(F.ws + WS_KM) + (size_t)m * 512 + F.lane * 8) = o;
        const f32x4 c = *(const GAS f32x4*)(src + 512 + F.lane * 8), d = *(const GAS f32x4*)(src + 512 + F.lane * 8 + 4);
        v4u q; q.x = pk2(c.x, c.y); q.y = pk2(c.z, c.w); q.z = pk2(d.x, d.y); q.w = pk2(d.z, d.w);
        *(GAS v4u*)((bf16*)(F.ws + WS_VM) + (size_t)m * 512 + F.lane * 8) = q;
    }
}
__device__ __forceinline__ void phase_qknorm_b(Frame& F) {
    const int gw = F.vcu * NWAVES + F.wave, NGW = F.G * NWAVES; bf16* proj = (bf16*)(F.ws + WS_PROJ);
    for (int m = gw; m < NTOK; m += NGW) { bf16* row = proj + (size_t)m * INB;
#pragma unroll
        for (int c = 0; c < 3; ++c) norm_chunk<16>(row + c * 512, F.in[16], QS128, F.lane);
        norm_chunk<16>(row + B_K, F.in[17], 1.f, F.lane);
        norm_chunk<16>(row + B_QM, F.in[20] + 128, QS128, F.lane);
    }
}

__device__ __forceinline__ int t5_bucket(int rel) {
    const int n = rel < 0 ? -rel : rel; const int side = rel > 0 ? 16 : 0;
    const int large = 8 + (n >= 12) + (n >= 16) + (n >= 23) + (n >= 32) + (n >= 46) + (n >= 64) + (n >= 91);
    return side + (n < 8 ? n : large);
}
template <int N> __device__ __forceinline__ float dot_kq(const bf16* k, const LAS float* q) {
    float s = 0.f;
#pragma unroll
    for (int d = 0; d < N; d += 8) { const v4u w = *(const GAS v4u*)(k + d);
        s += bf_lo(w.x) * q[d] + bf_hi(w.x) * q[d + 1] + bf_lo(w.y) * q[d + 2] + bf_hi(w.y) * q[d + 3] + bf_lo(w.z) * q[d + 4] + bf_hi(w.z) * q[d + 5] + bf_lo(w.w) * q[d + 6] + bf_hi(w.w) * q[d + 7]; }
    return s;
}
__device__ __forceinline__ void pv_row(const LAS float* sc, int nkeys, const bf16* vrow0, size_t vstride, int lane, float& o0, float& o1) {
    o0 = 0.f; o1 = 0.f;
#pragma unroll 8
    for (int j = 0; j < nkeys; ++j) { const unsigned w = *(const GAS unsigned*)(vrow0 + (size_t)j * vstride + 2 * lane); const float a = sc[j]; o0 += a * bf_lo(w); o1 += a * bf_hi(w); }
}
__device__ __forceinline__ void mem_attn_item(Frame& F, const bf16* qrow, const bf16* km, const bf16* vm, bf16* orow) {
    LAS float* sc = (LAS float*)(F.lds + RING_OFF + F.wave * 16384); LAS float* qv = (LAS float*)(F.lds + EXTRA_OFF + F.wave * 512);
    { const unsigned w = *(const GAS unsigned*)(qrow + 2 * F.lane); qv[2 * F.lane] = bf_lo(w); qv[2 * F.lane + 1] = bf_hi(w); }
    LDS_WAIT(); asm volatile("" ::: "memory");
    float s[4]; float mx = -1e30f;
#pragma unroll
    for (int i = 0; i < 4; ++i) { s[i] = dot_kq<128>(km + (size_t)(F.lane + 64 * i) * 512, qv); mx = fmaxf(mx, s[i]); }
    mx = wave_max(mx); float l = 0.f;
#pragma unroll
    for (int i = 0; i < 4; ++i) { s[i] = exp2f(s[i] - mx); l += s[i]; }
    l = wave_sum(l); const float rl = 1.f / l;
#pragma unroll
    for (int i = 0; i < 4; ++i) sc[F.lane + 64 * i] = s[i] * rl;
    LDS_WAIT(); asm volatile("" ::: "memory");
    float o0, o1; pv_row(sc, MEML, vm, 512, F.lane, o0, o1);
    *(GAS unsigned*)(orow + 2 * F.lane) = pk2(o0, o1);
    LDS_WAIT(); asm volatile("" ::: "memory");
}
__device__ __forceinline__ void phase_attn_a(Frame& F) {
    const int gw = F.vcu * NWAVES + F.wave, NGW = F.G * NWAVES, lane = F.lane;
    const bf16* proj = (const bf16*)(F.ws + WS_PROJ); bf16* heads = (bf16*)(F.ws + WS_HEADS);
    const int* pos = (const int*)F.in[2]; const float* relb = F.in[3];
    LAS float* sc = (LAS float*)(F.lds + RING_OFF + F.wave * 16384); LAS float* qv = (LAS float*)(F.lds + EXTRA_OFF + F.wave * 512);
    float lam;
    { const float a = wave_sum(F.in[10][lane] * F.in[11][lane]), b = wave_sum(F.in[12][lane] * F.in[13][lane]); lam = expf(a) - expf(b) + LAM_INIT0; }
    for (int it = gw; it < NB * NH * SEQ; it += NGW) {
        const int t = it % SEQ, bh = it / SEQ, h = bh % NH, b = bh / NH; const size_t tok = (size_t)b * SEQ + t;
        { const unsigned w = *(const GAS unsigned*)(proj + tok * INA + h * 128 + 2 * lane); qv[2 * lane] = bf_lo(w); qv[2 * lane + 1] = bf_hi(w); }
        LDS_WAIT(); asm volatile("" ::: "memory");
        const int qpos = pos[tok]; const bf16* kbase = proj + (size_t)b * SEQ * INA + A_K + h * 128;
        float m1 = -1e30f, l1 = 0.f, m2 = -1e30f, l2 = 0.f;
        for (int i = 0; i < SEQ / 64; ++i) { const int j = lane + 64 * i; const bf16* kr = kbase + (size_t)j * INA;
            const float bias = relb[t5_bucket(pos[b * SEQ + j] - qpos) * NH + h] * LOG2E;
            const float s1 = dot_kq<64>(kr, qv) + bias, s2 = dot_kq<64>(kr + 64, qv + 64) + bias;
            { const float mn = fmaxf(m1, s1); l1 = l1 * exp2f(m1 - mn) + exp2f(s1 - mn); m1 = mn; }
            { const float mn = fmaxf(m2, s2); l2 = l2 * exp2f(m2 - mn) + exp2f(s2 - mn); m2 = mn; } }
        const float M1 = wave_max(m1), M2 = wave_max(m2);
        const float L1 = wave_sum(l1 * exp2f(m1 - M1)), L2 = wave_sum(l2 * exp2f(m2 - M2));
        const float r1 = 1.f / L1, r2 = lam / L2;
        for (int i = 0; i < SEQ / 64; ++i) { const int j = lane + 64 * i; const bf16* kr = kbase + (size_t)j * INA;
            const float bias = relb[t5_bucket(pos[b * SEQ + j] - qpos) * NH + h] * LOG2E;
            const float s1 = dot_kq<64>(kr, qv) + bias, s2 = dot_kq<64>(kr + 64, qv + 64) + bias;
            sc[j] = exp2f(s1 - M1) * r1 - exp2f(s2 - M2) * r2; }
        LDS_WAIT(); asm volatile("" ::: "memory");
        float o0, o1; pv_row(sc, SEQ, proj + (size_t)b * SEQ * INA + A_V + h * 128, INA, lane, o0, o1);
        const float r = (1.f - LAM_INIT0) / sqrtf(wave_sum(o0 * o0 + o1 * o1) * (1.f / 128.f) + RMS_EPS);
        *(GAS unsigned*)(heads + tok * DM + h * 128 + 2 * lane) = pk2(o0 * r * F.in[14][2 * lane], o1 * r * F.in[14][2 * lane + 1]);
        LDS_WAIT(); asm volatile("" ::: "memory");
    }
    for (int it = gw; it < NB * NMH * SEQ; it += NGW) {
        const int t = it % SEQ, bh = it / SEQ, hm = bh % NMH, b = bh / NMH; const size_t tok = (size_t)b * SEQ + t;
        mem_attn_item(F, proj + tok * INA + A_QM + hm * 128, (const bf16*)(F.ws + WS_KM) + (size_t)(b * MEML) * 512 + hm * 128,
                      (const bf16*)(F.ws + WS_VM) + (size_t)(b * MEML) * 512 + hm * 128, heads + tok * DM + MIXW + hm * 128);
    }
}
__device__ __forceinline__ void phase_attn_b(Frame& F) {
    const int gw = F.vcu * NWAVES + F.wave, NGW = F.G * NWAVES, lane = F.lane;
    const bf16* proj = (const bf16*)(F.ws + WS_PROJ); bf16* heads = (bf16*)(F.ws + WS_HEADS);
    const int* pos = (const int*)F.in[2]; const float* relb = F.in[3];
    LAS float* sc = (LAS float*)(F.lds + RING_OFF + F.wave * 16384); LAS float* qv = (LAS float*)(F.lds + EXTRA_OFF + F.wave * 512);
    for (int it = gw; it < NB * NH * SEQ; it += NGW) {
        const int t = it % SEQ, bh = it / SEQ, h = bh % NH, b = bh / NH, kvh = h / 3; const size_t tok = (size_t)b * SEQ + t;
        { const unsigned w = *(const GAS unsigned*)(proj + tok * INB + h * 128 + 2 * lane); qv[2 * lane] = bf_lo(w); qv[2 * lane + 1] = bf_hi(w); }
        LDS_WAIT(); asm volatile("" ::: "memory");
        const int qpos = pos[tok]; const int jlo = t - 128 < 0 ? 0 : t - 128, jhi = t + 128 > SEQ - 1 ? SEQ - 1 : t + 128, nk = jhi - jlo + 1;
        const bf16* kbase = proj + ((size_t)b * SEQ + jlo) * INB + B_K + kvh * 128;
        const float sink = F.in[18][h] * LOG2E;
        float s[5]; float mx = sink;
#pragma unroll
        for (int i = 0; i < 5; ++i) { const int jj = lane + 64 * i; s[i] = -1e30f;
            if (jj < nk) { s[i] = dot_kq<128>(kbase + (size_t)jj * INB, qv) + relb[t5_bucket(pos[b * SEQ + jlo + jj] - qpos) * NH + h] * LOG2E; }
            mx = fmaxf(mx, s[i]); }
        mx = wave_max(mx); float l = 0.f;
#pragma unroll
        for (int i = 0; i < 5; ++i) { const int jj = lane + 64 * i; s[i] = jj < nk ? exp2f(s[i] - mx) : 0.f; l += s[i]; }
        l = wave_sum(l) + exp2f(sink - mx); const float rl = 1.f / l;
#pragma unroll
        for (int i = 0; i < 5; ++i) sc[lane + 64 * i] = s[i] * rl;
        LDS_WAIT(); asm volatile("" ::: "memory");
        float o0, o1; pv_row(sc, nk, proj + ((size_t)b * SEQ + jlo) * INB + B_V + kvh * 128, INB, lane, o0, o1);
        *(GAS unsigned*)(heads + tok * DM + h * 128 + 2 * lane) = pk2(o0, o1);
        LDS_WAIT(); asm volatile("" ::: "memory");
    }
    for (int it = gw; it < NB * NMH * SEQ; it += NGW) {
        const int t = it % SEQ, bh = it / SEQ, hm = bh % NMH, b = bh / NMH; const size_t tok = (size_t)b * SEQ + t;
        mem_attn_item(F, proj + tok * INB + B_QM + hm * 128, (const bf16*)(F.ws + WS_KM) + (size_t)(MEMR + b * MEML) * 512 + hm * 128,
                      (const bf16*)(F.ws + WS_VM) + (size_t)(MEMR + b * MEML) * 512 + hm * 128, heads + tok * DM + MIXW + hm * 128);
    }
}

struct Args { const float* in[25]; float* out; unsigned char* ws; int ph_lo, ph_hi, li, pad; };
__global__ void __launch_bounds__(NWAVES * 64, 2) mk_fwd(Args args) {
    extern __shared__ __attribute__((aligned(16))) unsigned char lds[];
    Frame F;
    F.lds = (LAS unsigned char*)lds;
    F.MISC = (volatile LAS unsigned*)(F.lds + MISC_OFF);
    F.tid = threadIdx.x; F.lane = F.tid & 63; F.wave = __builtin_amdgcn_readfirstlane(F.tid >> 6);
    F.G = gridDim.x; { const int bx = blockIdx.x; F.vcu = (F.G % 8 == 0) ? (bx % 8) * (F.G / 8) + bx / 8 : bx; }
    F.ws = args.ws; F.out = args.out; F.ctl = (gu32*)(args.ws + WS_CTL);
#pragma unroll
    for (int i = 0; i < 25; ++i) F.in[i] = args.in[i];
    for (int u = F.tid; u < (LDS_BYTES - LDSCTL_OFF) / 4; u += NWAVES * 64) ((LAS unsigned*)(F.lds + LDSCTL_OFF))[u] = 0u;
    __syncthreads();
    const bool single = (args.ph_hi - args.ph_lo) > 1;
    XcdBarrier bar; bar.bar = (unsigned*)(F.ctl + CW_BAR); bar.x = 0; bar.st = nullptr;
    if (single) bar = xcd_barrier_post((unsigned*)(F.ctl + CW_BAR), F.MISC + 8);
    const int lo = args.ph_lo, hi = args.ph_hi;
#define IN(k) (lo <= (k) && (k) < hi)
#define SEAM(k) do { if (IN(k) && IN((k) + 1)) xcd_barrier(bar); } while (0)
    bf16* const HN = (bf16*)(F.ws + WS_HN); bf16* const PROJ = (bf16*)(F.ws + WS_PROJ); bf16* const HEADS = (bf16*)(F.ws + WS_HEADS); bf16* const U = (bf16*)(F.ws + WS_U);
    bf16* const WA = (bf16*)(F.ws + WS_WA); bf16* const WB = (bf16*)(F.ws + WS_WB); bf16* const WM = (bf16*)(F.ws + WS_WMKV);
    bf16* const WO = (bf16*)(F.ws + WS_WOUT); bf16* const WU = (bf16*)(F.ws + WS_WUP); bf16* const WD = (bf16*)(F.ws + WS_WDN);

    if (IN(0)) { p0_prologue(F); } SEAM(0);
    if (IN(1)) {
        for (int l = 0; l < 2; ++l) {
            pg8::Gemm g{(const bf16*)(F.ws + WS_MN) + (size_t)l * MEMR * DM, WM + (size_t)l * 1024 * DM, MEMR, 1024, DM}; pg8::StaticOrder S; S.init(MEMR, 1024, F.G, (int)blockIdx.x);
            pg8::EpiF32 E{(float*)(F.ws + WS_MKVRAW) + (size_t)l * MEMR * 1024, 1024};
            pg8::gemm_phase<pg8::EpiF32, pg8::StaticOrder, false, true>(F.lds + RING_OFF, g, S, E);
        }
    } SEAM(1);
    if (IN(2)) {
        pg8::Gemm g{HN, WA, NTOK, INA, DM}; pg8::StaticOrder S; S.init(NTOK, INA, F.G, (int)blockIdx.x);
        pg8::EpiBf16<0> E{PROJ, INA};
        pg8::gemm_phase<pg8::EpiBf16<0>, pg8::StaticOrder, true, true>(F.lds + RING_OFF, g, S, E);
    } SEAM(2);
    if (IN(3)) { phase_qknorm_a(F); } SEAM(3);
    if (IN(4)) { phase_attn_a(F); } SEAM(4);
    if (IN(5)) {
        pg8::Gemm g{HEADS, WO, NTOK, DM, DM}; pg8::StaticOrder S; S.init(NTOK, DM, F.G, (int)blockIdx.x);
        pg8::EpiResF32 E{F.in[0], F.out, DM};
        pg8::gemm_phase<pg8::EpiResF32, pg8::StaticOrder, false, true>(F.lds + RING_OFF, g, S, E);
    } SEAM(5);
    if (IN(6)) { phase_rms_rows(F, F.out, F.in[6], HN, NTOK); } SEAM(6);
    if (IN(7)) {
        pg8::Gemm g{HN, WU, NTOK, DFF, DM}; pg8::StaticOrder S; S.init(NTOK, DFF, F.G, (int)blockIdx.x);
        pg8::EpiBf16<1> E{U, DFF};
        pg8::gemm_phase<pg8::EpiBf16<1>, pg8::StaticOrder, true, true>(F.lds + RING_OFF, g, S, E);
    } SEAM(7);
    if (IN(8)) {
        pg8::Gemm g{U, WD, NTOK, DM, DFF}; pg8::StaticOrder S; S.init(NTOK, DM, F.G, (int)blockIdx.x);
        pg8::EpiResF32 E{F.out, F.out, DM};
        pg8::gemm_phase<pg8::EpiResF32, pg8::StaticOrder, false, true>(F.lds + RING_OFF, g, S, E);
    } SEAM(8);
    if (IN(9)) { phase_rms_rows(F, F.out, F.in[4] + DM, HN, NTOK); } SEAM(9);
    if (IN(10)) {
        pg8::Gemm g{HN, WB, NTOK, INB, DM}; pg8::StaticOrder S; S.init(NTOK, INB, F.G, (int)blockIdx.x);
        pg8::EpiBf16<0> E{PROJ, INB};
        pg8::gemm_phase<pg8::EpiBf16<0>, pg8::StaticOrder, true, true>(F.lds + RING_OFF, g, S, E);
    } SEAM(10);
    if (IN(11)) { phase_qknorm_b(F); } SEAM(11);
    if (IN(12)) { phase_attn_b(F); } SEAM(12);
    if (IN(13)) {
        pg8::Gemm g{HEADS, WO + (size_t)DM * DM, NTOK, DM, DM}; pg8::StaticOrder S; S.init(NTOK, DM, F.G, (int)blockIdx.x);
        pg8::EpiResF32 E{F.out, F.out, DM};
        pg8::gemm_phase<pg8::EpiResF32, pg8::StaticOrder, false, true>(F.lds + RING_OFF, g, S, E);
    } SEAM(13);
    if (IN(14)) { phase_rms_rows(F, F.out, F.in[6] + DM, HN, NTOK); } SEAM(14);
    if (IN(15)) {
        pg8::Gemm g{HN, WU + (size_t)DFF * DM, NTOK, DFF, DM}; pg8::StaticOrder S; S.init(NTOK, DFF, F.G, (int)blockIdx.x);
        pg8::EpiBf16<1> E{U, DFF};
        pg8::gemm_phase<pg8::EpiBf16<1>, pg8::StaticOrder, true, true>(F.lds + RING_OFF, g, S, E);
    } SEAM(15);
    if (IN(16)) {
        pg8::Gemm g{U, WD + (size_t)DM * DFF, NTOK, DM, DFF}; pg8::StaticOrder S; S.init(NTOK, DM, F.G, (int)blockIdx.x);
        pg8::EpiResF32 E{F.out, F.out, DM};
        pg8::gemm_phase<pg8::EpiResF32, pg8::StaticOrder, false, true>(F.lds + RING_OFF, g, S, E);
    }
#undef IN
#undef SEAM
}

#ifndef MK_ONE_LAUNCH
#define MK_ONE_LAUNCH 0
#endif
extern "C" void kernel_launch(void* const* d_in, const int* in_sizes, int n_in, void* d_out, int out_size, void* d_ws, size_t ws_size, hipStream_t stream) {
    static int grid = 0;
    if (grid == 0) {
        if (n_in != 25 || in_sizes[0] != NTOK * DM || out_size != NTOK * DM || ws_size < WS_END) { fprintf(stderr, "kernel_launch: unexpected shapes: n_in %d in0 %d out %d ws %zu (need %zu)\n", n_in, n_in > 0 ? in_sizes[0] : -1, out_size, ws_size, (size_t)WS_END); grid = -1; return; }
        int dev = 0, cus = 0;
        if (hipGetDevice(&dev) != hipSuccess || hipDeviceGetAttribute(&cus, hipDeviceAttributeMultiprocessorCount, dev) != hipSuccess) { fprintf(stderr, "kernel_launch: device query failed\n"); grid = -1; return; }
        if (hipFuncSetAttribute((const void*)mk_fwd, hipFuncAttributeMaxDynamicSharedMemorySize, LDS_BYTES) != hipSuccess) { fprintf(stderr, "kernel_launch: hipFuncSetAttribute failed\n"); grid = -1; return; }
        int per_cu = 0;
        if (hipOccupancyMaxActiveBlocksPerMultiprocessor(&per_cu, (const void*)mk_fwd, NWAVES * 64, LDS_BYTES) != hipSuccess || per_cu < 1) fprintf(stderr, "kernel_launch: note: occupancy query reports %d workgroups per CU\n", per_cu);
        (void)hipGetLastError();
        grid = cus;
    }
    if (grid < 0) return;
    if (hipMemsetAsync((char*)d_ws + WS_CTL, 0, CTL_ZERO_BYTES, stream) != hipSuccess) { fprintf(stderr, "kernel_launch: hipMemsetAsync failed\n"); return; }
    Args a{};
    for (int i = 0; i < 25; ++i) a.in[i] = (const float*)d_in[i];
    a.out = (float*)d_out; a.ws = (unsigned char*)d_ws;
#if MK_ONE_LAUNCH
    a.ph_lo = 0; a.ph_hi = N_PHASES; a.li = 0;
    hipLaunchKernelGGL(mk_fwd, dim3(grid), dim3(NWAVES * 64), LDS_BYTES, stream, a);
#else
    for (int p = 0; p < N_PHASES; ++p) { a.ph_lo = p; a.ph_hi = p + 1; a.li = p; hipLaunchKernelGGL(mk_fwd, dim3(grid), dim3(NWAVES * 64), LDS_BYTES, stream, a); }
#endif
    const hipError_t le = hipPeekAtLastError();
    if (le != hipSuccess) fprintf(stderr, "kernel_launch: launch failed: %s\n", hipGetErrorName(le));
}
```

```cpp
#include <hip/hip_runtime.h>
#include <cstdio>
#include <cstdint>
namespace pg8 {
#define PG8_LAS __attribute__((address_space(3)))
typedef unsigned short bf16_t;
typedef short bf16x8 __attribute__((ext_vector_type(8)));
typedef float f32x4 __attribute__((ext_vector_type(4)));
typedef unsigned u32x4 __attribute__((ext_vector_type(4)));
constexpr int BM = 256, BK = 64, HALF = 128, HTB = HALF * BK * 2  , STAGE_BYTES = 8 * HTB, NXCD = 8, WGM = 8;

__host__ __device__ __forceinline__ int lds_byte(int r, int c) { const int st = (r >> 4) * 2 + (c >> 5), rr = r & 15, cc = c & 31, ob = rr * 64 + cc * 2; return st * 1024 + (ob ^ (((ob >> 9) & 1) << 5)); }
__host__ __device__ __forceinline__ void stage_rc(int b, int& R, int& C) { const int st = b / 1024, sb = b % 1024, swz = sb ^ (((sb >> 9) & 1) << 5); R = (st >> 1) * 16 + swz / 64; C = (st & 1) * 32 + (swz % 64) / 2; }
__host__ __device__ __forceinline__ int perm32(int rho) { const int n = rho >> 4, i = rho & 15; return 8 * (i >> 2) + 4 * n + (i & 3); }

struct Unit { int pm, pn, kind; };
struct Gemm { const bf16_t* A; const bf16_t* Bt; int M, N, K; };

struct StaticOrder {
    int nM, nN, nwg, G, c, xl;
    __host__ __device__ void init(int M, int N, int G_, int c_, int xl_ = 0) { nM = M / BM; nN = N / BM; nwg = nM * nN; G = G_; c = c_; xl = xl_; }
    __host__ __device__ bool next(int i, Unit& u) const {
        const long L = (long)i * G + c; if (L >= nwg) return false;
        int pm, pn;
        if (xl) { const int xcd = (int)L % NXCD, off = (int)L / NXCD, P = nM / NXCD; pm = P * xcd + off % P; pn = off / P; }
        else {
            int wgid = (int)L; { const int q = nwg / NXCD, r = nwg % NXCD, xcd = wgid % NXCD, off = wgid / NXCD; wgid = (xcd < r ? xcd * (q + 1) : r * (q + 1) + (xcd - r) * q) + off; }
            const int nig = WGM * nN, gid = wgid / nig, fm = gid * WGM, gsz = (nM - fm) < WGM ? (nM - fm) : WGM;
            pm = fm + ((wgid % nig) % gsz); pn = (wgid % nig) / gsz; }
        u.pm = pm; u.pn = pn; u.kind = 0; return true;
    }
    __device__ __forceinline__ const char* a_base(const Unit& u, const Gemm& g, size_t tstep) const { return (const char*)g.A + (size_t)u.pm * tstep; }
    __device__ __forceinline__ const char* b_base(const Unit& u, const Gemm& g, size_t tstep) const { return (const char*)g.Bt + (size_t)u.pn * tstep; }
    __device__ __forceinline__ void a_ready(const Unit&) const {}
    __device__ __forceinline__ void done(const Unit&) const {}
};
struct ComboOrder : StaticOrder {
    const bf16_t* A2; const bf16_t* B2; int nx;
    __device__ bool next(int i, Unit& u) const {
        const long L = (long)i * G + c; if (L >= nwg + nx) return false;
        int pm, pn, kind;
        if (L < nwg) { Unit t; StaticOrder::next(i, t); pm = t.pm; pn = t.pn; kind = 0; }
        else { const int e = (int)(L - nwg), r = e & 7; pm = r & 1; pn = r >> 1; kind = 1 + (e >> 3); }
        u.pm = pm; u.pn = pn; u.kind = kind; return true;
    }
    __device__ __forceinline__ const char* a_base(const Unit& u, const Gemm& g, size_t tstep) const { return u.kind == 0 ? (const char*)g.A + (size_t)u.pm * tstep : (const char*)A2 + (size_t)u.pm * tstep; }
    __device__ __forceinline__ const char* b_base(const Unit& u, const Gemm& g, size_t tstep) const { return u.kind == 0 ? (const char*)g.Bt + (size_t)u.pn * tstep : (const char*)B2 + (size_t)((u.kind - 1) * 4 + u.pn) * tstep; }
};


__device__ __forceinline__ float xsum_rows(float v) {
    const auto r = __builtin_amdgcn_permlane16_swap(__float_as_uint(v), __float_as_uint(v), false, false); const float t = __uint_as_float(r[0]) + __uint_as_float(r[1]);
    const auto q = __builtin_amdgcn_permlane32_swap(__float_as_uint(t), __float_as_uint(t), false, false); return __uint_as_float(q[0]) + __uint_as_float(q[1]);
}
__device__ __forceinline__ unsigned cvt_pk_bf16(float lo, float hi) { unsigned r; asm volatile("v_cvt_pk_bf16_f32 %0, %1, %2" : "=v"(r) : "v"(lo), "v"(hi)); return r; }

template <int ACT  > struct EpiBf16 {
    static constexpr bool PERM = true, AFTER_DRAIN = false;
    bf16_t* O; int ldc;
    __device__ __forceinline__ void operator()(const f32x4 (&acc)[2][2][4][2], const Unit& u, int wr, int wc, int fr, int fq) const {
        asm volatile("" : "+v"(fr), "+v"(fq));
        const int row0 = u.pm * BM + wr * 64 + fr; const int col0 = u.pn * BM + wc * 32 + 8 * fq;
#pragma unroll
        for (int ai = 0; ai < 2; ++ai)
#pragma unroll
            for (int m = 0; m < 4; ++m) { bf16_t* rowp = O + (size_t)(row0 + ai * HALF + m * 16) * ldc + col0;
#pragma unroll
                for (int bj = 0; bj < 2; ++bj) { f32x4 v0 = acc[ai][bj][m][0], v1 = acc[ai][bj][m][1];
                    if (ACT == 1) {
#pragma unroll
                        for (int j = 0; j < 4; ++j) { const float a = fmaxf(v0[j], 0.f), b = fmaxf(v1[j], 0.f); v0[j] = a * a; v1[j] = b * b; } }
                    u32x4 w; w.x = cvt_pk_bf16(v0[0], v0[1]); w.y = cvt_pk_bf16(v0[2], v0[3]); w.z = cvt_pk_bf16(v1[0], v1[1]); w.w = cvt_pk_bf16(v1[2], v1[3]);
                    *(u32x4*)(rowp + bj * HALF) = w; } }
    }
};
struct EpiF32 {
    static constexpr bool PERM = false, AFTER_DRAIN = false;
    float* C; int ldc;
    __device__ __forceinline__ void operator()(const f32x4 (&acc)[2][2][4][2], const Unit& u, int wr, int wc, int fr, int fq) const {
        asm volatile("" : "+v"(fr), "+v"(fq));
        const int row0 = u.pm * BM + wr * 64 + fr, col0 = u.pn * BM + wc * 32 + 4 * fq;
#pragma unroll
        for (int ai = 0; ai < 2; ++ai)
#pragma unroll
            for (int m = 0; m < 4; ++m) { float* rowp = C + (size_t)(row0 + ai * HALF + m * 16) * ldc + col0;
#pragma unroll
                for (int bj = 0; bj < 2; ++bj)
#pragma unroll
                    for (int n = 0; n < 2; ++n) *(f32x4*)(rowp + bj * HALF + n * 16) = acc[ai][bj][m][n]; }
    }
};
struct EpiResF32 {
    static constexpr bool PERM = false, AFTER_DRAIN = false;
    const float* base; float* out; int ldc;
    __device__ __forceinline__ void operator()(const f32x4 (&acc)[2][2][4][2], const Unit& u, int wr, int wc, int fr, int fq) const {
        asm volatile("" : "+v"(fr), "+v"(fq));
        const int row0 = u.pm * BM + wr * 64 + fr, col0 = u.pn * BM + wc * 32 + 4 * fq;
#pragma unroll
        for (int ai = 0; ai < 2; ++ai)
#pragma unroll
            for (int m = 0; m < 4; ++m) { const size_t off = (size_t)(row0 + ai * HALF + m * 16) * ldc + col0;
#pragma unroll
                for (int bj = 0; bj < 2; ++bj)
#pragma unroll
                    for (int n = 0; n < 2; ++n) { const f32x4 b = *(const f32x4*)(base + off + bj * HALF + n * 16); *(f32x4*)(out + off + bj * HALF + n * 16) = b + acc[ai][bj][m][n]; } }
    }
};

constexpr float NORM_EPS = 1e-6f;
template <bool BASEF32, bool OUTF32> struct EpiRes {
    static constexpr bool PERM = true, AFTER_DRAIN = false; static constexpr int KIND = OUTF32 ? 3 : 0;
    const void* base; void* out; int ldc; float* rowsq;
    __device__ __forceinline__ void operator()(f32x4 (&acc)[2][2][4][2], const Unit& u, int wr, int wc, int fr, int fq) const {
        asm volatile("" : "+v"(fr), "+v"(fq));
        const int row0 = u.pm * BM + wr * 64 + fr, col0 = u.pn * BM + wc * 32 + 8 * fq;
        u32x4 bb[2][4][2];
        if (!BASEF32) {
#pragma unroll
            for (int ai = 0; ai < 2; ++ai)
#pragma unroll
                for (int m = 0; m < 4; ++m)
#pragma unroll
                    for (int bj = 0; bj < 2; ++bj) bb[ai][m][bj] = *(const u32x4*)((const bf16_t*)base + (size_t)(row0 + ai * HALF + m * 16) * ldc + col0 + bj * HALF); }
#pragma unroll
        for (int ai = 0; ai < 2; ++ai)
#pragma unroll
            for (int m = 0; m < 4; ++m) { const int row = row0 + ai * HALF + m * 16; const size_t off = (size_t)row * ldc + col0; float ss = 0.f;
#pragma unroll
                for (int bj = 0; bj < 2; ++bj) { f32x4 v0, v1;
                    if (BASEF32) { v0 = *(const f32x4*)((const float*)base + off + bj * HALF); v1 = *(const f32x4*)((const float*)base + off + bj * HALF + 4); }
                    else { const u32x4 b = bb[ai][m][bj];
                        v0 = (f32x4){__uint_as_float(b.x << 16), __uint_as_float(b.x & 0xffff0000u), __uint_as_float(b.y << 16), __uint_as_float(b.y & 0xffff0000u)};
                        v1 = (f32x4){__uint_as_float(b.z << 16), __uint_as_float(b.z & 0xffff0000u), __uint_as_float(b.w << 16), __uint_as_float(b.w & 0xffff0000u)}; }
                    v0 = v0 + acc[ai][bj][m][0]; v1 = v1 + acc[ai][bj][m][1];
                    if (OUTF32) { *(f32x4*)((float*)out + off + bj * HALF) = v0; *(f32x4*)((float*)out + off + bj * HALF + 4) = v1; }
                    else { ss += (v0[0] * v0[0] + v0[1] * v0[1]) + (v0[2] * v0[2] + v0[3] * v0[3]) + (v1[0] * v1[0] + v1[1] * v1[1]) + (v1[2] * v1[2] + v1[3] * v1[3]);
                        u32x4 w; w.x = cvt_pk_bf16(v0[0], v0[1]); w.y = cvt_pk_bf16(v0[2], v0[3]); w.z = cvt_pk_bf16(v1[0], v1[1]); w.w = cvt_pk_bf16(v1[2], v1[3]);
                        *(u32x4*)((bf16_t*)out + off + bj * HALF) = w; } }
                if (!OUTF32) { ss = xsum_rows(ss);
                    if (fq == 0) __hip_atomic_fetch_add(rowsq + row, ss, __ATOMIC_RELAXED, __HIP_MEMORY_SCOPE_AGENT); } }
    }
};
struct EpiUp {
    static constexpr bool PERM = true, AFTER_DRAIN = false; static constexpr int KIND = 1;
    bf16_t* O; int ldc; const float* rowsq; float invk;
    __device__ __forceinline__ void operator()(f32x4 (&acc)[2][2][4][2], const Unit& u, int wr, int wc, int fr, int fq) const {
        asm volatile("" : "+v"(fr), "+v"(fq));
        const int row0 = u.pm * BM + wr * 64 + fr; const int col0 = u.pn * BM + wc * 32 + 8 * fq;
        float rq[2][4];
#pragma unroll
        for (int ai = 0; ai < 2; ++ai)
#pragma unroll
            for (int m = 0; m < 4; ++m) rq[ai][m] = __hip_atomic_load(rowsq + row0 + ai * HALF + m * 16, __ATOMIC_RELAXED, __HIP_MEMORY_SCOPE_AGENT);
#pragma unroll
        for (int ai = 0; ai < 2; ++ai)
#pragma unroll
            for (int m = 0; m < 4; ++m)
#pragma unroll
                for (int bj = 0; bj < 2; ++bj)
#pragma unroll
                    for (int n = 0; n < 2; ++n)
#pragma unroll
                        for (int j = 0; j < 4; ++j) { const float a = fmaxf(acc[ai][bj][m][n][j], 0.f); acc[ai][bj][m][n][j] = a * a; }
#pragma unroll
        for (int ai = 0; ai < 2; ++ai)
#pragma unroll
            for (int m = 0; m < 4; ++m) { const int row = row0 + ai * HALF + m * 16; bf16_t* rowp = O + (size_t)row * ldc + col0;
                const float rs2 = __builtin_amdgcn_rcpf(rq[ai][m] * invk + NORM_EPS);
#pragma unroll
                for (int bj = 0; bj < 2; ++bj) { f32x4 v0 = acc[ai][bj][m][0] * rs2, v1 = acc[ai][bj][m][1] * rs2;
                    u32x4 w; w.x = cvt_pk_bf16(v0[0], v0[1]); w.y = cvt_pk_bf16(v0[2], v0[3]); w.z = cvt_pk_bf16(v1[0], v1[1]); w.w = cvt_pk_bf16(v1[2], v1[3]);
                    *(u32x4*)(rowp + bj * HALF) = w; } }
    }
};
template <int LAYER> struct EpiProj {
    static constexpr bool PERM = true, AFTER_DRAIN = false; static constexpr int KIND = 2;
    bf16_t* O; int ldc; const float* rowsq; float invk;
    bf16_t* KM; bf16_t* VM; const float* rowsq_m;
    PG8_LAS float* xb; PG8_LAS const float* xg;
    float qs64, qs128;
    __device__ __forceinline__ void operator()(f32x4 (&acc)[2][2][4][2], const Unit& u, int wr, int wc, int fr, int fq) const {
        asm volatile("" : "+v"(fr), "+v"(fq));
        bf16_t* ob; int ld, colt, cls, q; const float* rq; float mult;
        if (u.kind == 0) { ob = O + (size_t)(u.pm * BM) * ldc; ld = ldc; colt = u.pn * BM; rq = rowsq + u.pm * BM;
            if (LAYER == 0) { q = u.pn < 6 ? 0 : (u.pn < 12 ? 1 : (u.pn < 18 ? 2 : 3)); cls = q < 2 ? 1 : (q == 2 ? 0 : 2); mult = q == 0 ? qs64 : (q == 3 ? qs128 : 1.f); }
            else { q = u.pn < 6 ? 0 : (u.pn < 8 ? 1 : (u.pn < 10 ? 2 : 3)); cls = q == 2 ? 0 : 2; mult = (q == 0 || q == 3) ? qs128 : 1.f; } }
        else { const int l = u.kind - 1; const bool isk = u.pn < 2; ob = (isk ? KM : VM) + (size_t)(l * 512 + u.pm * BM) * 512; ld = 512; colt = (u.pn & 1) * BM; rq = rowsq_m + u.pm * BM;
               cls = isk ? 2 : 0; q = 4 + l; mult = 1.f; }
        const int rl0 = wr * 64 + fr;
        float rqv[2][4];
#pragma unroll
        for (int ai = 0; ai < 2; ++ai)
#pragma unroll
            for (int m = 0; m < 4; ++m) rqv[ai][m] = __hip_atomic_load(rq + rl0 + ai * HALF + m * 16, __ATOMIC_RELAXED, __HIP_MEMORY_SCOPE_AGENT);
        f32x4 g0 = {1.f, 1.f, 1.f, 1.f}, g1 = g0;
        if (cls != 0) {
            float sv[2][4][2];
#pragma unroll
            for (int ai = 0; ai < 2; ++ai)
#pragma unroll
                for (int m = 0; m < 4; ++m)
#pragma unroll
                    for (int bj = 0; bj < 2; ++bj) { const f32x4 a = acc[ai][bj][m][0], b = acc[ai][bj][m][1];
                        const float s = (a[0] * a[0] + a[1] * a[1]) + (a[2] * a[2] + a[3] * a[3]) + (b[0] * b[0] + b[1] * b[1]) + (b[2] * b[2] + b[3] * b[3]);
                        sv[ai][m][bj] = xsum_rows(s); }
            if (fq == 0) {
#pragma unroll
                for (int ai = 0; ai < 2; ++ai)
#pragma unroll
                    for (int m = 0; m < 4; ++m) { const float rs2 = __builtin_amdgcn_rcpf(rqv[ai][m] * invk + NORM_EPS);
#pragma unroll
                        for (int bj = 0; bj < 2; ++bj) xb[(rl0 + ai * HALF + m * 16) * 8 + bj * 4 + wc] = sv[ai][m][bj] * rs2; } }
            asm volatile("s_waitcnt lgkmcnt(0)" ::: "memory"); __builtin_amdgcn_s_barrier(); asm volatile("" ::: "memory");
            const float invn = cls == 1 ? (1.f / 64.f) : (1.f / 128.f);
            const float w01 = (cls == 2 || wc < 2) ? 1.f : 0.f, w23 = (cls == 2 || wc >= 2) ? 1.f : 0.f;
            f32x4 pv[2][4][2];
#pragma unroll
            for (int ai = 0; ai < 2; ++ai)
#pragma unroll
                for (int m = 0; m < 4; ++m)
#pragma unroll
                    for (int bj = 0; bj < 2; ++bj) pv[ai][m][bj] = *(const PG8_LAS f32x4*)(xb + (rl0 + ai * HALF + m * 16) * 8 + bj * 4);
#pragma unroll
            for (int ai = 0; ai < 2; ++ai)
#pragma unroll
                for (int m = 0; m < 4; ++m) { const float rs = __builtin_amdgcn_rsqf(rqv[ai][m] * invk + NORM_EPS);
#pragma unroll
                    for (int bj = 0; bj < 2; ++bj) { const f32x4 p = pv[ai][m][bj];
                        const float s = w01 * (p[0] + p[1]) + w23 * (p[2] + p[3]);
                        const float f = mult * __builtin_amdgcn_rsqf(s * invn + NORM_EPS) * rs;
                        acc[ai][bj][m][0] *= f; acc[ai][bj][m][1] *= f; } }
            PG8_LAS const float* gp = xg + q * 128 + (cls == 1 ? 32 * (wc & 1) : 32 * wc) + 8 * fq;
            g0 = *(PG8_LAS const f32x4*)gp; g1 = *(PG8_LAS const f32x4*)(gp + 4);
        } else {
#pragma unroll
            for (int ai = 0; ai < 2; ++ai)
#pragma unroll
                for (int m = 0; m < 4; ++m) { const float rs = __builtin_amdgcn_rsqf(rqv[ai][m] * invk + NORM_EPS);
#pragma unroll
                    for (int bj = 0; bj < 2; ++bj) { acc[ai][bj][m][0] *= rs; acc[ai][bj][m][1] *= rs; } }
        }
#pragma unroll
        for (int ai = 0; ai < 2; ++ai)
#pragma unroll
            for (int m = 0; m < 4; ++m) { bf16_t* rowp = ob + (size_t)(rl0 + ai * HALF + m * 16) * ld + colt + wc * 32 + 8 * fq;
#pragma unroll
                for (int bj = 0; bj < 2; ++bj) { const f32x4 v0 = acc[ai][bj][m][0] * g0, v1 = acc[ai][bj][m][1] * g1;
                    u32x4 w; w.x = cvt_pk_bf16(v0[0], v0[1]); w.y = cvt_pk_bf16(v0[2], v0[3]); w.z = cvt_pk_bf16(v1[0], v1[1]); w.w = cvt_pk_bf16(v1[2], v1[3]);
                    *(u32x4*)(rowp + bj * HALF) = w; } }
    }
};

template <class Epi, class Sched, bool ALIGN_EPI = false, bool SP2 = false, bool A_SC1 = false>
__device__ __forceinline__ void gemm_phase(PG8_LAS unsigned char* lds, const Gemm g, const Sched& S, const Epi& E) {
    const int tid = threadIdx.x, wid = __builtin_amdgcn_readfirstlane(tid >> 6), lane = tid & 63, wr = wid >> 2, wc = wid & 3, fr = lane & 15, fq = lane >> 4;
    const int K = g.K, nt = K / BK;
    unsigned voffA[2], voffB[2];
#pragma unroll
    for (int i = 0; i < 2; ++i) { int R, C; stage_rc(tid * 16 + i * 8192, R, C); const int Rb = Epi::PERM ? ((R & ~31) + perm32(R & 31)) : R;
        voffA[i] = (unsigned)(R * K + C) * 2u; voffB[i] = (unsigned)(Rb * K + C) * 2u; }
    const size_t kstep = (size_t)(BK * 2);
    const size_t hstep = (size_t)HALF * K * 2;
    const size_t tstep = 2 * hstep;
    const unsigned ldsw = (unsigned)wid * 1024u;
    const int aoff = lds_byte(wr * 64 + fr, fq * 8), boff = lds_byte(wc * 32 + fr, fq * 8);
#define PG8_SA(b, h) (((b) * 2 + (h)) * HTB)
#define PG8_SB(b, h) ((4 + (b) * 2 + (h)) * HTB)
#define PG8_STAGE(bufoff, gbase, voff) do { _Pragma("unroll") for (int _i = 0; _i < 2; ++_i) \
        __builtin_amdgcn_global_load_lds((const unsigned*)((const char*)(gbase) + (voff)[_i]), (PG8_LAS unsigned*)(lds + (bufoff) + ldsw + _i * 8192), 16, 0, 0); } while (0)
#define PG8_STAGEA(bufoff, gbase, voff) do { _Pragma("unroll") for (int _i = 0; _i < 2; ++_i) \
        __builtin_amdgcn_global_load_lds((const unsigned*)((const char*)(gbase) + (voff)[_i]), (PG8_LAS unsigned*)(lds + (bufoff) + ldsw + _i * 8192), 16, 0, A_SC1 ? 16 : 0); } while (0)
#define PG8_LDA(dst, b, h) do { _Pragma("unroll") for (int m = 0; m < 4; ++m) _Pragma("unroll") for (int k = 0; k < 2; ++k) dst[m][k] = *(const PG8_LAS bf16x8*)(lds + PG8_SA(b, h) + aoff + m * 2048 + k * 1024); } while (0)
#define PG8_LDB(dst, b, h) do { _Pragma("unroll") for (int n = 0; n < 2; ++n) _Pragma("unroll") for (int k = 0; k < 2; ++k) dst[n][k] = *(const PG8_LAS bf16x8*)(lds + PG8_SB(b, h) + boff + n * 2048 + k * 1024); } while (0)
#define PG8_MMA(ai, bj, At, Bt) do { __builtin_amdgcn_s_setprio(1); _Pragma("unroll") for (int m = 0; m < 4; ++m) _Pragma("unroll") for (int n = 0; n < 2; ++n) _Pragma("unroll") for (int k = 0; k < 2; ++k) \
        acc[ai][bj][m][n] = __builtin_amdgcn_mfma_f32_16x16x32_bf16(Bt[n][k], At[m][k], acc[ai][bj][m][n], 0, 0, 0); __builtin_amdgcn_s_setprio(0); } while (0)
#define PG8_WAIT_V(n) asm volatile("s_waitcnt vmcnt(" #n ")" ::: "memory")
#define PG8_WAIT_L(n) asm volatile("s_waitcnt lgkmcnt(" #n ")" ::: "memory")
#define PG8_BAR __builtin_amdgcn_s_barrier()
#define PG8_SCHED __builtin_amdgcn_sched_barrier(0)
    Unit cur, nxt; int ui = 0;
    if (!S.next(0, cur)) return;
    f32x4 acc[2][2][4][2];
#pragma unroll
    for (int a = 0; a < 2; ++a)
#pragma unroll
        for (int b = 0; b < 2; ++b)
#pragma unroll
            for (int m = 0; m < 4; ++m)
#pragma unroll
                for (int n = 0; n < 2; ++n) acc[a][b][m][n] = (f32x4){0.f, 0.f, 0.f, 0.f};
    bf16x8 At[4][2], B0[2][2], B1[2][2];
    const char* cA = S.a_base(cur, g, tstep); const char* cB = S.b_base(cur, g, tstep);
    S.a_ready(cur);
    if constexpr (SP2) {
        PG8_STAGE(PG8_SB(0, 0), cB, voffB); PG8_STAGE(PG8_SB(0, 1), cB + hstep, voffB); PG8_STAGEA(PG8_SA(0, 0), cA, voffA); PG8_STAGEA(PG8_SA(0, 1), cA + hstep, voffA);
        if (wr == 1) PG8_BAR;
        PG8_WAIT_V(2); PG8_BAR;
        PG8_STAGE(PG8_SB(1, 0), cB + kstep, voffB); PG8_STAGEA(PG8_SA(1, 0), cA + kstep, voffA); PG8_STAGE(PG8_SB(1, 1), cB + hstep + kstep, voffB);
        PG8_WAIT_V(6); PG8_BAR;
    } else {
        PG8_STAGE(PG8_SB(0, 0), cB, voffB); PG8_STAGEA(PG8_SA(0, 0), cA, voffA); PG8_STAGE(PG8_SB(0, 1), cB + hstep, voffB); PG8_STAGEA(PG8_SA(0, 1), cA + hstep, voffA);
        if (wr == 1) PG8_BAR;
        PG8_WAIT_V(4); PG8_BAR;
        PG8_STAGE(PG8_SB(1, 0), cB + kstep, voffB); PG8_STAGEA(PG8_SA(1, 0), cA + kstep, voffA); PG8_STAGE(PG8_SB(1, 1), cB + hstep + kstep, voffB);
        PG8_WAIT_V(6); PG8_BAR;
    }
    for (;;) {
        const bool has_next = S.next(ui + 1, nxt);
        const char* nA = has_next ? S.a_base(nxt, g, tstep) : cA; const char* nB = has_next ? S.b_base(nxt, g, tstep) : cB;
        for (int t = 0; t < nt; t += 2) {
            const bool last = (t == nt - 2);
            const char* a1 = cA + (size_t)(t + 1) * kstep;
            const char* a2 = last ? nA : cA + (size_t)(t + 2) * kstep; const char* b2 = last ? nB : cB + (size_t)(t + 2) * kstep;
            const char* a3 = a2 + kstep; const char* b3 = b2 + kstep;
            if (last && has_next) S.a_ready(nxt);
            if constexpr (SP2) {
            PG8_LDB(B0, 0, 0); PG8_LDB(B1, 0, 1); PG8_SCHED; PG8_LDA(At, 0, 0); PG8_STAGEA(PG8_SA(1, 1), a1 + hstep, voffA);
            PG8_WAIT_V(8); PG8_WAIT_L(0); PG8_BAR; PG8_MMA(0, 0, At, B0); PG8_MMA(0, 1, At, B1); PG8_BAR; PG8_SCHED;
            PG8_LDA(At, 0, 1); PG8_STAGE(PG8_SB(0, 0), b2, voffB); PG8_STAGE(PG8_SB(0, 1), b2 + hstep, voffB); PG8_STAGEA(PG8_SA(0, 0), a2, voffA);
            PG8_WAIT_V(8); PG8_WAIT_L(0); PG8_BAR; PG8_MMA(1, 0, At, B0); PG8_MMA(1, 1, At, B1); PG8_BAR; PG8_SCHED;
            PG8_LDB(B0, 1, 0); PG8_LDB(B1, 1, 1); PG8_SCHED; PG8_LDA(At, 1, 0); PG8_STAGEA(PG8_SA(0, 1), a2 + hstep, voffA);
            PG8_WAIT_V(8); PG8_WAIT_L(0); PG8_BAR; PG8_MMA(0, 0, At, B0); PG8_MMA(0, 1, At, B1); PG8_BAR; PG8_SCHED;
            PG8_LDA(At, 1, 1); PG8_STAGE(PG8_SB(1, 0), b3, voffB); PG8_STAGE(PG8_SB(1, 1), b3 + hstep, voffB); PG8_STAGEA(PG8_SA(1, 0), a3, voffA);
            PG8_WAIT_V(8); PG8_WAIT_L(0); PG8_BAR; PG8_MMA(1, 0, At, B0); PG8_MMA(1, 1, At, B1); PG8_BAR; PG8_SCHED;
            } else {
            PG8_LDB(B0, 0, 0); PG8_SCHED; PG8_LDA(At, 0, 0); PG8_STAGEA(PG8_SA(1, 1), a1 + hstep, voffA);
            PG8_WAIT_L(8); PG8_BAR; PG8_WAIT_L(0); PG8_MMA(0, 0, At, B0); PG8_BAR; PG8_SCHED;
            PG8_LDB(B1, 0, 1); PG8_STAGE(PG8_SB(0, 0), b2, voffB);
            PG8_BAR; PG8_WAIT_L(0); PG8_MMA(0, 1, At, B1); PG8_BAR;
            PG8_LDA(At, 0, 1); PG8_STAGEA(PG8_SA(0, 0), a2, voffA);
            PG8_BAR; PG8_WAIT_L(0); PG8_MMA(1, 0, At, B0); PG8_BAR; PG8_SCHED;
            PG8_STAGE(PG8_SB(0, 1), b2 + hstep, voffB);
            PG8_WAIT_V(6); PG8_BAR; PG8_MMA(1, 1, At, B1); PG8_BAR;
            PG8_LDB(B0, 1, 0); PG8_SCHED; PG8_LDA(At, 1, 0); PG8_STAGEA(PG8_SA(0, 1), a2 + hstep, voffA);
            PG8_WAIT_L(8); PG8_BAR; PG8_WAIT_L(0); PG8_MMA(0, 0, At, B0); PG8_BAR; PG8_SCHED;
            PG8_LDB(B1, 1, 1); PG8_STAGE(PG8_SB(1, 0), b3, voffB);
            PG8_BAR; PG8_WAIT_L(0); PG8_MMA(0, 1, At, B1); PG8_BAR;
            PG8_LDA(At, 1, 1); PG8_STAGEA(PG8_SA(1, 0), a3, voffA);
            PG8_BAR; PG8_WAIT_L(0); PG8_MMA(1, 0, At, B0); PG8_BAR; PG8_SCHED;
            PG8_STAGE(PG8_SB(1, 1), b3 + hstep, voffB);
            PG8_WAIT_V(6); PG8_BAR; PG8_MMA(1, 1, At, B1); PG8_BAR;
            }
        }
        if constexpr (ALIGN_EPI) { if (wr == 0) PG8_BAR; }
#ifdef PROBE_EPI
        const unsigned long long e0_ = __builtin_amdgcn_s_memrealtime();
#endif
        if constexpr (!Epi::AFTER_DRAIN) { E(acc, cur, wr, wc, fr, fq); S.done(cur); }
#ifdef PROBE_EPI
        if ((PROBE_EPI == 1 || PROBE_EPI == 10 + Epi::KIND) && blockIdx.x == 0 && threadIdx.x == 0) { const unsigned dt_ = (unsigned)(__builtin_amdgcn_s_memrealtime() - e0_); *(volatile PG8_LAS unsigned*)(lds + 143744) += dt_; }
#endif
        if (!has_next) break;
#pragma unroll
        for (int a = 0; a < 2; ++a)
#pragma unroll
            for (int b = 0; b < 2; ++b)
#pragma unroll
                for (int m = 0; m < 4; ++m)
#pragma unroll
                    for (int n = 0; n < 2; ++n) acc[a][b][m][n] = (f32x4){0.f, 0.f, 0.f, 0.f};
        cur = nxt; cA = nA; cB = nB; ++ui;
        if constexpr (ALIGN_EPI) { if (wr == 1) PG8_BAR; }
    }
    PG8_WAIT_V(0);
    if constexpr (!ALIGN_EPI) { if (wr == 0) PG8_BAR; }
    PG8_BAR;
    if constexpr (Epi::AFTER_DRAIN) { E.fused(acc, cur, wr, wc, fr, fq, lds, wid, lane); S.done(cur); }
#undef PG8_SA
#undef PG8_SB
#undef PG8_STAGE
#undef PG8_STAGEA
#undef PG8_LDA
#undef PG8_LDB
#undef PG8_MMA
#undef PG8_WAIT_V
#undef PG8_WAIT_L
#undef PG8_BAR
#undef PG8_SCHED
}
}
#define GAS __attribute__((address_space(1)))
#define LAS __attribute__((address_space(3)))
typedef unsigned short bf16;
typedef unsigned v4u __attribute__((ext_vector_type(4)));
typedef float f32x4 __attribute__((ext_vector_type(4)));
typedef short bf16x8 __attribute__((ext_vector_type(8)));
typedef GAS unsigned gu32;
typedef GAS unsigned long long gu64;
#define RLX_AGENT __ATOMIC_RELAXED, __HIP_MEMORY_SCOPE_AGENT
#define LDS_WAIT() asm volatile("s_waitcnt lgkmcnt(0)" ::: "memory")
#define VM_WAIT() asm volatile("s_waitcnt vmcnt(0)" ::: "memory")
__device__ __forceinline__ unsigned long long rt() { return __builtin_amdgcn_s_memrealtime(); }
__device__ __forceinline__ unsigned f2bf(float f) { unsigned u = __builtin_bit_cast(unsigned, f); return (u + 0x7fffu + ((u >> 16) & 1u)) >> 16; }
__device__ __forceinline__ unsigned pk2(float lo, float hi) { return f2bf(lo) | (f2bf(hi) << 16); }

#define XB_TMO      128
#define XB_XCNT(j)  (256  + 64 * (j))
#define XB_XSUB(j)  (1280 + 64 * (j))
#define XB_XGEN(j)  (2304 + 64 * (j))
#define XB_TOP      3328
#define XB_TOPGEN   3392
#define XCD_BAR_WORDS 3456
#define XB_SPIN_CAP (1u << 18)

__device__ __forceinline__ unsigned xb_ld(unsigned* p)              { return __hip_atomic_load(p, __ATOMIC_RELAXED, __HIP_MEMORY_SCOPE_AGENT); }
__device__ __forceinline__ unsigned xb_add(unsigned* p, unsigned v) { return __hip_atomic_fetch_add(p, v, __ATOMIC_RELAXED, __HIP_MEMORY_SCOPE_AGENT); }
__device__ __forceinline__ unsigned xb_xcc_id() { return (unsigned)__builtin_amdgcn_s_getreg((3 << 11) | 20) & 0xFu; }
#define XB_SPIN(cond, bar) do { unsigned _sp = 0; while (cond) { __builtin_amdgcn_s_sleep(1); \
    if ((++_sp & 255u) == 0u) { if (xb_ld(&(bar)[XB_TMO])) break; if (_sp > XB_SPIN_CAP) { atomicAdd(&(bar)[XB_TMO], 1u); break; } } } } while (0)

struct XcdBarrier {
    unsigned* bar; unsigned x;
    volatile LAS unsigned* st;
};

__device__ __forceinline__ XcdBarrier xcd_barrier_post(unsigned* bar, volatile LAS unsigned* st) {
    XcdBarrier b; b.bar = bar; b.x = xb_xcc_id(); b.st = st;
    if (threadIdx.x == 0) (void)xb_add(&bar[XB_XCNT(b.x)], 1u);
    return b;
}
__device__ __forceinline__ void xcd_barrier_complete(unsigned* bar, unsigned x, unsigned& nloc, unsigned& nx) {
    const unsigned G = gridDim.x * gridDim.y * gridDim.z;
    unsigned sum, cnt, mine, sp = 0u;
    for (;;) {
        sum = 0u; cnt = 0u; mine = 0u;
#pragma unroll
        for (unsigned j = 0; j < 16; ++j) { const unsigned c = xb_ld(&bar[XB_XCNT(j)]); sum += c; cnt += (c > 0u) ? 1u : 0u; mine = (j == x) ? c : mine; }
        if (sum == G) break;
        __builtin_amdgcn_s_sleep(1);
        if ((++sp & 255u) == 0u) { if (xb_ld(&bar[XB_TMO])) break; if (sp > XB_SPIN_CAP) { atomicAdd(&bar[XB_TMO], 1u); break; } }
    }
    nloc = mine > 0u ? mine : 1u; nx = cnt > 0u ? cnt : 1u;
}

__device__ __forceinline__ void xcd_barrier(const XcdBarrier& b) {
    asm volatile("s_waitcnt vmcnt(0)" ::: "memory");
    __syncthreads();
    if (threadIdx.x == 0) {
        unsigned* bar = b.bar;
        __builtin_amdgcn_s_waitcnt(0);
        unsigned nloc = b.st[0], nx = b.st[1];
        if (nloc == 0u) { xcd_barrier_complete(bar, b.x, nloc, nx); b.st[0] = nloc; b.st[1] = nx; }
#ifndef XB_EARLY_WB
#define XB_EARLY_WB 0
#endif
        if (XB_EARLY_WB) asm volatile("buffer_wbl2 sc1" ::: "memory");
        const unsigned old = xb_add(&bar[XB_XSUB(b.x)], 1u);
        const unsigned gen = old / nloc;
        if (old + 1u == (gen + 1u) * nloc) {
            __builtin_amdgcn_fence(__ATOMIC_RELEASE, "agent");
            asm volatile("s_waitcnt vmcnt(0)" ::: "memory");
            const unsigned og = xb_add(&bar[XB_TOP], 1u);
            const unsigned tg = og / nx;
            asm volatile("buffer_inv sc1" ::: "memory");
            if (og + 1u == (tg + 1u) * nx) xb_add(&bar[XB_TOPGEN], 1u);
            else XB_SPIN(xb_ld(&bar[XB_TOPGEN]) == tg, bar);
            xb_add(&bar[XB_XGEN(b.x)], 1u);
            asm volatile("s_waitcnt vmcnt(0)" ::: "memory");
        } else {
            asm volatile("buffer_inv sc1" ::: "memory");
            XB_SPIN(xb_ld(&bar[XB_XGEN(b.x)]) == gen, bar);
            asm volatile("s_waitcnt vmcnt(0)" ::: "memory");
        }
    }
    __syncthreads();
}

constexpr int NWAVES = 8;
constexpr int NB = 2, SEQ = 4096, NTOK = NB * SEQ, DM = 2048, INA = 5120, INB = 3072, DFF = 8192, MEML = 256, MEMR = NB * MEML;
constexpr int NH = 12, NMH = 4, MIXW = 1536, MEMW = 512, KVW = 512;
constexpr int A_K = 1536, A_V = 3072, A_QM = 4608;
constexpr int B_K = 1536, B_V = 2048, B_QM = 2560;
constexpr float RMS_EPS = 1e-6f;
constexpr float LOG2E = 1.4426950408889634f;
constexpr float QS64 = 0.125f * LOG2E;
constexpr float QS128 = 0.08838834764831845f * LOG2E;
constexpr float LAM_INIT0 = 0.2f;
constexpr int N_PHASES = 11;
constexpr unsigned CONV_P0 = 0x10D, CONV_P1 = 0x052, CONV_P6 = 0x2A0;
#ifndef CONV_DEPTH
#define CONV_DEPTH 2
#endif
#ifndef CONV_P1Y_N
#define CONV_P1Y_N 0
#endif
constexpr int CONV_P1Y_ITEMS = CONV_P1Y_N;
#ifndef CONV_P1X_N
#define CONV_P1X_N 0
#endif
constexpr int CONV_P1X_ITEMS = CONV_P1X_N;
#ifndef CONV_P7_N
#define CONV_P7_N 0
#endif
constexpr int CONV_P7_ITEMS = CONV_P7_N;
#ifndef CONV_P1_BACK
#define CONV_P1_BACK 768
#endif
constexpr int CONV_P1_BACK_ITEMS = CONV_P1_BACK;
#ifndef CONV_P2_N
#define CONV_P2_N 3072
#endif
constexpr int CONV_P2_ITEMS = CONV_P2_N;
constexpr int GEMM_CUS_P1 = 224, GEMM_CUS_P6 = 192;
static_assert((CONV_P0 | CONV_P1 | CONV_P6) == 0x3FF && (CONV_P0 & CONV_P1) == 0 && (CONV_P0 & CONV_P6) == 0 && (CONV_P1 & CONV_P6) == 0, "every weight matrix is converted exactly once");

constexpr size_t MiB = 1u << 20;
constexpr size_t WS_CTL = 0, CTL_ZERO_BYTES = 256 * 1024;
constexpr size_t WS_WA = 2 * MiB, WS_WB = 22 * MiB, WS_WMKV = 34 * MiB, WS_WOUT = 42 * MiB, WS_WUP = 58 * MiB, WS_WDN = 122 * MiB;
constexpr size_t WS_HN = 186 * MiB;
constexpr size_t WS_PROJ = 218 * MiB;
constexpr size_t WS_HEADS = 298 * MiB;
constexpr size_t WS_U = 330 * MiB;
constexpr size_t WS_MN = 458 * MiB;
constexpr size_t WS_MKVRAW = 462 * MiB;
constexpr size_t WS_KM = 466 * MiB;
constexpr size_t WS_VM = 467 * MiB;
constexpr size_t WS_POSMM = 468 * MiB;
constexpr size_t WS_END = 469 * MiB;
constexpr int CW_TMO = 0, CW_CODE = 1, CW_BAR = 4096;
constexpr int CW_RSQ_MLP0 = 16384, CW_RSQ_ATT1 = CW_RSQ_MLP0 + NTOK, CW_RSQ_MLP1 = CW_RSQ_ATT1 + NTOK, CW_RSQ_X = CW_RSQ_MLP1 + NTOK, CW_RSQ_M = CW_RSQ_X + NTOK;
constexpr int CW_PANEL = CW_RSQ_M + 2 * MEMR + 64;
constexpr int CW_XCC = CW_PANEL + 32 * 64;
constexpr int CW_CONVDONE = CW_XCC + 256;
static_assert((CW_CONVDONE + 64) * 4 <= (int)CTL_ZERO_BYTES, "control words inside the memset region");

constexpr int RING_OFF = 0, RING_BYTES = 131072;
constexpr int EXTRA_OFF = RING_BYTES, EXTRA_BYTES = 12288;
constexpr int LDSCTL_OFF = EXTRA_OFF + EXTRA_BYTES, MISC_OFF = LDSCTL_OFF + 320;
constexpr int LDS_BYTES = 147456;
static_assert(MISC_OFF + 128 <= LDS_BYTES, "LDS map");

struct Frame {
    LAS unsigned char* lds; unsigned char* ldsg;
    volatile LAS unsigned* MISC;
    gu32* ctl;
    int wave;
    int vcu, G, xl;
    const float* in[25]; float* out; unsigned char* ws;
};
__device__ __forceinline__ int cur_lane() { int l = (int)__builtin_amdgcn_mbcnt_hi(~0u, __builtin_amdgcn_mbcnt_lo(~0u, 0u)); asm volatile("" : "+v"(l)); return l; }
__device__ __forceinline__ float wave_sum(float v) {
#pragma unroll
    for (int o = 1; o < 64; o <<= 1) v += __shfl_xor(v, o);
    return v;
}
__device__ __forceinline__ float wave_max(float v) {
#pragma unroll
    for (int o = 1; o < 64; o <<= 1) v = fmaxf(v, __shfl_xor(v, o));
    return v;
}
__device__ __forceinline__ float bf_lo(unsigned u) { return __uint_as_float(u << 16); }
__device__ __forceinline__ float bf_hi(unsigned u) { return __uint_as_float(u & 0xffff0000u); }

struct TItem { const float* W; bf16* WT; const float* gain; int K, N, item; };
__device__ __forceinline__ void t_load(const TItem& t, f32x4 (&v)[8], int lane) {
    const int nblk = t.N / 32, kb = t.item / nblk, nb = t.item % nblk, k0 = 64 * kb, n0 = 32 * nb, r = lane >> 3, c4 = lane & 7;
#pragma unroll
    for (int i = 0; i < 8; ++i) v[i] = __builtin_nontemporal_load((const GAS f32x4*)(t.W + (size_t)(k0 + 8 * i + r) * t.N + n0 + 4 * c4));
}
__device__ __forceinline__ void t_store(const TItem& t, f32x4 (&v)[8], LAS float* scr, int lane) {
    const int nblk = t.N / 32, kb = t.item / nblk, nb = t.item % nblk, k0 = 64 * kb, n0 = 32 * nb, r = lane >> 3, c4 = lane & 7;
    if (t.gain) {
#pragma unroll
        for (int i = 0; i < 8; ++i) v[i] = v[i] * t.gain[k0 + 8 * i + r]; }
#pragma unroll
    for (int i = 0; i < 8; ++i) { LAS float* p = scr + (8 * i + r) * 33 + 4 * c4; p[0] = v[i].x; p[1] = v[i].y; p[2] = v[i].z; p[3] = v[i].w; }
    LDS_WAIT(); asm volatile("" ::: "memory");
    const int c = lane & 7;
#pragma unroll
    for (int j = 0; j < 4; ++j) { const int n = (lane >> 3) + 8 * j; const LAS float* s = scr + (8 * c) * 33 + n;
        v4u o; o.x = pk2(s[0 * 33], s[1 * 33]); o.y = pk2(s[2 * 33], s[3 * 33]); o.z = pk2(s[4 * 33], s[5 * 33]); o.w = pk2(s[6 * 33], s[7 * 33]);
        *(GAS v4u*)(t.WT + (size_t)(n0 + n) * t.K + k0 + 8 * c) = o; }
    LDS_WAIT(); asm volatile("" ::: "memory");
}
__device__ __forceinline__ void row_to_bf16(const float* xrow, bf16* orow, float* rowsq, int lane) {
    const GAS f32x4* xr = (const GAS f32x4*)xrow + lane;
    f32x4 v[8]; float s = 0.f;
#pragma unroll
    for (int j = 0; j < 8; ++j) { v[j] = xr[64 * j]; s += (v[j].x * v[j].x + v[j].y * v[j].y) + (v[j].z * v[j].z + v[j].w * v[j].w); }
    s = wave_sum(s); if (lane == 0) *rowsq = s;
    GAS unsigned long long* o8 = (GAS unsigned long long*)orow + lane;
#pragma unroll
    for (int j = 0; j < 8; ++j) o8[64 * j] = (unsigned long long)pk2(v[j].x, v[j].y) | ((unsigned long long)pk2(v[j].z, v[j].w) << 32);
}
__device__ __forceinline__ void row2_to_bf16(const float* x0, const float* x1, bf16* o0, bf16* o1, float* rq0, float* rq1, int lane) {
    const GAS f32x4* xa = (const GAS f32x4*)x0 + lane; const GAS f32x4* xb = (const GAS f32x4*)x1 + lane;
    f32x4 v[8], w[8]; float s = 0.f, t = 0.f;
#pragma unroll
    for (int j = 0; j < 8; ++j) v[j] = xa[64 * j];
#pragma unroll
    for (int j = 0; j < 8; ++j) w[j] = xb[64 * j];
#pragma unroll
    for (int j = 0; j < 8; ++j) { s += (v[j].x * v[j].x + v[j].y * v[j].y) + (v[j].z * v[j].z + v[j].w * v[j].w); t += (w[j].x * w[j].x + w[j].y * w[j].y) + (w[j].z * w[j].z + w[j].w * w[j].w); }
    s = wave_sum(s); t = wave_sum(t); if (lane == 0) { *rq0 = s; *rq1 = t; }
    GAS unsigned long long* p0 = (GAS unsigned long long*)o0 + lane; GAS unsigned long long* p1 = (GAS unsigned long long*)o1 + lane;
#pragma unroll
    for (int j = 0; j < 8; ++j) { p0[64 * j] = (unsigned long long)pk2(v[j].x, v[j].y) | ((unsigned long long)pk2(v[j].z, v[j].w) << 32);
                                  p1[64 * j] = (unsigned long long)pk2(w[j].x, w[j].y) | ((unsigned long long)pk2(w[j].z, w[j].w) << 32); }
}
__device__ __forceinline__ void phase_rows_bf16(Frame& F, const float* x, bf16* out, float* rowsq, int nrows) {
    const int gw = F.vcu * NWAVES + F.wave, NGW = F.G * NWAVES;
    for (int m = 2 * gw; m < nrows; m += 2 * NGW) row2_to_bf16(x + (size_t)m * DM, x + (size_t)(m + 1) * DM, out + (size_t)m * DM, out + (size_t)(m + 1) * DM, rowsq + m, rowsq + m + 1, cur_lane());
}
template <unsigned MASK, int DEPTH = 2> __device__ __forceinline__ void convert_weights(Frame& F, int gw, int NGW, int from_end0 = -1, int from_end1 = 0) {
    LAS float* scr = (LAS float*)(F.lds + RING_OFF + F.wave * 16384);
    bf16* const wa = (bf16*)(F.ws + WS_WA); bf16* const wb = (bf16*)(F.ws + WS_WB); bf16* const wm = (bf16*)(F.ws + WS_WMKV);
    bf16* const wo = (bf16*)(F.ws + WS_WOUT); bf16* const wu = (bf16*)(F.ws + WS_WUP); bf16* const wd = (bf16*)(F.ws + WS_WDN);
    constexpr int I_A = (DM / 64) * (INA / 32), I_B = (DM / 64) * (INB / 32), I_M = (DM / 64) * (1024 / 32), I_O = (DM / 64) * (DM / 32), I_U = (DM / 64) * (DFF / 32), I_D = (DFF / 64) * (DM / 32);
    constexpr int NITEMS = ((MASK >> 0) & 1) * I_A + ((MASK >> 1) & 1) * I_B + (((MASK >> 2) & 1) + ((MASK >> 3) & 1)) * I_M + (((MASK >> 4) & 1) + ((MASK >> 5) & 1)) * I_O
                         + (((MASK >> 6) & 1) + ((MASK >> 7) & 1)) * I_U + (((MASK >> 8) & 1) + ((MASK >> 9) & 1)) * I_D;
#define CW_TRY(bit, items, W_, K_, N_, WT_, G_) if ((MASK >> (bit)) & 1u) { if (!done && r < (items)) { t.W = (W_); t.K = (K_); t.N = (N_); t.WT = (WT_); t.gain = (G_); t.item = r; done = true; } r -= (items); }
#define CW_DECODE(IT, T) do { int r = (IT); bool done = false; TItem t{}; \
        CW_TRY(0, I_A, F.in[7], DM, INA, wa, F.in[4]) CW_TRY(1, I_B, F.in[15], DM, INB, wb, F.in[4] + DM) \
        CW_TRY(2, I_M, F.in[19], DM, 1024, wm, F.in[5]) CW_TRY(3, I_M, F.in[19] + (size_t)DM * 1024, DM, 1024, wm + (size_t)1024 * DM, F.in[5] + DM) \
        CW_TRY(4, I_O, F.in[22], DM, DM, wo, (const float*)nullptr) CW_TRY(5, I_O, F.in[22] + (size_t)DM * DM, DM, DM, wo + (size_t)DM * DM, (const float*)nullptr) \
        CW_TRY(6, I_U, F.in[23], DM, DFF, wu, F.in[6]) CW_TRY(7, I_U, F.in[23] + (size_t)DM * DFF, DM, DFF, wu + (size_t)DFF * DM, F.in[6] + DM) \
        CW_TRY(8, I_D, F.in[24], DFF, DM, wd, (const float*)nullptr) CW_TRY(9, I_D, F.in[24] + (size_t)DFF * DM, DFF, DM, wd + (size_t)DM * DFF, (const float*)nullptr) \
        T = t; } while (0)
    const int it0 = from_end0 < 0 ? 0 : NITEMS - from_end0, it1 = NITEMS - from_end1;
    if constexpr (DEPTH == 4) {
    for (int it = it0 + gw; it < it1; it += 4 * NGW) {
        const int lane = cur_lane(); const bool h1 = it + NGW < it1, h2 = it + 2 * NGW < it1, h3 = it + 3 * NGW < it1;
        TItem ta, tb_, tc, td; CW_DECODE(it, ta); CW_DECODE(h1 ? it + NGW : it, tb_); CW_DECODE(h2 ? it + 2 * NGW : it, tc); CW_DECODE(h3 ? it + 3 * NGW : it, td);
        f32x4 va[8], vb[8], vc[8], vd[8];
        t_load(ta, va, lane); if (h1) t_load(tb_, vb, lane); if (h2) t_load(tc, vc, lane); if (h3) t_load(td, vd, lane);
        t_store(ta, va, scr, lane); if (h1) t_store(tb_, vb, scr, lane); if (h2) t_store(tc, vc, scr, lane); if (h3) t_store(td, vd, scr, lane);
    }
    } else {
    for (int it = it0 + gw; it < it1; it += 2 * NGW) {
        const int lane = cur_lane(); const bool two = it + NGW < it1;
        TItem ta, tb_; CW_DECODE(it, ta); CW_DECODE(two ? it + NGW : it, tb_);
        f32x4 va[8], vb[8];
        t_load(ta, va, lane); if (two) t_load(tb_, vb, lane);
        t_store(ta, va, scr, lane); if (two) t_store(tb_, vb, scr, lane);
    }
    }
#undef CW_TRY
#undef CW_DECODE
}
__device__ __forceinline__ void p0_prologue(Frame& F) {
    const int gw = F.vcu * NWAVES + F.wave, NGW = F.G * NWAVES;
    convert_weights<CONV_P0>(F, gw, NGW, -1, F.G == 256 ? CONV_P2_ITEMS + CONV_P1X_ITEMS + CONV_P1Y_ITEMS : 0);
    if (F.G >= 256 && CONV_P1_BACK_ITEMS > 0) convert_weights<CONV_P1>(F, gw, NGW, CONV_P1_BACK_ITEMS, 0);
    phase_rows_bf16(F, F.in[0], (bf16*)(F.ws + WS_HN), (float*)(F.ctl + CW_RSQ_X), NTOK);
    phase_rows_bf16(F, F.in[1], (bf16*)(F.ws + WS_MN), (float*)(F.ctl + CW_RSQ_M), MEMR);
}

__device__ __forceinline__ int t5_bucket(int rel) {
    const int n = rel < 0 ? -rel : rel; const int side = rel > 0 ? 16 : 0;
    const int large = 8 + (n >= 12) + (n >= 16) + (n >= 23) + (n >= 32) + (n >= 46) + (n >= 64) + (n >= 91);
    return side + (n < 8 ? n : large);
}

namespace att {
typedef short bf16x8 __attribute__((ext_vector_type(8)));
typedef short s16x4 __attribute__((ext_vector_type(4)));
typedef float f32x16 __attribute__((ext_vector_type(16)));
typedef unsigned u32x4 __attribute__((ext_vector_type(4)));
typedef int i32x4 __attribute__((ext_vector_type(4)));
enum { M_DIFF = 0, M_WIN = 1, M_MEM = 2 };
#define KSWZ(row, colB) ((row) * 256 + ((colB) ^ (((row) & 15) << 4)))
#define SBAR() __builtin_amdgcn_sched_barrier(0)
constexpr int SHM_V = 16384, SHM_K = 16384;
constexpr int L_V = 0, L_K = 32768, L_XCH = 65536;
constexpr int X_FLG = 5632, X_TBM = 6144, TBM_OFF = 512;
constexpr int X_WS = 0, X_POS = 2048, X_TB = 4096, X_TMM = 5120;
constexpr int NREL = 91;
__device__ __forceinline__ int crow(int r, int hi) { return (r & 3) + 8 * (r >> 2) + 4 * hi; }
__device__ __forceinline__ unsigned cvtpk(float lo, float hi) { unsigned r; asm volatile("v_cvt_pk_bf16_f32 %0, %1, %2" : "=v"(r) : "v"(lo), "v"(hi)); return r; }
template <int K> __device__ __forceinline__ int xor_i(int v) {
  if (K < 32) return __builtin_amdgcn_ds_swizzle(v, (K << 10) | 0x1f);
  else { auto r = __builtin_amdgcn_permlane32_swap((unsigned)v, (unsigned)v, false, false); return (int)r[0] == v ? (int)r[1] : (int)r[0]; }
}
template <int K> __device__ __forceinline__ float xor_f(float v) { return __int_as_float(xor_i<K>(__float_as_int(v))); }
__device__ __forceinline__ int v_st(int k, int c) { const int kk = k; return ((kk >> 3) * 4 + (c >> 5)) * 512 + ((kk & 7) * 32 + (c & 31)) * 2; }
__device__ __forceinline__ int v_rd_base(int lane) { return ((lane & 3) << 3) | (((lane >> 2) & 3) << 6) | (((lane >> 4) & 1) << 5) | (((lane >> 5) & 1) << 8); }
constexpr int v_rd_off(int d0, int ks, int half) { return d0 * 512 + ks * 4096 + half * 2048; }
template <int OFF> __device__ __forceinline__ s16x4 tr_read(int vb) { s16x4 r; asm volatile("ds_read_b64_tr_b16 %0, %1 offset:%2" : "=&v"(r) : "v"(vb), "i"(OFF) : "memory"); return r; }
template <int D0> __device__ __forceinline__ void pv_one(f32x16& od, int vb, bf16x8 pa0, bf16x8 pa1, bf16x8 pa2, bf16x8 pa3) {
  const s16x4 l0 = tr_read<v_rd_off(D0, 0, 0)>(vb), h0 = tr_read<v_rd_off(D0, 0, 1)>(vb), l1 = tr_read<v_rd_off(D0, 1, 0)>(vb), h1 = tr_read<v_rd_off(D0, 1, 1)>(vb);
  const s16x4 l2 = tr_read<v_rd_off(D0, 2, 0)>(vb), h2 = tr_read<v_rd_off(D0, 2, 1)>(vb), l3 = tr_read<v_rd_off(D0, 3, 0)>(vb), h3 = tr_read<v_rd_off(D0, 3, 1)>(vb);
  asm volatile("s_waitcnt lgkmcnt(0)" ::: "memory"); SBAR();
#define PK(L, H) (bf16x8){L[0], L[1], L[2], L[3], H[0], H[1], H[2], H[3]}
  od = __builtin_amdgcn_mfma_f32_32x32x16_bf16(pa0, PK(l0, h0), od, 0, 0, 0);
  od = __builtin_amdgcn_mfma_f32_32x32x16_bf16(pa1, PK(l1, h1), od, 0, 0, 0);
  od = __builtin_amdgcn_mfma_f32_32x32x16_bf16(pa2, PK(l2, h2), od, 0, 0, 0);
  od = __builtin_amdgcn_mfma_f32_32x32x16_bf16(pa3, PK(l3, h3), od, 0, 0, 0);
#undef PK
}
__device__ __forceinline__ void pv_d0(f32x16* o, int vb, bf16x8 pa0, bf16x8 pa1, bf16x8 pa2, bf16x8 pa3) {
  pv_one<0>(o[0], vb, pa0, pa1, pa2, pa3); pv_one<1>(o[1], vb, pa0, pa1, pa2, pa3); pv_one<2>(o[2], vb, pa0, pa1, pa2, pa3); pv_one<3>(o[3], vb, pa0, pa1, pa2, pa3);
}
template <int ND0> __device__ __forceinline__ void qkt(f32x16& p0, f32x16& p1, const char* Ks, const bf16x8* qr, int r32, int hi, int kcolB) {
  p0 = f32x16{}; p1 = f32x16{};
#pragma unroll
  for (int d0 = 0; d0 < ND0; ++d0) { const int cb = kcolB + (d0 * 16 + hi * 8) * 2;
    const bf16x8 b0 = *reinterpret_cast<const bf16x8*>(Ks + KSWZ(r32, cb));
    const bf16x8 b1 = *reinterpret_cast<const bf16x8*>(Ks + KSWZ(32 + r32, cb));
    p0 = __builtin_amdgcn_mfma_f32_32x32x16_bf16(b0, qr[d0], p0, 0, 0, 0);
    p1 = __builtin_amdgcn_mfma_f32_32x32x16_bf16(b1, qr[d0], p1, 0, 0, 0); }
}
__device__ __forceinline__ void add_bias(f32x16& p0, f32x16& p1, const int* kp, const float* tb, int qpos, int hi) {
#pragma unroll
  for (int g = 0; g < 4; ++g) { const i32x4 ka = *reinterpret_cast<const i32x4*>(kp + 8 * g + 4 * hi), kb = *reinterpret_cast<const i32x4*>(kp + 32 + 8 * g + 4 * hi);
#pragma unroll
    for (int i = 0; i < 4; ++i) { int ia = ka[i] - qpos + NREL, ib = kb[i] - qpos + NREL; ia = ia < 0 ? 0 : (ia > 2 * NREL ? 2 * NREL : ia); ib = ib < 0 ? 0 : (ib > 2 * NREL ? 2 * NREL : ib);
      p0[4 * g + i] += tb[ia]; p1[4 * g + i] += tb[ib]; } }
}
__device__ __forceinline__ void win_mask(f32x16& p0, f32x16& p1, int dq) {
#pragma unroll
  for (int r = 0; r < 16; ++r) { const int d = dq + (r & 3) + 8 * (r >> 2);
    if ((unsigned)(d + 128) > 256u) p0[r] = -INFINITY;
    if ((unsigned)(d + 160) > 256u) p1[r] = -INFINITY; }
}
__device__ __forceinline__ void add_bias_fast(f32x16& p0, f32x16& p1, const float* tp) {
#pragma unroll
  for (int r = 0; r < 16; ++r) { p0[r] += tp[(r & 3) + 8 * (r >> 2)]; p1[r] += tp[32 + (r & 3) + 8 * (r >> 2)]; }
}
__device__ __forceinline__ void exp_half(f32x16& p) {
#pragma unroll
  for (int r = 0; r < 16; ++r) p[r] = __builtin_amdgcn_exp2f(p[r]);
}
__device__ __forceinline__ void finishSM(f32x16& p0, f32x16& p1, float& l_reg, bf16x8& pa0, bf16x8& pa1, bf16x8& pa2, bf16x8& pa3) {
  exp_half(p1);
  float ps = 0.f;
#pragma unroll
  for (int r = 0; r < 16; ++r) ps += p0[r];
#pragma unroll
  for (int r = 0; r < 16; ++r) ps += p1[r];
  l_reg += ps;
#define PK4(P, BASE, OUT) do { unsigned a0 = cvtpk(P[BASE + 0], P[BASE + 1]), a1 = cvtpk(P[BASE + 2], P[BASE + 3]);   \
    unsigned b0 = cvtpk(P[BASE + 4], P[BASE + 5]), b1 = cvtpk(P[BASE + 6], P[BASE + 7]);                              \
    u32x4 w = {a0, a1, b0, b1}; OUT = *reinterpret_cast<bf16x8*>(&w); } while (0)
  PK4(p0, 0, pa0); PK4(p0, 8, pa1); PK4(p1, 0, pa2); PK4(p1, 8, pa3);
#undef PK4
}

struct UnitArgs {
  const bf16* Q; int ldq;
  const bf16* K; const bf16* V;
  bf16* O;
  const int* posb;
  const float* relb; int h;
  int q0;
  float sinkl2;
  float lam; const float* subln;
};

template <int MODE>
__device__ __forceinline__ void attn_epilogue(f32x16 (&o)[4], float l_reg, const UnitArgs& A, char* ring, char* extra) {
  int tid = threadIdx.x; asm volatile("" : "+v"(tid));
  const int wid = __builtin_amdgcn_readfirstlane(tid >> 6), lane = tid & 63, r32 = lane & 31, hi = lane >> 5;
  const int wq = (MODE == M_DIFF) ? (wid & 3) : wid, half = (MODE == M_DIFF) ? (wid >> 2) : 0;
  float* wsf = (float*)(extra + X_WS) + wid * 64;
  { auto rr = __builtin_amdgcn_permlane32_swap(__float_as_uint(l_reg), __float_as_uint(l_reg), false, false); l_reg = __uint_as_float(rr[0]) + __uint_as_float(rr[1]); }
  if (MODE == M_WIN) l_reg += __builtin_amdgcn_exp2f(A.sinkl2);
  if (hi == 0) wsf[r32] = l_reg; asm volatile("s_waitcnt lgkmcnt(0)" ::: "memory");
  float rli[16];
#pragma unroll
  for (int r = 0; r < 16; ++r) rli[r] = __builtin_amdgcn_rcpf(wsf[crow(r, hi)]);
  if (MODE == M_DIFF) {
    float* xch = (float*)(ring + L_XCH);
    __syncthreads();
    if (half == 1) {
#pragma unroll
      for (int r = 0; r < 16; ++r)
#pragma unroll
        for (int d0 = 0; d0 < 4; ++d0) xch[(wq * 32 + crow(r, hi)) * 128 + d0 * 32 + r32] = o[d0][r] * rli[r] * A.lam;
    }
    __syncthreads();
    if (half == 0) {
      float ss[16];
#pragma unroll
      for (int r = 0; r < 16; ++r) { ss[r] = 0.f;
#pragma unroll
        for (int d0 = 0; d0 < 4; ++d0) { const float v = o[d0][r] * rli[r] - xch[(wq * 32 + crow(r, hi)) * 128 + d0 * 32 + r32]; o[d0][r] = v; ss[r] += v * v; } }
#pragma unroll
      for (int r = 0; r < 16; ++r) {
        ss[r] += xor_f<1>(ss[r]); ss[r] += xor_f<2>(ss[r]); ss[r] += xor_f<4>(ss[r]); ss[r] += xor_f<8>(ss[r]); ss[r] += xor_f<16>(ss[r]);
        ss[r] = (1.f - LAM_INIT0) / sqrtf(ss[r] * (1.f / 128.f) + RMS_EPS); }
      bf16* stg = (bf16*)(ring + wq * 8192);
#pragma unroll
      for (int d0 = 0; d0 < 4; ++d0) { const float g = A.subln[d0 * 32 + r32];
#pragma unroll
        for (int r = 0; r < 16; ++r) stg[crow(r, hi) * 128 + d0 * 32 + r32] = (bf16)f2bf(o[d0][r] * ss[r] * g); }
      asm volatile("s_waitcnt lgkmcnt(0)" ::: "memory");
#pragma unroll
      for (int i = 0; i < 8; ++i) { const int row = i * 4 + (lane >> 4), ch = lane & 15; const u32x4 v = *(const u32x4*)(stg + row * 128 + ch * 8);
        *(u32x4*)(A.O + (size_t)(wq * 32 + row) * DM + ch * 8) = v; }
    }
  } else {
    __syncthreads();
    bf16* stg = (bf16*)(ring + wq * 8192);
#pragma unroll
    for (int d0 = 0; d0 < 4; ++d0)
#pragma unroll
      for (int r = 0; r < 16; ++r) stg[crow(r, hi) * 128 + d0 * 32 + r32] = (bf16)f2bf(o[d0][r] * rli[r]);
    asm volatile("s_waitcnt lgkmcnt(0)" ::: "memory");
#pragma unroll
    for (int i = 0; i < 8; ++i) { const int row = i * 4 + (lane >> 4), ch = lane & 15; const u32x4 v = *(const u32x4*)(stg + row * 128 + ch * 8);
      *(u32x4*)(A.O + (size_t)(wq * 32 + row) * DM + ch * 8) = v; }
  }
}
constexpr int DSLOT = 32768, D_POS = 3 * DSLOT;
typedef short v4i16_t __attribute__((ext_vector_type(4)));
typedef __attribute__((address_space(3))) const char* lds_cptr;
__device__ __forceinline__ s16x4 vtr(lds_cptr p) { return __builtin_bit_cast(s16x4, __builtin_amdgcn_ds_read_tr16_b64_v4i16((__attribute__((address_space(3))) v4i16_t*)p)); }
#ifndef ATT_PRIO
#define ATT_PRIO 0
#endif
#ifndef ATT_VD
#define ATT_VD 4
#endif
constexpr int VD = ATT_VD;
template <int MODE>
__device__ __forceinline__ void attn_unit_pipe(char* ring, char* extra, const UnitArgs& A) {
  constexpr int ND0 = (MODE == M_DIFF) ? 4 : 8, LDK = (MODE == M_DIFF) ? INA : INB, NF = 2 * ND0;
  int NT = (MODE == M_DIFF) ? SEQ / 64 : 8; asm volatile("" : "+s"(NT));
  int tid = threadIdx.x; asm volatile("" : "+v"(tid));
  const int wid = __builtin_amdgcn_readfirstlane(tid >> 6), lane = tid & 63, r32 = lane & 31, hi = lane >> 5;
  const int wq = (MODE == M_DIFF) ? (wid & 3) : wid, half = (MODE == M_DIFF) ? (wid >> 2) : 0;
  const int kt0 = (MODE == M_WIN) ? A.q0 - 128 : 0;
#define KEYC(k) ((MODE == M_WIN) ? ((k) < 0 ? 0 : ((k) > SEQ - 1 ? SEQ - 1 : (k))) : (k))
  const int sr = tid >> 4, sc = (tid & 15) * 8, vst0 = v_st(sr, sc), vst1 = v_st(32 + sr, sc);
  struct { bf16x8 vs0, vs1, ks0, ks1; } sr_[1];
#define SLOADV(i, t) do { const int ka_ = KEYC(kt0 + (t) * 64 + sr), kb_ = KEYC(kt0 + (t) * 64 + 32 + sr); \
    sr_[i].vs0 = *reinterpret_cast<const bf16x8*>(A.V + (size_t)ka_ * LDK + sc); sr_[i].vs1 = *reinterpret_cast<const bf16x8*>(A.V + (size_t)kb_ * LDK + sc); } while (0)
#define SLOADK(i, t) do { const int ka_ = KEYC(kt0 + (t) * 64 + sr), kb_ = KEYC(kt0 + (t) * 64 + 32 + sr); \
    sr_[i].ks0 = *reinterpret_cast<const bf16x8*>(A.K + (size_t)ka_ * LDK + sc); sr_[i].ks1 = *reinterpret_cast<const bf16x8*>(A.K + (size_t)kb_ * LDK + sc); } while (0)
  SLOADV(0, 0); SLOADK(0, 0);
  int* posl = (int*)(ring + D_POS); float* tb = (float*)(extra + X_TB); int* tmm = (int*)(extra + X_TMM); float* tbm = (float*)(extra + X_TBM); int* flg = (int*)(extra + X_FLG);
  if (tid < 2 * NREL + 1) tb[tid] = A.relb[t5_bucket(tid - NREL) * NH + A.h] * LOG2E;
  if constexpr (MODE == M_WIN)
#pragma unroll
  for (int i = tid; i < 2 * TBM_OFF + 1; i += 512) { const int dd = i - TBM_OFF, dc = dd < -NREL ? -NREL : (dd > NREL ? NREL : dd); float v = A.relb[t5_bucket(dc) * NH + A.h] * LOG2E;
    if (MODE == M_WIN) { if (dd < -128 || dd > 128) v = -INFINITY; } tbm[i] = v; }
  bool ok_ = false;
  if constexpr (MODE == M_DIFF) {
    { const i32x4 a = *reinterpret_cast<const i32x4*>(A.posb + tid * 8), b = *reinterpret_cast<const i32x4*>(A.posb + tid * 8 + 4);
      *reinterpret_cast<i32x4*>(posl + tid * 8) = a; *reinterpret_cast<i32x4*>(posl + tid * 8 + 4) = b;
    int mn = min(min(min(a[0], a[1]), min(a[2], a[3])), min(min(b[0], b[1]), min(b[2], b[3]))), mx = max(max(max(a[0], a[1]), max(a[2], a[3])), max(max(b[0], b[1]), max(b[2], b[3])));
      mn = min(mn, xor_i<1>(mn)); mx = max(mx, xor_i<1>(mx)); mn = min(mn, xor_i<2>(mn)); mx = max(mx, xor_i<2>(mx)); mn = min(mn, xor_i<4>(mn)); mx = max(mx, xor_i<4>(mx));
      if ((tid & 7) == 0) { tmm[2 * (tid >> 3)] = mn; tmm[2 * (tid >> 3) + 1] = mx; } }
  } else { const int k_ = kt0 + tid; const int p_ = A.posb[KEYC(k_)]; posl[tid] = p_;
    ok_ = (k_ < 0 || k_ + 1 >= SEQ || tid == 511) ? true : (A.posb[k_ + 1] - p_ == 1); }
  if constexpr (MODE == M_WIN) { const bool w_ = __all(ok_); if (lane == 0) flg[wid] = w_ ? 1 : 0; }
  bf16x8 qr[ND0];
  { const bf16* Qw = A.Q + (size_t)(wq * 32 + r32) * A.ldq + half * 64 + hi * 8;
#pragma unroll
    for (int d0 = 0; d0 < ND0; ++d0) qr[d0] = *reinterpret_cast<const bf16x8*>(Qw + d0 * 16); }
  const int qpos = A.posb[A.q0 + wq * 32 + r32]; int qmin = 0, qmax = 0;
  if constexpr (MODE == M_DIFF) { int a = qpos, b = qpos;
    a = min(a, xor_i<1>(a)); b = max(b, xor_i<1>(b)); a = min(a, xor_i<2>(a)); b = max(b, xor_i<2>(b)); a = min(a, xor_i<4>(a)); b = max(b, xor_i<4>(b));
    a = min(a, xor_i<8>(a)); b = max(b, xor_i<8>(b)); a = min(a, xor_i<16>(a)); b = max(b, xor_i<16>(b));
    { auto ra = __builtin_amdgcn_permlane32_swap((unsigned)a, (unsigned)a, false, false); a = min((int)ra[0], (int)ra[1]); auto rb = __builtin_amdgcn_permlane32_swap((unsigned)b, (unsigned)b, false, false); b = max((int)rb[0], (int)rb[1]); }
    qmin = __builtin_amdgcn_readfirstlane(a); qmax = __builtin_amdgcn_readfirstlane(b); }
  const int kcolB = half * 128;
  float l_reg = 0.f; f32x16 o[4];
#pragma unroll
  for (int d = 0; d < 4; ++d)
#pragma unroll
    for (int r = 0; r < 16; ++r) o[d][r] = 0.f;
  const lds_cptr ring3 = (lds_cptr)ring;
  const lds_cptr vp0 = ring3 + v_rd_base(lane);
  const lds_cptr kp0 = ring3 + SHM_V + r32 * 256;
  const int kx0 = (kcolB + hi * 16) ^ ((r32 & 15) << 4);
#define SWRITEV(so, i) do { char* v_ = ring + (so); *(bf16x8*)(v_ + vst0) = sr_[i].vs0; *(bf16x8*)(v_ + vst1) = sr_[i].vs1; } while (0)
#define SWRITEK(so, i) do { char* k_ = ring + (so) + SHM_V; const int kc_ = sc * 2; *(bf16x8*)(k_ + KSWZ(sr, kc_)) = sr_[i].ks0; *(bf16x8*)(k_ + KSWZ(32 + sr, kc_)) = sr_[i].ks1; } while (0)
#define TILE_SETUP(t, CI, NEAR) do { NEAR = true; CI = 0.f; if constexpr (MODE == M_DIFF) { const int kmn_ = __builtin_amdgcn_readfirstlane(tmm[2 * (t)]), kmx_ = __builtin_amdgcn_readfirstlane(tmm[2 * (t) + 1]); \
    if (kmn_ - qmax >= NREL) { CI = cfar_pos; NEAR = false; } else if (kmx_ - qmin <= -NREL) { CI = cfar_neg; NEAR = false; } } } while (0)
#define RESC(CI) do { if constexpr (MODE == M_DIFF) if ((CI) != ccur) { const float f_ = __builtin_amdgcn_exp2f(ccur - (CI)); ccur = (CI); l_reg *= f_; \
      _Pragma("unroll") for (int d_ = 0; d_ < 4; ++d_) _Pragma("unroll") for (int r_ = 0; r_ < 16; ++r_) o[d_][r_] *= f_; } } while (0)
#define BIAS(C0, C1, t, NEAR) do { const int k0_ = kt0 + (t) * 64; \
    if (contig && k0_ >= 0 && k0_ < SEQ) { add_bias_fast(C0, C1, tbq + (t) * 64); } \
    else { if (NEAR) add_bias(C0, C1, posl + (t) * 64, tb, qpos, hi); \
      if constexpr (MODE == M_WIN) { win_mask(C0, C1, (k0_ < 0 || k0_ >= SEQ) ? 100000 : k0_ - (A.q0 + wq * 32 + r32) + 4 * hi); } } } while (0)
#define ROT() do { const int t_ = s_prev; s_prev = s_cur; s_cur = s_next; s_next = t_; } while (0)
#define KFRAG(SO, i) (*reinterpret_cast<const __attribute__((address_space(3))) bf16x8*>(kp0 + (SO) + ((i) & 1) * 8192 + (kx0 ^ (((i) >> 1) * 32))))
#define MF(a, b, c) __builtin_amdgcn_mfma_f32_32x32x16_bf16(a, b, c, 0, 0, 0)
#define PK4A(P, B) const unsigned a0_ = cvtpk(P[B + 0], P[B + 1]), a1_ = cvtpk(P[B + 2], P[B + 3])
#define PK4B(P, B, OUT) do { const unsigned b0_ = cvtpk(P[B + 4], P[B + 5]), b1_ = cvtpk(P[B + 6], P[B + 7]); u32x4 w_ = {a0_, a1_, b0_, b1_}; OUT = *reinterpret_cast<bf16x8*>(&w_); } while (0)
#define KR(i) (*((i) % 4 == 0 ? &ka_ : (i) % 4 == 1 ? &kb_ : (i) % 4 == 2 ? &kc_ : &kd_))
#define XS_N(s, C0, C1, SO) do { if (2 * (s) + 3 < NF) KR(2 * (s) + 3) = KFRAG(SO, 2 * (s) + 3); C0 = MF(KR(2 * (s)), qr[s], (s) == 0 ? z_ : C0); SBAR(); \
    if (2 * (s) + 4 < NF) KR(2 * (s) + 4) = KFRAG(SO, 2 * (s) + 4); C1 = MF(KR(2 * (s) + 1), qr[s], (s) == 0 ? z_ : C1); SBAR(); } while (0)
#define XS_F(s, C0, C1, SO, P, B, OUT) do { if (2 * (s) + 3 < NF) KR(2 * (s) + 3) = KFRAG(SO, 2 * (s) + 3); C0 = MF(KR(2 * (s)), qr[s], (s) == 0 ? z_ : C0); PK4A(P, B); SBAR(); \
    if (2 * (s) + 4 < NF) KR(2 * (s) + 4) = KFRAG(SO, 2 * (s) + 4); C1 = MF(KR(2 * (s) + 1), qr[s], (s) == 0 ? z_ : C1); PK4B(P, B, OUT); SBAR(); } while (0)
#define XPART(C0, C1, P0, P1, SO, FIN) do { const f32x16 z_ = {}; bf16x8 ka_ = KFRAG(SO, 0), kb_ = KFRAG(SO, 1), kc_ = KFRAG(SO, 2), kd_; SBAR(); \
    if constexpr (MODE == M_DIFF) { \
      if (FIN) { XS_F(0, C0, C1, SO, P0, 0, pa0); XS_F(1, C0, C1, SO, P0, 8, pa1); XS_F(2, C0, C1, SO, P1, 0, pa2); XS_F(3, C0, C1, SO, P1, 8, pa3); } \
      else { XS_N(0, C0, C1, SO); XS_N(1, C0, C1, SO); XS_N(2, C0, C1, SO); XS_N(3, C0, C1, SO); } \
    } else { \
      if (FIN) { XS_F(0, C0, C1, SO, P0, 0, pa0); XS_N(1, C0, C1, SO); XS_F(2, C0, C1, SO, P0, 8, pa1); XS_N(3, C0, C1, SO); XS_F(4, C0, C1, SO, P1, 0, pa2); XS_N(5, C0, C1, SO); XS_F(6, C0, C1, SO, P1, 8, pa3); XS_N(7, C0, C1, SO); } \
      else { XS_N(0, C0, C1, SO); XS_N(1, C0, C1, SO); XS_N(2, C0, C1, SO); XS_N(3, C0, C1, SO); XS_N(4, C0, C1, SO); XS_N(5, C0, C1, SO); XS_N(6, C0, C1, SO); XS_N(7, C0, C1, SO); } \
    } } while (0)
#define VLO(VP, i) vtr((VP) + v_rd_off((i) >> 2, (i) & 3, 0))
#define VHI(VP, i) vtr((VP) + v_rd_off((i) >> 2, (i) & 3, 1))
#define VPK(L, H) (bf16x8){L[0], L[1], L[2], L[3], H[0], H[1], H[2], H[3]}
#define PAK(i) (((i) & 3) == 0 ? pa0 : ((i) & 3) == 1 ? pa1 : ((i) & 3) == 2 ? pa2 : pa3)
#define FADD(a, b) ({ float r_; asm("v_add_f32_e32 %0, %1, %2" : "=v"(r_) : "v"(a), "v"(b)); r_; })
#define YG(i, C0, C1, VP, DOEXP, EXTRA) do { if ((i) + VD - 1 < 16) { vl_[((i) + VD - 1) % VD] = VLO(VP, (i) + VD - 1); vh_[((i) + VD - 1) % VD] = VHI(VP, (i) + VD - 1); } \
    o[(i) >> 2] = MF(PAK(i), VPK(vl_[(i) % VD], vh_[(i) % VD]), o[(i) >> 2]); \
    if (DOEXP) { C0[i] = __builtin_amdgcn_exp2f(C0[i]); C1[i] = __builtin_amdgcn_exp2f(C1[i]); if ((i) > 0) { sA_ = FADD(sA_, C0[(i) - 1]); sB_ = FADD(sB_, C1[(i) - 1]); } } \
    EXTRA; SBAR(); } while (0)
#define NOP_ do { } while (0)
#define YPART(C0, C1, PSN, SOV, DOEXP, STG) do { const lds_cptr vp_ = vp0 + (SOV); float sA_ = 0.f, sB_ = 0.f; s16x4 vl_[VD], vh_[VD]; \
    _Pragma("unroll") for (int q_ = 0; q_ < VD - 1; ++q_) { vl_[q_] = vtr(vp_ + v_rd_off(q_ >> 2, q_ & 3, 0)); vh_[q_] = vtr(vp_ + v_rd_off(q_ >> 2, q_ & 3, 1)); } SBAR(); \
    YG(0, C0, C1, vp_, DOEXP, NOP_); YG(1, C0, C1, vp_, DOEXP, NOP_); YG(2, C0, C1, vp_, DOEXP, NOP_); YG(3, C0, C1, vp_, DOEXP, NOP_); \
    YG(4, C0, C1, vp_, DOEXP, NOP_); YG(5, C0, C1, vp_, DOEXP, NOP_); YG(6, C0, C1, vp_, DOEXP, NOP_); YG(7, C0, C1, vp_, DOEXP, NOP_); \
    YG(8, C0, C1, vp_, DOEXP, STG(0)); YG(9, C0, C1, vp_, DOEXP, STG(1)); YG(10, C0, C1, vp_, DOEXP, STG(2)); YG(11, C0, C1, vp_, DOEXP, STG(3)); \
    YG(12, C0, C1, vp_, DOEXP, STG(4)); YG(13, C0, C1, vp_, DOEXP, STG(5)); YG(14, C0, C1, vp_, DOEXP, STG(6)); YG(15, C0, C1, vp_, DOEXP, STG(7)); \
    if (DOEXP) { sA_ = FADD(sA_, C0[15]); sB_ = FADD(sB_, C1[15]); PSN = sA_ + sB_; } } while (0)
  f32x16 pA0, pA1, pB0, pB1; bf16x8 pa0, pa1, pa2, pa3; float ciA, ciB, psA = 0.f, psB = 0.f; bool nearA, nearB;
  int ta = 0; if constexpr (MODE == M_WIN) { ta = wq >> 1; asm volatile("" : "+s"(ta)); }
  const int tend = (MODE == M_WIN) ? ta + 6 : NT;
#define STAGE_STEP(t) do { SWRITEV(s_next, 0); SLOADV(0, ((t) + 2 < NT ? (t) + 2 : NT - 1)); SWRITEK(s_next, 0); SLOADK(0, ((t) + 2 < NT ? (t) + 2 : NT - 1)); __syncthreads(); ROT(); } while (0)
  int s_prev = 2 * DSLOT, s_cur = 0, s_next = DSLOT;
  SWRITEV(0, 0); SWRITEK(0, 0); SLOADV(0, 1); SLOADK(0, 1);
  __syncthreads();
  const float cfar_pos = (MODE == M_DIFF) ? tb[2 * NREL] : 0.f, cfar_neg = (MODE == M_DIFF) ? tb[0] : 0.f;
#ifndef PROBE_NOCONTIG
#define PROBE_NOCONTIG 0
#endif
  const bool contig = (MODE == M_WIN) && !PROBE_NOCONTIG && __builtin_amdgcn_readfirstlane(flg[0] & flg[1] & flg[2] & flg[3] & flg[4] & flg[5] & flg[6] & flg[7]) != 0;
  const float* tbq = tbm + (TBM_OFF + kt0 - (A.q0 + wq * 32 + r32) + 4 * hi);
  float ccur = 0.f;
  if constexpr (MODE == M_WIN) { _Pragma("nounroll") for (int t = 0; t < ta; ++t) STAGE_STEP(t); }
  TILE_SETUP(ta, ciA, nearA); XPART(pA0, pA1, pA0, pA1, s_cur, false);
  BIAS(pA0, pA1, ta, nearA);
  exp_half(pA0); exp_half(pA1);
  { float t_ = 0.f;
#pragma unroll
    for (int r = 0; r < 16; ++r) t_ += pA0[r] + pA1[r];
    psA = t_; }
  SWRITEV(s_next, 0); SWRITEK(s_next, 0); SLOADV(0, (ta + 2 < NT ? ta + 2 : NT - 1)); SLOADK(0, (ta + 2 < NT ? ta + 2 : NT - 1)); __syncthreads(); ROT();
#define STG_(SI, TW, TL, k) do { if ((k) == 0) SWRITEV(s_next, SI); if ((k) == 1) SLOADV(SI, TL); if ((k) == 2) SWRITEK(s_next, SI); if ((k) == 3) SLOADK(SI, TL); } while (0)
#define STG_A(k) STG_(0, j + 1, (j + 2 < NT ? j + 2 : NT - 1), k)
#define STG_B(k) STG_(0, j + 2, (j + 3 < NT ? j + 3 : NT - 1), k)
#define STG_N(k) NOP_
  if (ATT_PRIO && wid >= 4) __builtin_amdgcn_s_setprio(1);
  _Pragma("nounroll") for (int j = ta + 1; j + 1 < tend; j += 2) {
    TILE_SETUP(j, ciB, nearB); XPART(pB0, pB1, pA0, pA1, s_cur, true);
    RESC(ciA); l_reg += psA; BIAS(pB0, pB1, j, nearB);
    YPART(pB0, pB1, psB, s_prev, true, STG_A);
    __syncthreads(); ROT();
    TILE_SETUP(j + 1, ciA, nearA); XPART(pA0, pA1, pB0, pB1, s_cur, true);
    RESC(ciB); l_reg += psB; BIAS(pA0, pA1, j + 1, nearA);
    YPART(pA0, pA1, psA, s_prev, true, STG_B);
    __syncthreads(); ROT();
  }
  TILE_SETUP(tend - 1, ciB, nearB); XPART(pB0, pB1, pA0, pA1, s_cur, true);
  RESC(ciA); l_reg += psA; BIAS(pB0, pB1, tend - 1, nearB);
  YPART(pB0, pB1, psB, s_prev, true, STG_N);
  { PK4A(pB0, 0); PK4B(pB0, 0, pa0); } { PK4A(pB0, 8); PK4B(pB0, 8, pa1); } { PK4A(pB1, 0); PK4B(pB1, 0, pa2); } { PK4A(pB1, 8); PK4B(pB1, 8, pa3); }
  RESC(ciB); l_reg += psB;
  YPART(pA0, pA1, psA, s_cur, false, STG_N);
  if constexpr (MODE == M_WIN) { _Pragma("nounroll") for (int t = tend - 1; t < NT; ++t) STAGE_STEP(t); }
  if (ATT_PRIO && wid >= 4) __builtin_amdgcn_s_setprio(0);
  attn_epilogue<MODE>(o, l_reg, A, ring, extra);
  asm volatile("s_waitcnt lgkmcnt(0)" ::: "memory");
  __syncthreads();
#undef KEYC
#undef BIAS
#undef KR
#undef XS_N
#undef XS_F
#undef SLOADV
#undef SLOADK
#undef SWRITEV
#undef SWRITEK
#undef TILE_SETUP
#undef STAGE_STEP
#undef RESC
#undef ROT
#undef KFRAG
#undef MF
#undef PK4A
#undef PK4B
#undef XPART
#undef VLO
#undef VHI
#undef VPK
#undef PAK
#undef YG
#undef FADD
#undef NOP_
#undef YPART
#undef STG_
#undef STG_A
#undef STG_B
#undef STG_N
}
template <int MODE>
__device__ __forceinline__ void attn_unit_simple(char* ring, char* extra, const UnitArgs& A) {
  constexpr int ND0 = 8, LDK = (MODE == M_WIN) ? INB : 512;
  int NT = (MODE == M_WIN) ? 8 : MEML / 64; asm volatile("" : "+s"(NT));
  int tid = threadIdx.x; asm volatile("" : "+v"(tid));
  const int wid = __builtin_amdgcn_readfirstlane(tid >> 6), lane = tid & 63, r32 = lane & 31, hi = lane >> 5;
  const int wq = wid;
  char* V_lds = ring + L_V; char* K_lds = ring + L_K;
  int* posl = (int*)(extra + X_POS); float* tb = (float*)(extra + X_TB);
  const int kt0 = (MODE == M_WIN) ? A.q0 - 128 : 0;
#define KEYC(k) ((MODE == M_WIN) ? ((k) < 0 ? 0 : ((k) > SEQ - 1 ? SEQ - 1 : (k))) : (k))
  if (MODE == M_WIN) { if (tid < 2 * NREL + 1) tb[tid] = A.relb[t5_bucket(tid - NREL) * NH + A.h] * LOG2E; posl[tid] = A.posb[KEYC(kt0 + tid)]; }
  bf16x8 qr[ND0];
  { const bf16* Qw = A.Q + (size_t)(wq * 32 + r32) * A.ldq + hi * 8;
#pragma unroll
    for (int d0 = 0; d0 < ND0; ++d0) qr[d0] = *reinterpret_cast<const bf16x8*>(Qw + d0 * 16); }
  int qpos = 0; if (MODE == M_WIN) qpos = A.posb[A.q0 + wq * 32 + r32];
  float l_reg = 0.f; f32x16 o[4];
#pragma unroll
  for (int d = 0; d < 4; ++d)
#pragma unroll
    for (int r = 0; r < 16; ++r) o[d][r] = 0.f;
  const int sr = tid >> 4, sc = (tid & 15) * 8, vst0 = v_st(sr, sc), vst1 = v_st(32 + sr, sc);
  const int vb0 = (int)(uintptr_t)V_lds + v_rd_base(lane);
  bf16x8 vs0, vs1, ks0, ks1;
#define SLOAD(t) do { const int k0_ = kt0 + (t) * 64; const int ka_ = KEYC(k0_ + sr), kb_ = KEYC(k0_ + 32 + sr); \
    vs0 = *reinterpret_cast<const bf16x8*>(A.V + (size_t)ka_ * LDK + sc); vs1 = *reinterpret_cast<const bf16x8*>(A.V + (size_t)kb_ * LDK + sc); \
    ks0 = *reinterpret_cast<const bf16x8*>(A.K + (size_t)ka_ * LDK + sc); ks1 = *reinterpret_cast<const bf16x8*>(A.K + (size_t)kb_ * LDK + sc); } while (0)
#define SWRITE(b) do { *(bf16x8*)(V_lds + (b) * SHM_V + vst0) = vs0; *(bf16x8*)(V_lds + (b) * SHM_V + vst1) = vs1; const int kc_ = sc * 2; \
    *(bf16x8*)(K_lds + (b) * SHM_K + KSWZ(sr, kc_)) = ks0; *(bf16x8*)(K_lds + (b) * SHM_K + KSWZ(32 + sr, kc_)) = ks1; } while (0)
  SLOAD(0); SWRITE(0); __syncthreads();
  _Pragma("nounroll") for (int t = 0; t < NT; ++t) {
    const int b = t & 1;
    if (t + 1 < NT) SLOAD(t + 1);
    f32x16 p0, p1; bf16x8 pa0, pa1, pa2, pa3;
    qkt<ND0>(p0, p1, K_lds + b * SHM_K, qr, r32, hi, 0);
    if (MODE == M_WIN) { add_bias(p0, p1, posl + t * 64, tb, qpos, hi);
      const int k0_ = kt0 + t * 64; const int dq = (k0_ < 0 || k0_ >= SEQ) ? 100000 : k0_ - (A.q0 + wq * 32 + r32) + 4 * hi; win_mask(p0, p1, dq); }
    exp_half(p0); finishSM(p0, p1, l_reg, pa0, pa1, pa2, pa3); SBAR();
    pv_d0(o, vb0 + b * SHM_V, pa0, pa1, pa2, pa3);
    if (t + 1 < NT) SWRITE(b ^ 1);
    __syncthreads();
  }
  attn_epilogue<MODE>(o, l_reg, A, ring, extra);
  asm volatile("s_waitcnt lgkmcnt(0)" ::: "memory");
  __syncthreads();
#undef KEYC
#undef SLOAD
#undef SWRITE
}
#undef KSWZ
#undef SBAR
}
__device__ __forceinline__ int panel_of(int c) { return 4 * (c % 8) + (c / 8) % 4; }
__device__ __forceinline__ bool panel_same_xcd(gu32* ctl) {
    const int c = (int)blockIdx.x; bool same = true; const unsigned mine = xb_ld((unsigned*)(ctl + CW_XCC + c));
#pragma unroll
    for (int m = 0; m < 8; ++m) { const unsigned o = xb_ld((unsigned*)(ctl + CW_XCC + (c % 8) + 8 * ((c / 8) % 4 + 4 * m))); same = same && (o == mine) && (o != 0u); }
    return __builtin_amdgcn_readfirstlane(same ? 1 : 0) != 0;
}
__device__ __forceinline__ void panel_barrier(gu32* ctl, unsigned target, bool same_xcd) {
    asm volatile("s_waitcnt vmcnt(0)" ::: "memory");
    __syncthreads();
    if (threadIdx.x == 0) {
        unsigned* cnt = (unsigned*)(ctl + CW_PANEL + 64 * panel_of((int)blockIdx.x));
        if (same_xcd) {
            asm volatile("buffer_inv sc1" ::: "memory");
            (void)xb_add(cnt, 1u);
            unsigned sp = 0;
            while (xb_ld(cnt) < target) { __builtin_amdgcn_s_sleep(1); if (++sp > (1u << 22)) break; }
            asm volatile("s_waitcnt vmcnt(0)" ::: "memory");
        } else {
            __builtin_amdgcn_fence(__ATOMIC_RELEASE, "agent");
            asm volatile("s_waitcnt vmcnt(0)" ::: "memory");
            (void)xb_add(cnt, 1u);
            unsigned sp = 0;
            while (xb_ld(cnt) < target) { __builtin_amdgcn_s_sleep(1); if (++sp > (1u << 22)) break; }
            __builtin_amdgcn_fence(__ATOMIC_ACQUIRE, "agent");
            asm volatile("s_waitcnt vmcnt(0)" ::: "memory");
        }
    }
    __syncthreads();
}


__device__ __forceinline__ void mem_units(Frame& F, int layer, int ldq, int qm_col, int cu_off, int xl = 0) {
    char* ring = (char*)F.ldsg + RING_OFF; char* extra = (char*)F.ldsg + EXTRA_OFF;
    const bf16* proj = (const bf16*)(F.ws + WS_PROJ); bf16* heads = (bf16*)(F.ws + WS_HEADS);
#ifndef REP_MEM
#define REP_MEM 1
#endif
    const int pc_ = panel_of((int)blockIdx.x), mm_ = (int)blockIdx.x / 32;
    for (int uu = xl ? (mm_ >= 4 ? 0 : REP_MEM * NB * NMH * (SEQ / 256)) : (F.vcu + F.G - cu_off % F.G) % F.G; uu < REP_MEM * NB * NMH * (SEQ / 256); uu += xl ? REP_MEM * NB * NMH * (SEQ / 256) : F.G) { const int u = uu % (NB * NMH * (SEQ / 256));
        int qb = u % (SEQ / 256), bh = u / (SEQ / 256), b = bh / NMH, hm = bh % NMH; if (xl) { b = pc_ / (SEQ / 256); qb = pc_ % (SEQ / 256); hm = mm_ - 4; } const size_t tok0 = (size_t)b * SEQ + qb * 256;
        att::UnitArgs A{};
        A.Q = proj + tok0 * ldq + qm_col + hm * 128; A.ldq = ldq;
        A.K = (const bf16*)(F.ws + WS_KM) + (size_t)(layer * MEMR + b * MEML) * 512 + hm * 128; A.V = (const bf16*)(F.ws + WS_VM) + (size_t)(layer * MEMR + b * MEML) * 512 + hm * 128;
        A.O = heads + tok0 * DM + MIXW + hm * 128; A.posb = nullptr; A.relb = nullptr; A.h = 0; A.q0 = qb * 256; A.sinkl2 = 0.f; A.lam = 0.f; A.subln = nullptr;
        att::attn_unit_simple<att::M_MEM>(ring, extra, A);
    }
}
__device__ __forceinline__ void phase_attn_a(Frame& F) {
    char* ring = (char*)F.ldsg + RING_OFF; char* extra = (char*)F.ldsg + EXTRA_OFF;
    const bf16* proj = (const bf16*)(F.ws + WS_PROJ); bf16* heads = (bf16*)(F.ws + WS_HEADS);
    {
        float lam; { const float a = wave_sum(F.in[10][cur_lane()] * F.in[11][cur_lane()]), b = wave_sum(F.in[12][cur_lane()] * F.in[13][cur_lane()]); lam = expf(a) - expf(b) + LAM_INIT0; }
#ifndef REP_DIFF
#define REP_DIFF 1
#endif
        const int pc_ = panel_of((int)blockIdx.x), mm_ = (int)blockIdx.x / 32, nU_ = REP_DIFF * NB * NH * (SEQ / 128);
        for (int uu = F.xl ? 0 : F.vcu; uu < nU_; uu += F.xl ? nU_ / 3 : F.G) { const int u = uu % (NB * NH * (SEQ / 128));
            int qb = u % (SEQ / 128), bh = u / (SEQ / 128), b = bh / NH, h = bh % NH; if (F.xl) { b = pc_ / (SEQ / 256); qb = 2 * (pc_ % (SEQ / 256)) + (mm_ >> 2); h = (mm_ & 3) + 4 * (uu / (nU_ / 3)); }
            const size_t tok0 = (size_t)b * SEQ + qb * 128;
            att::UnitArgs A{};
            A.Q = proj + tok0 * INA + h * 128; A.ldq = INA;
            A.K = proj + (size_t)b * SEQ * INA + A_K + h * 128; A.V = proj + (size_t)b * SEQ * INA + A_V + h * 128;
            A.O = heads + tok0 * DM + h * 128; A.posb = (const int*)F.in[2] + b * SEQ; A.relb = F.in[3]; A.h = h; A.q0 = qb * 128;
            A.sinkl2 = 0.f; A.lam = lam; A.subln = F.in[14];
            att::attn_unit_pipe<att::M_DIFF>(ring, extra, A);
        }
    }
    mem_units(F, 0, INA, A_QM, (NB * NH * (SEQ / 128)) % F.G, F.xl);
    if (F.G == 256 && (F.xl ? (int)blockIdx.x < 128 : F.vcu >= 128)) { convert_weights<CONV_P0>(F, (F.xl ? (int)blockIdx.x : F.vcu - 128) * NWAVES + F.wave, 128 * NWAVES, CONV_P2_ITEMS, 0);
        if (F.xl) { asm volatile("s_waitcnt vmcnt(0)" ::: "memory"); __syncthreads();
            if (threadIdx.x == 0) { __builtin_amdgcn_fence(__ATOMIC_RELEASE, "agent"); asm volatile("s_waitcnt vmcnt(0)" ::: "memory"); (void)xb_add((unsigned*)(F.ctl + CW_CONVDONE), 1u); } } }
}
__device__ __forceinline__ void phase_attn_b(Frame& F) {
    char* ring = (char*)F.ldsg + RING_OFF; char* extra = (char*)F.ldsg + EXTRA_OFF;
    const bf16* proj = (const bf16*)(F.ws + WS_PROJ); bf16* heads = (bf16*)(F.ws + WS_HEADS);
    {
#ifndef REP_WIN
#define REP_WIN 1
#endif
        const int pc_ = panel_of((int)blockIdx.x), mm_ = (int)blockIdx.x / 32, nU_ = REP_WIN * NB * NH * (SEQ / 256);
        for (int uu = F.xl ? (mm_ < 4 ? 0 : nU_ / 2) : F.vcu; uu < nU_; uu += F.xl ? nU_ / 2 : F.G) { const int u = uu % (NB * NH * (SEQ / 256));
            int qb = u % (SEQ / 256), bh = u / (SEQ / 256), b = bh / NH, h = bh % NH; if (F.xl) { b = pc_ / (SEQ / 256); qb = pc_ % (SEQ / 256); h = mm_ + (uu == 0 ? 8 : 0); }
            const int kvh = h / 3; const size_t tok0 = (size_t)b * SEQ + qb * 256;
            att::UnitArgs A{};
            A.Q = proj + tok0 * INB + h * 128; A.ldq = INB;
            A.K = proj + (size_t)b * SEQ * INB + B_K + kvh * 128; A.V = proj + (size_t)b * SEQ * INB + B_V + kvh * 128;
            A.O = heads + tok0 * DM + h * 128; A.posb = (const int*)F.in[2] + b * SEQ; A.relb = F.in[3]; A.h = h; A.q0 = qb * 256;
            A.sinkl2 = F.in[18][h] * LOG2E; A.lam = 0.f; A.subln = nullptr;
            att::attn_unit_pipe<att::M_WIN>(ring, extra, A);
        }
    }
    mem_units(F, 1, INB, B_QM, (NB * NH * (SEQ / 256)) % F.G, F.xl);
    if (F.G == 256 && F.vcu >= 128) convert_weights<CONV_P6>(F, (F.vcu - 128) * NWAVES + F.wave, 128 * NWAVES, CONV_P7_ITEMS, 0);
}

struct Args { const float* in[25]; float* out; unsigned char* ws; int ph_lo, ph_hi, li, pad; };
__global__ void __launch_bounds__(NWAVES * 64, 2) mk_fwd(Args args) {
    extern __shared__ __attribute__((aligned(16))) unsigned char lds[];
    Frame F;
    F.lds = (LAS unsigned char*)lds; F.ldsg = lds;
    F.MISC = (volatile LAS unsigned*)(F.lds + MISC_OFF);
    F.wave = __builtin_amdgcn_readfirstlane((int)threadIdx.x >> 6);
    F.G = gridDim.x; { const int bx = blockIdx.x; F.vcu = (F.G % 8 == 0) ? (bx % 8) * (F.G / 8) + bx / 8 : bx; }
    F.ws = args.ws; F.out = args.out; F.ctl = (gu32*)(args.ws + WS_CTL);
#pragma unroll
    for (int i = 0; i < 25; ++i) F.in[i] = args.in[i];
    for (int u = (F.wave * 64 + cur_lane()); u < (LDS_BYTES - LDSCTL_OFF) / 4; u += NWAVES * 64) ((LAS unsigned*)(F.lds + LDSCTL_OFF))[u] = 0u;
    if (threadIdx.x == 0 && blockIdx.x < 256) __hip_atomic_store((unsigned*)(F.ctl + CW_XCC + blockIdx.x), 1u + xb_xcc_id(), __ATOMIC_RELAXED, __HIP_MEMORY_SCOPE_AGENT);
    __syncthreads();
    const bool single = (args.ph_hi - args.ph_lo) > 1;
    XcdBarrier bar; bar.bar = (unsigned*)(F.ctl + CW_BAR); bar.x = 0; bar.st = nullptr;
    if (single) bar = xcd_barrier_post((unsigned*)(F.ctl + CW_BAR), F.MISC + 8);
    const int lo = args.ph_lo, hi = args.ph_hi;
#define IN(k) (lo <= (k) && (k) < hi)
#ifndef REP_PHASE
#define REP_PHASE -1
#endif
#define REPS(k) for (int rep_ = 0; rep_ < ((REP_PHASE) == (k) ? 2 : 1); ++rep_)
#ifndef PROBE_PHASE
#define PROBE_PHASE -1
#endif
    unsigned long long tpa_ = 0, tpb_ = 0;
#ifndef PROBE_CLK
#define PROBE_CLK 0
#endif
    unsigned long long tca_ = 0, tcb_ = 0;
#define TP_A(k) do { if ((PROBE_PHASE) == (k)) { tpa_ = rt(); if (PROBE_CLK) tca_ = __builtin_amdgcn_s_memtime(); } } while (0)
#define TP_B(k) do { if ((PROBE_PHASE) == (k)) { tpb_ = rt(); if (PROBE_CLK) tcb_ = __builtin_amdgcn_s_memtime(); } } while (0)
#ifndef UP_ALIGN
#define UP_ALIGN true
#endif
#ifndef PROBE_2BAR
#define PROBE_2BAR 0
#endif
#define SEAM(k) do { if (IN(k) && IN((k) + 1)) { xcd_barrier(bar); if (PROBE_2BAR) xcd_barrier(bar); } } while (0)
#ifndef PANEL_SEAMS
#define PANEL_SEAMS 1
#endif
#define PSEAM(k, target) do { if (IN(k) && IN((k) + 1)) { if (XL) panel_barrier(F.ctl, target, same_xcd); else xcd_barrier(bar); } } while (0)
    bf16* const XB = (bf16*)(F.ws + WS_HN);
    bf16* const PROJ = (bf16*)(F.ws + WS_PROJ); bf16* const HEADS = (bf16*)(F.ws + WS_HEADS); bf16* const U = (bf16*)(F.ws + WS_U);
    bf16* const WA = (bf16*)(F.ws + WS_WA); bf16* const WB = (bf16*)(F.ws + WS_WB); bf16* const WM = (bf16*)(F.ws + WS_WMKV);
    bf16* const WO = (bf16*)(F.ws + WS_WOUT); bf16* const WU = (bf16*)(F.ws + WS_WUP); bf16* const WD = (bf16*)(F.ws + WS_WDN);

    float* const RSQ_X = (float*)(F.ctl + CW_RSQ_X); float* const RSQ_M = (float*)(F.ctl + CW_RSQ_M);
    float* const RSQ_MLP0 = (float*)(F.ctl + CW_RSQ_MLP0); float* const RSQ_ATT1 = (float*)(F.ctl + CW_RSQ_ATT1); float* const RSQ_MLP1 = (float*)(F.ctl + CW_RSQ_MLP1);
    LAS float* const XB_LDS = (LAS float*)(F.lds + EXTRA_OFF);
    LAS float* const XG = (LAS float*)(F.lds + EXTRA_OFF + 8192);
    constexpr float INVK = 1.f / DM;
    const int XL = (PANEL_SEAMS && F.G == 256 && single && lo == 0) ? 1 : 0; F.xl = XL;
    TP_A(0); if (IN(0)) REPS(0) { p0_prologue(F); } SEAM(0); TP_B(0);
#ifndef PROBE_FORCE_NOTSAME
#define PROBE_FORCE_NOTSAME 0
#endif
    const bool same_xcd = (XL && !PROBE_FORCE_NOTSAME) ? panel_same_xcd(F.ctl) : false;
    TP_A(1); if (IN(1)) REPS(1) {
        const int ncu = F.G >= 256 ? GEMM_CUS_P1 : F.G;
        if ((int)blockIdx.x >= ncu) { convert_weights<CONV_P1, CONV_DEPTH>(F, ((int)blockIdx.x - ncu) * NWAVES + F.wave, (F.G - ncu) * NWAVES, -1, CONV_P1_BACK_ITEMS);
                                      if (CONV_P1Y_ITEMS > 0) convert_weights<CONV_P0, CONV_DEPTH>(F, ((int)blockIdx.x - ncu) * NWAVES + F.wave, (F.G - ncu) * NWAVES, CONV_P2_ITEMS + CONV_P1X_ITEMS + CONV_P1Y_ITEMS, CONV_P2_ITEMS + CONV_P1X_ITEMS);
                                      } else {
        pg8::Gemm g{XB, WA, NTOK, INA, DM}; pg8::ComboOrder S; S.init(NTOK, INA, ncu, (int)blockIdx.x); S.A2 = (const bf16*)(F.ws + WS_MN); S.B2 = WM; S.nx = 16;
        if ((F.wave * 64 + cur_lane()) < 128) { const int t = (F.wave * 64 + cur_lane()); XG[t] = F.in[8][t & 63]; XG[128 + t] = F.in[9][t & 63]; XG[256 + t] = 1.f; XG[384 + t] = F.in[20][t]; XG[512 + t] = F.in[21][t]; XG[640 + t] = F.in[21][128 + t]; }
        __syncthreads();
        pg8::EpiProj<0> E{PROJ, INA, RSQ_X, INVK, (bf16*)(F.ws + WS_KM), (bf16*)(F.ws + WS_VM), RSQ_M, XB_LDS, XG, QS64, QS128};
        pg8::gemm_phase<pg8::EpiProj<0>, pg8::ComboOrder, true, true>(F.lds + RING_OFF, g, S, E);
        { const int nu = (NTOK / 256) * (INA / 256) + 16, nfull = nu % ncu;
          if (F.G >= 256 && CONV_P1X_ITEMS > 0 && nfull > 0 && (int)blockIdx.x >= nfull) { asm volatile("s_waitcnt vmcnt(0)" ::: "memory"); __syncthreads();
              convert_weights<CONV_P0>(F, ((int)blockIdx.x - nfull) * NWAVES + F.wave, (ncu - nfull) * NWAVES, CONV_P2_ITEMS + CONV_P1X_ITEMS, CONV_P2_ITEMS); } } }
        if (F.G < 256) convert_weights<CONV_P1>(F, F.vcu * NWAVES + F.wave, F.G * NWAVES);
    } SEAM(1); TP_B(1);
    TP_A(2); if (IN(2)) REPS(2) { phase_attn_a(F); } PSEAM(2, 8u); TP_B(2);
    TP_A(3); if (IN(3)) REPS(3) {
        pg8::Gemm g{HEADS, WO, NTOK, DM, DM}; pg8::StaticOrder S; S.init(NTOK, DM, F.G, (int)blockIdx.x, XL);
        pg8::EpiRes<false, false> E{XB, XB, DM, RSQ_MLP0};
        pg8::gemm_phase<pg8::EpiRes<false, false>, pg8::StaticOrder, false, true>(F.lds + RING_OFF, g, S, E);
    } PSEAM(3, 16u); TP_B(3);
    TP_A(4); if (IN(4)) REPS(4) {
        pg8::Gemm g{XB, WU, NTOK, DFF, DM}; pg8::StaticOrder S; S.init(NTOK, DFF, F.G, (int)blockIdx.x, XL);
        pg8::EpiUp E{U, DFF, RSQ_MLP0, INVK};
        pg8::gemm_phase<pg8::EpiUp, pg8::StaticOrder, UP_ALIGN, true>(F.lds + RING_OFF, g, S, E);
    }
    if (XL && IN(4) && IN(5) && threadIdx.x == 0) {
        unsigned sp = 0; while (xb_ld((unsigned*)(F.ctl + CW_CONVDONE)) < 128u) { __builtin_amdgcn_s_sleep(1); if (++sp > (1u << 22)) break; } }
    PSEAM(4, 24u); TP_B(4);
    TP_A(5); if (IN(5)) REPS(5) {
        pg8::Gemm g{U, WD, NTOK, DM, DFF}; pg8::StaticOrder S; S.init(NTOK, DM, F.G, (int)blockIdx.x, XL);
        pg8::EpiRes<false, false> E{XB, XB, DM, RSQ_ATT1};
        pg8::gemm_phase<pg8::EpiRes<false, false>, pg8::StaticOrder, false, true>(F.lds + RING_OFF, g, S, E);
    } PSEAM(5, 32u); TP_B(5);
    TP_A(6); if (IN(6)) REPS(6) {
        const int ncu = F.G >= 256 ? GEMM_CUS_P6 : F.G;
        if ((int)blockIdx.x >= ncu) { convert_weights<CONV_P6, CONV_DEPTH>(F, ((int)blockIdx.x - ncu) * NWAVES + F.wave, (F.G - ncu) * NWAVES, -1, F.G == 256 ? CONV_P7_ITEMS : 0); } else {
        pg8::Gemm g{XB, WB, NTOK, INB, DM}; pg8::ComboOrder S; S.init(NTOK, INB, ncu, (int)blockIdx.x, XL); S.A2 = (const bf16*)(F.ws + WS_MN); S.B2 = WM; S.nx = 0;
        if ((F.wave * 64 + cur_lane()) < 128) { const int t = (F.wave * 64 + cur_lane()); XG[t] = F.in[16][t]; XG[128 + t] = F.in[17][t]; XG[256 + t] = 1.f; XG[384 + t] = F.in[20][128 + t]; XG[512 + t] = F.in[21][t]; XG[640 + t] = F.in[21][128 + t]; }
        __syncthreads();
        pg8::EpiProj<1> E{PROJ, INB, RSQ_ATT1, INVK, (bf16*)(F.ws + WS_KM), (bf16*)(F.ws + WS_VM), RSQ_M, XB_LDS, XG, QS64, QS128};
        pg8::gemm_phase<pg8::EpiProj<1>, pg8::ComboOrder, true, true>(F.lds + RING_OFF, g, S, E); }
        if (F.G < 256) convert_weights<CONV_P6>(F, F.vcu * NWAVES + F.wave, F.G * NWAVES);
    } SEAM(6); TP_B(6);
    TP_A(7); if (IN(7)) REPS(7) { phase_attn_b(F); } PSEAM(7, 40u); TP_B(7);
    TP_A(8); if (IN(8)) REPS(8) {
        pg8::Gemm g{HEADS, WO + (size_t)DM * DM, NTOK, DM, DM}; pg8::StaticOrder S; S.init(NTOK, DM, F.G, (int)blockIdx.x, XL);
        pg8::EpiRes<false, false> E{XB, XB, DM, RSQ_MLP1};
        pg8::gemm_phase<pg8::EpiRes<false, false>, pg8::StaticOrder, false, true>(F.lds + RING_OFF, g, S, E);
    } PSEAM(8, 48u); TP_B(8);
    TP_A(9); if (IN(9)) REPS(9) {
        pg8::Gemm g{XB, WU + (size_t)DFF * DM, NTOK, DFF, DM}; pg8::StaticOrder S; S.init(NTOK, DFF, F.G, (int)blockIdx.x, XL);
        pg8::EpiUp E{U, DFF, RSQ_MLP1, INVK};
        pg8::gemm_phase<pg8::EpiUp, pg8::StaticOrder, UP_ALIGN, true>(F.lds + RING_OFF, g, S, E);
    } PSEAM(9, 56u); TP_B(9);
    TP_A(10); if (IN(10)) REPS(10) {
        pg8::Gemm g{U, WD + (size_t)DM * DFF, NTOK, DM, DFF}; pg8::StaticOrder S; S.init(NTOK, DM, F.G, (int)blockIdx.x, XL);
        pg8::EpiRes<false, true> E{XB, F.out, DM, nullptr};
        pg8::gemm_phase<pg8::EpiRes<false, true>, pg8::StaticOrder, false, true>(F.lds + RING_OFF, g, S, E);
    }
    if ((PROBE_PHASE) >= 0) { if ((PROBE_PHASE) == N_PHASES - 1) tpb_ = rt(); if (blockIdx.x == 0) { const unsigned long long t0_ = rt(), d_ = PROBE_CLK ? (tcb_ - tca_) * 1000ull / (tpb_ - tpa_) : 8ull * (tpb_ - tpa_); while (rt() - t0_ < d_) __builtin_amdgcn_s_sleep(8); } }
#ifdef PROBE_EPI
    if (blockIdx.x == 0) { const unsigned long long t0_ = rt(), d_ = 8ull * F.MISC[16]; while (rt() - t0_ < d_) __builtin_amdgcn_s_sleep(8); }
#endif
#undef IN
#undef SEAM
}

#ifndef MK_ONE_LAUNCH
#define MK_ONE_LAUNCH 1
#endif
extern "C" void kernel_launch(void* const* d_in, const int* in_sizes, int n_in, void* d_out, int out_size, void* d_ws, size_t ws_size, hipStream_t stream) {
    static int grid = 0;
    if (grid == 0) {
        if (n_in != 25 || in_sizes[0] != NTOK * DM || out_size != NTOK * DM || ws_size < WS_END) { fprintf(stderr, "kernel_launch: unexpected shapes: n_in %d in0 %d out %d ws %zu (need %zu)\n", n_in, n_in > 0 ? in_sizes[0] : -1, out_size, ws_size, (size_t)WS_END); grid = -1; return; }
        int dev = 0, cus = 0;
        if (hipGetDevice(&dev) != hipSuccess || hipDeviceGetAttribute(&cus, hipDeviceAttributeMultiprocessorCount, dev) != hipSuccess) { fprintf(stderr, "kernel_launch: device query failed\n"); grid = -1; return; }
        if (hipFuncSetAttribute((const void*)mk_fwd, hipFuncAttributeMaxDynamicSharedMemorySize, LDS_BYTES) != hipSuccess) { fprintf(stderr, "kernel_launch: hipFuncSetAttribute failed\n"); grid = -1; return; }
        int per_cu = 0;
        if (hipOccupancyMaxActiveBlocksPerMultiprocessor(&per_cu, (const void*)mk_fwd, NWAVES * 64, LDS_BYTES) != hipSuccess || per_cu < 1) fprintf(stderr, "kernel_launch: note: occupancy query reports %d workgroups per CU\n", per_cu);
        (void)hipGetLastError();
        grid = cus;
    }
    if (grid < 0) return;
    if (hipMemsetAsync((char*)d_ws + WS_CTL, 0, CTL_ZERO_BYTES, stream) != hipSuccess) { fprintf(stderr, "kernel_launch: hipMemsetAsync failed\n"); return; }
    Args a{};
    for (int i = 0; i < 25; ++i) a.in[i] = (const float*)d_in[i];
    a.out = (float*)d_out; a.ws = (unsigned char*)d_ws;
#if MK_ONE_LAUNCH
    a.ph_lo = 0; a.ph_hi = N_PHASES; a.li = 0;
    hipLaunchKernelGGL(mk_fwd, dim3(grid), dim3(NWAVES * 64), LDS_BYTES, stream, a);
#else
    for (int p = 0; p < N_PHASES; ++p) { a.ph_lo = p; a.ph_hi = p + 1; a.li = p; hipLaunchKernelGGL(mk_fwd, dim3(grid), dim3(NWAVES * 64), LDS_BYTES, stream, a); }
#endif
    const hipError_t le = hipPeekAtLastError();
    if (le != hipSuccess) fprintf(stderr, "kernel_launch: launch failed: %s\n", hipGetErrorName(le));
}
```

```cpp
#include <hip/hip_runtime.h>
#include <cstdio>
#include <cstdint>
namespace pg8 {
#define PG8_LAS __attribute__((address_space(3)))
typedef unsigned short bf16_t;
typedef short bf16x8 __attribute__((ext_vector_type(8)));
typedef float f32x4 __attribute__((ext_vector_type(4)));
typedef unsigned u32x4 __attribute__((ext_vector_type(4)));
constexpr int BM = 256, BK = 64, HALF = 128, HTB = HALF * BK * 2  , STAGE_BYTES = 8 * HTB, NXCD = 8, WGM = 8;

__host__ __device__ __forceinline__ int lds_byte(int r, int c) { const int st = (r >> 4) * 2 + (c >> 5), rr = r & 15, cc = c & 31, ob = rr * 64 + cc * 2; return st * 1024 + (ob ^ (((ob >> 9) & 1) << 5)); }
__host__ __device__ __forceinline__ void stage_rc(int b, int& R, int& C) { const int st = b / 1024, sb = b % 1024, swz = sb ^ (((sb >> 9) & 1) << 5); R = (st >> 1) * 16 + swz / 64; C = (st & 1) * 32 + (swz % 64) / 2; }
__host__ __device__ __forceinline__ int perm32(int rho) { const int n = rho >> 4, i = rho & 15; return 8 * (i >> 2) + 4 * n + (i & 3); }

struct Unit { int pm, pn, kind; };
struct Gemm { const bf16_t* A; const bf16_t* Bt; int M, N, K; };

struct StaticOrder {
    int nM, nN, nwg, G, c, xl;
    __host__ __device__ void init(int M, int N, int G_, int c_, int xl_ = 0) { nM = M / BM; nN = N / BM; nwg = nM * nN; G = G_; c = c_; xl = xl_; }
    __host__ __device__ bool next(int i, Unit& u) const {
        const long L = (long)i * G + c; if (L >= nwg) return false;
        int pm, pn;
        if (xl) { const int xcd = (int)L % NXCD, off = (int)L / NXCD, P = nM / NXCD; pm = P * xcd + off % P; pn = off / P; }
        else {
            int wgid = (int)L; { const int q = nwg / NXCD, r = nwg % NXCD, xcd = wgid % NXCD, off = wgid / NXCD; wgid = (xcd < r ? xcd * (q + 1) : r * (q + 1) + (xcd - r) * q) + off; }
            const int nig = WGM * nN, gid = wgid / nig, fm = gid * WGM, gsz = (nM - fm) < WGM ? (nM - fm) : WGM;
            pm = fm + ((wgid % nig) % gsz); pn = (wgid % nig) / gsz; }
        u.pm = pm; u.pn = pn; u.kind = 0; return true;
    }
    __device__ __forceinline__ const char* a_base(const Unit& u, const Gemm& g, size_t tstep) const { return (const char*)g.A + (size_t)u.pm * tstep; }
    __device__ __forceinline__ const char* b_base(const Unit& u, const Gemm& g, size_t tstep) const { return (const char*)g.Bt + (size_t)u.pn * tstep; }
    __device__ __forceinline__ void a_ready(const Unit&) const {}
    __device__ __forceinline__ void done(const Unit&) const {}
};
struct ComboOrder : StaticOrder {
    const bf16_t* A2; const bf16_t* B2; int nx;
    __device__ bool next(int i, Unit& u) const {
        const long L = (long)i * G + c; if (L >= nwg + nx) return false;
        int pm, pn, kind;
        if (L < nwg) { Unit t; StaticOrder::next(i, t); pm = t.pm; pn = t.pn; kind = 0; }
        else { const int e = (int)(L - nwg), r = e & 7; pm = r & 1; pn = r >> 1; kind = 1 + (e >> 3); }
        u.pm = pm; u.pn = pn; u.kind = kind; return true;
    }
    __device__ __forceinline__ const char* a_base(const Unit& u, const Gemm& g, size_t tstep) const { return u.kind == 0 ? (const char*)g.A + (size_t)u.pm * tstep : (const char*)A2 + (size_t)u.pm * tstep; }
    __device__ __forceinline__ const char* b_base(const Unit& u, const Gemm& g, size_t tstep) const { return u.kind == 0 ? (const char*)g.Bt + (size_t)u.pn * tstep : (const char*)B2 + (size_t)((u.kind - 1) * 4 + u.pn) * tstep; }
};


__device__ __forceinline__ float xsum_rows(float v) {
    const auto r = __builtin_amdgcn_permlane16_swap(__float_as_uint(v), __float_as_uint(v), false, false); const float t = __uint_as_float(r[0]) + __uint_as_float(r[1]);
    const auto q = __builtin_amdgcn_permlane32_swap(__float_as_uint(t), __float_as_uint(t), false, false); return __uint_as_float(q[0]) + __uint_as_float(q[1]);
}
__device__ __forceinline__ void rows4(float v, float (&o)[4]) {
    const auto r = __builtin_amdgcn_permlane16_swap(__float_as_uint(v), __float_as_uint(v), false, false);
    const auto p = __builtin_amdgcn_permlane32_swap(r[0], r[0], false, false);
    const auto q = __builtin_amdgcn_permlane32_swap(r[1], r[1], false, false);
    o[0] = __uint_as_float(p[0]); o[1] = __uint_as_float(q[0]); o[2] = __uint_as_float(p[1]); o[3] = __uint_as_float(q[1]);
}
struct PreNone {}; struct PreRows { float a, b; };
__device__ __forceinline__ unsigned cvt_pk_bf16(float lo, float hi) { unsigned r; asm volatile("v_cvt_pk_bf16_f32 %0, %1, %2" : "=v"(r) : "v"(lo), "v"(hi)); return r; }

template <int ACT  > struct EpiBf16 {
    static constexpr bool PERM = true, AFTER_DRAIN = false;
    bf16_t* O; int ldc;
    __device__ __forceinline__ void operator()(const f32x4 (&acc)[2][2][4][2], const Unit& u, int wr, int wc, int fr, int fq) const {
        asm volatile("" : "+v"(fr), "+v"(fq));
        const int row0 = u.pm * BM + wr * 64 + fr; const int col0 = u.pn * BM + wc * 32 + 8 * fq;
#pragma unroll
        for (int ai = 0; ai < 2; ++ai)
#pragma unroll
            for (int m = 0; m < 4; ++m) { bf16_t* rowp = O + (size_t)(row0 + ai * HALF + m * 16) * ldc + col0;
#pragma unroll
                for (int bj = 0; bj < 2; ++bj) { f32x4 v0 = acc[ai][bj][m][0], v1 = acc[ai][bj][m][1];
                    if (ACT == 1) {
#pragma unroll
                        for (int j = 0; j < 4; ++j) { const float a = fmaxf(v0[j], 0.f), b = fmaxf(v1[j], 0.f); v0[j] = a * a; v1[j] = b * b; } }
                    u32x4 w; w.x = cvt_pk_bf16(v0[0], v0[1]); w.y = cvt_pk_bf16(v0[2], v0[3]); w.z = cvt_pk_bf16(v1[0], v1[1]); w.w = cvt_pk_bf16(v1[2], v1[3]);
                    *(u32x4*)(rowp + bj * HALF) = w; } }
    }
};
struct EpiF32 {
    static constexpr bool PERM = false, AFTER_DRAIN = false;
    float* C; int ldc;
    __device__ __forceinline__ void operator()(const f32x4 (&acc)[2][2][4][2], const Unit& u, int wr, int wc, int fr, int fq) const {
        asm volatile("" : "+v"(fr), "+v"(fq));
        const int row0 = u.pm * BM + wr * 64 + fr, col0 = u.pn * BM + wc * 32 + 4 * fq;
#pragma unroll
        for (int ai = 0; ai < 2; ++ai)
#pragma unroll
            for (int m = 0; m < 4; ++m) { float* rowp = C + (size_t)(row0 + ai * HALF + m * 16) * ldc + col0;
#pragma unroll
                for (int bj = 0; bj < 2; ++bj)
#pragma unroll
                    for (int n = 0; n < 2; ++n) *(f32x4*)(rowp + bj * HALF + n * 16) = acc[ai][bj][m][n]; }
    }
};
struct EpiResF32 {
    static constexpr bool PERM = false, AFTER_DRAIN = false;
    const float* base; float* out; int ldc;
    __device__ __forceinline__ void operator()(const f32x4 (&acc)[2][2][4][2], const Unit& u, int wr, int wc, int fr, int fq) const {
        asm volatile("" : "+v"(fr), "+v"(fq));
        const int row0 = u.pm * BM + wr * 64 + fr, col0 = u.pn * BM + wc * 32 + 4 * fq;
#pragma unroll
        for (int ai = 0; ai < 2; ++ai)
#pragma unroll
            for (int m = 0; m < 4; ++m) { const size_t off = (size_t)(row0 + ai * HALF + m * 16) * ldc + col0;
#pragma unroll
                for (int bj = 0; bj < 2; ++bj)
#pragma unroll
                    for (int n = 0; n < 2; ++n) { const f32x4 b = *(const f32x4*)(base + off + bj * HALF + n * 16); *(f32x4*)(out + off + bj * HALF + n * 16) = b + acc[ai][bj][m][n]; } }
    }
};

constexpr float NORM_EPS = 1e-6f;
template <bool BASEF32, bool OUTF32> struct EpiRes {
    static constexpr bool PERM = true, AFTER_DRAIN = false; static constexpr int KIND = OUTF32 ? 3 : 0;
    const void* base; void* out; int ldc; float* rowsq;
    typedef PreNone Pre; __device__ __forceinline__ Pre pre(const Unit&, int, int) const { return Pre{}; }
    __device__ __forceinline__ void operator()(f32x4 (&acc)[2][2][4][2], const Unit& u, int wr, int wc, int fr, int fq, const Pre&) const {
        asm volatile("" : "+v"(fr), "+v"(fq));
        const int row0 = u.pm * BM + wr * 64 + fr, col0 = u.pn * BM + wc * 32 + 8 * fq;
        u32x4 bb[2][4][2];
        if (!BASEF32) {
#pragma unroll
            for (int ai = 0; ai < 2; ++ai)
#pragma unroll
                for (int m = 0; m < 4; ++m)
#pragma unroll
                    for (int bj = 0; bj < 2; ++bj) bb[ai][m][bj] = *(const u32x4*)((const bf16_t*)base + (size_t)(row0 + ai * HALF + m * 16) * ldc + col0 + bj * HALF); }
#pragma unroll
        for (int ai = 0; ai < 2; ++ai)
#pragma unroll
            for (int m = 0; m < 4; ++m) { const int row = row0 + ai * HALF + m * 16; const size_t off = (size_t)row * ldc + col0; float ss = 0.f;
#pragma unroll
                for (int bj = 0; bj < 2; ++bj) { f32x4 v0, v1;
                    if (BASEF32) { v0 = *(const f32x4*)((const float*)base + off + bj * HALF); v1 = *(const f32x4*)((const float*)base + off + bj * HALF + 4); }
                    else { const u32x4 b = bb[ai][m][bj];
                        v0 = (f32x4){__uint_as_float(b.x << 16), __uint_as_float(b.x & 0xffff0000u), __uint_as_float(b.y << 16), __uint_as_float(b.y & 0xffff0000u)};
                        v1 = (f32x4){__uint_as_float(b.z << 16), __uint_as_float(b.z & 0xffff0000u), __uint_as_float(b.w << 16), __uint_as_float(b.w & 0xffff0000u)}; }
                    v0 = v0 + acc[ai][bj][m][0]; v1 = v1 + acc[ai][bj][m][1];
                    if (OUTF32) { *(f32x4*)((float*)out + off + bj * HALF) = v0; *(f32x4*)((float*)out + off + bj * HALF + 4) = v1; }
                    else { ss += (v0[0] * v0[0] + v0[1] * v0[1]) + (v0[2] * v0[2] + v0[3] * v0[3]) + (v1[0] * v1[0] + v1[1] * v1[1]) + (v1[2] * v1[2] + v1[3] * v1[3]);
                        u32x4 w; w.x = cvt_pk_bf16(v0[0], v0[1]); w.y = cvt_pk_bf16(v0[2], v0[3]); w.z = cvt_pk_bf16(v1[0], v1[1]); w.w = cvt_pk_bf16(v1[2], v1[3]);
                        *(u32x4*)((bf16_t*)out + off + bj * HALF) = w; } }
                if (!OUTF32) { ss = xsum_rows(ss);
                    if (fq == 0) __hip_atomic_fetch_add(rowsq + row, ss, __ATOMIC_RELAXED, __HIP_MEMORY_SCOPE_AGENT); } }
    }
};
struct EpiUp {
    static constexpr bool PERM = true, AFTER_DRAIN = false; static constexpr int KIND = 1;
    bf16_t* O; int ldc; const float* rowsq; float invk;
    typedef PreRows Pre;
    __device__ __forceinline__ Pre pre(const Unit& u, int wr, int lane) const { const float* p = rowsq + u.pm * BM + wr * 64 + lane;
        return Pre{__hip_atomic_load(p, __ATOMIC_RELAXED, __HIP_MEMORY_SCOPE_AGENT), __hip_atomic_load(p + HALF, __ATOMIC_RELAXED, __HIP_MEMORY_SCOPE_AGENT)}; }
    __device__ __forceinline__ void operator()(f32x4 (&acc)[2][2][4][2], const Unit& u, int wr, int wc, int fr, int fq, const Pre& pr) const {
        asm volatile("" : "+v"(fr), "+v"(fq));
        const int row0 = u.pm * BM + wr * 64 + fr; const int col0 = u.pn * BM + wc * 32 + 8 * fq;
        float rq[2][4]; rows4(pr.a, rq[0]); rows4(pr.b, rq[1]);
#pragma unroll
        for (int ai = 0; ai < 2; ++ai)
#pragma unroll
            for (int m = 0; m < 4; ++m)
#pragma unroll
                for (int bj = 0; bj < 2; ++bj)
#pragma unroll
                    for (int n = 0; n < 2; ++n)
#pragma unroll
                        for (int j = 0; j < 4; ++j) { const float a = fmaxf(acc[ai][bj][m][n][j], 0.f); acc[ai][bj][m][n][j] = a * a; }
#pragma unroll
        for (int ai = 0; ai < 2; ++ai)
#pragma unroll
            for (int m = 0; m < 4; ++m) { const int row = row0 + ai * HALF + m * 16; bf16_t* rowp = O + (size_t)row * ldc + col0;
                const float rs2 = __builtin_amdgcn_rcpf(rq[ai][m] * invk + NORM_EPS);
#pragma unroll
                for (int bj = 0; bj < 2; ++bj) { f32x4 v0 = acc[ai][bj][m][0] * rs2, v1 = acc[ai][bj][m][1] * rs2;
                    u32x4 w; w.x = cvt_pk_bf16(v0[0], v0[1]); w.y = cvt_pk_bf16(v0[2], v0[3]); w.z = cvt_pk_bf16(v1[0], v1[1]); w.w = cvt_pk_bf16(v1[2], v1[3]);
                    *(u32x4*)(rowp + bj * HALF) = w; } }
    }
};
template <int LAYER> struct EpiProj {
    static constexpr bool PERM = true, AFTER_DRAIN = false; static constexpr int KIND = 2;
    bf16_t* O; int ldc; const float* rowsq; float invk;
    bf16_t* KM; bf16_t* VM; const float* rowsq_m;
    PG8_LAS float* xb; PG8_LAS const float* xg;
    float qs64, qs128;
    typedef PreRows Pre;
    __device__ __forceinline__ Pre pre(const Unit& u, int wr, int lane) const { const float* p = (u.kind == 0 ? rowsq : rowsq_m) + u.pm * BM + wr * 64 + lane;
        return Pre{__hip_atomic_load(p, __ATOMIC_RELAXED, __HIP_MEMORY_SCOPE_AGENT), __hip_atomic_load(p + HALF, __ATOMIC_RELAXED, __HIP_MEMORY_SCOPE_AGENT)}; }
    __device__ __forceinline__ void operator()(f32x4 (&acc)[2][2][4][2], const Unit& u, int wr, int wc, int fr, int fq, const Pre& pr) const {
        asm volatile("" : "+v"(fr), "+v"(fq));
        bf16_t* ob; int ld, colt, cls, q; const float* rq; float mult;
        if (u.kind == 0) { ob = O + (size_t)(u.pm * BM) * ldc; ld = ldc; colt = u.pn * BM; rq = rowsq + u.pm * BM;
            if (LAYER == 0) { q = u.pn < 6 ? 0 : (u.pn < 12 ? 1 : (u.pn < 18 ? 2 : 3)); cls = q < 2 ? 1 : (q == 2 ? 0 : 2); mult = q == 0 ? qs64 : (q == 3 ? qs128 : 1.f); }
            else { q = u.pn < 6 ? 0 : (u.pn < 8 ? 1 : (u.pn < 10 ? 2 : 3)); cls = q == 2 ? 0 : 2; mult = (q == 0 || q == 3) ? qs128 : 1.f; } }
        else { const int l = u.kind - 1; const bool isk = u.pn < 2; ob = (isk ? KM : VM) + (size_t)(l * 512 + u.pm * BM) * 512; ld = 512; colt = (u.pn & 1) * BM; rq = rowsq_m + u.pm * BM;
               cls = isk ? 2 : 0; q = 4 + l; mult = 1.f; }
        const int rl0 = wr * 64 + fr;
        float rqv[2][4]; rows4(pr.a, rqv[0]); rows4(pr.b, rqv[1]);
        f32x4 g0 = {1.f, 1.f, 1.f, 1.f}, g1 = g0;
        if (cls != 0) {
            float sv[2][4][2];
#pragma unroll
            for (int ai = 0; ai < 2; ++ai)
#pragma unroll
                for (int m = 0; m < 4; ++m)
#pragma unroll
                    for (int bj = 0; bj < 2; ++bj) { const f32x4 a = acc[ai][bj][m][0], b = acc[ai][bj][m][1];
                        const float s = (a[0] * a[0] + a[1] * a[1]) + (a[2] * a[2] + a[3] * a[3]) + (b[0] * b[0] + b[1] * b[1]) + (b[2] * b[2] + b[3] * b[3]);
                        sv[ai][m][bj] = xsum_rows(s); }
            if (fq == 0) {
#pragma unroll
                for (int ai = 0; ai < 2; ++ai)
#pragma unroll
                    for (int m = 0; m < 4; ++m) { const float rs2 = __builtin_amdgcn_rcpf(rqv[ai][m] * invk + NORM_EPS);
#pragma unroll
                        for (int bj = 0; bj < 2; ++bj) xb[(rl0 + ai * HALF + m * 16) * 8 + bj * 4 + wc] = sv[ai][m][bj] * rs2; } }
            asm volatile("s_waitcnt lgkmcnt(0)" ::: "memory"); __builtin_amdgcn_s_barrier(); asm volatile("" ::: "memory");
            const float invn = cls == 1 ? (1.f / 64.f) : (1.f / 128.f);
            const float w01 = (cls == 2 || wc < 2) ? 1.f : 0.f, w23 = (cls == 2 || wc >= 2) ? 1.f : 0.f;
            f32x4 pv[2][4][2];
#pragma unroll
            for (int ai = 0; ai < 2; ++ai)
#pragma unroll
                for (int m = 0; m < 4; ++m)
#pragma unroll
                    for (int bj = 0; bj < 2; ++bj) pv[ai][m][bj] = *(const PG8_LAS f32x4*)(xb + (rl0 + ai * HALF + m * 16) * 8 + bj * 4);
#pragma unroll
            for (int ai = 0; ai < 2; ++ai)
#pragma unroll
                for (int m = 0; m < 4; ++m) { const float rs = __builtin_amdgcn_rsqf(rqv[ai][m] * invk + NORM_EPS);
#pragma unroll
                    for (int bj = 0; bj < 2; ++bj) { const f32x4 p = pv[ai][m][bj];
                        const float s = w01 * (p[0] + p[1]) + w23 * (p[2] + p[3]);
                        const float f = mult * __builtin_amdgcn_rsqf(s * invn + NORM_EPS) * rs;
                        acc[ai][bj][m][0] *= f; acc[ai][bj][m][1] *= f; } }
            PG8_LAS const float* gp = xg + q * 128 + (cls == 1 ? 32 * (wc & 1) : 32 * wc) + 8 * fq;
            g0 = *(PG8_LAS const f32x4*)gp; g1 = *(PG8_LAS const f32x4*)(gp + 4);
        } else {
#pragma unroll
            for (int ai = 0; ai < 2; ++ai)
#pragma unroll
                for (int m = 0; m < 4; ++m) { const float rs = __builtin_amdgcn_rsqf(rqv[ai][m] * invk + NORM_EPS);
#pragma unroll
                    for (int bj = 0; bj < 2; ++bj) { acc[ai][bj][m][0] *= rs; acc[ai][bj][m][1] *= rs; } }
        }
#pragma unroll
        for (int ai = 0; ai < 2; ++ai)
#pragma unroll
            for (int m = 0; m < 4; ++m) { bf16_t* rowp = ob + (size_t)(rl0 + ai * HALF + m * 16) * ld + colt + wc * 32 + 8 * fq;
#pragma unroll
                for (int bj = 0; bj < 2; ++bj) { const f32x4 v0 = acc[ai][bj][m][0] * g0, v1 = acc[ai][bj][m][1] * g1;
                    u32x4 w; w.x = cvt_pk_bf16(v0[0], v0[1]); w.y = cvt_pk_bf16(v0[2], v0[3]); w.z = cvt_pk_bf16(v1[0], v1[1]); w.w = cvt_pk_bf16(v1[2], v1[3]);
                    *(u32x4*)(rowp + bj * HALF) = w; } }
    }
};

template <class Epi, class Sched, bool ALIGN_EPI = false, bool SP2 = false, bool A_SC1 = false>
__device__ __forceinline__ void gemm_phase(PG8_LAS unsigned char* lds, const Gemm g, const Sched& S, const Epi& E) {
    const int tid = threadIdx.x, wid = __builtin_amdgcn_readfirstlane(tid >> 6), lane = tid & 63, wr = wid >> 2, wc = wid & 3, fr = lane & 15, fq = lane >> 4;
    const int K = g.K, nt = K / BK;
    unsigned voffA[2], voffB[2];
#pragma unroll
    for (int i = 0; i < 2; ++i) { int R, C; stage_rc(tid * 16 + i * 8192, R, C); const int Rb = Epi::PERM ? ((R & ~31) + perm32(R & 31)) : R;
        voffA[i] = (unsigned)(R * K + C) * 2u; voffB[i] = (unsigned)(Rb * K + C) * 2u; }
    const size_t kstep = (size_t)(BK * 2);
    const size_t hstep = (size_t)HALF * K * 2;
    const size_t tstep = 2 * hstep;
    const unsigned ldsw = (unsigned)wid * 1024u;
    const int aoff = lds_byte(wr * 64 + fr, fq * 8), boff = lds_byte(wc * 32 + fr, fq * 8);
#define PG8_SA(b, h) (((b) * 2 + (h)) * HTB)
#define PG8_SB(b, h) ((4 + (b) * 2 + (h)) * HTB)
#define PG8_STAGE(bufoff, gbase, voff) do { _Pragma("unroll") for (int _i = 0; _i < 2; ++_i) \
        __builtin_amdgcn_global_load_lds((const unsigned*)((const char*)(gbase) + (voff)[_i]), (PG8_LAS unsigned*)(lds + (bufoff) + ldsw + _i * 8192), 16, 0, 0); } while (0)
#define PG8_STAGEA(bufoff, gbase, voff) do { _Pragma("unroll") for (int _i = 0; _i < 2; ++_i) \
        __builtin_amdgcn_global_load_lds((const unsigned*)((const char*)(gbase) + (voff)[_i]), (PG8_LAS unsigned*)(lds + (bufoff) + ldsw + _i * 8192), 16, 0, A_SC1 ? 16 : 0); } while (0)
#define PG8_LDA(dst, b, h) do { _Pragma("unroll") for (int m = 0; m < 4; ++m) _Pragma("unroll") for (int k = 0; k < 2; ++k) dst[m][k] = *(const PG8_LAS bf16x8*)(lds + PG8_SA(b, h) + aoff + m * 2048 + k * 1024); } while (0)
#define PG8_LDB(dst, b, h) do { _Pragma("unroll") for (int n = 0; n < 2; ++n) _Pragma("unroll") for (int k = 0; k < 2; ++k) dst[n][k] = *(const PG8_LAS bf16x8*)(lds + PG8_SB(b, h) + boff + n * 2048 + k * 1024); } while (0)
#define PG8_MMA(ai, bj, At, Bt) do { __builtin_amdgcn_s_setprio(1); _Pragma("unroll") for (int m = 0; m < 4; ++m) _Pragma("unroll") for (int n = 0; n < 2; ++n) _Pragma("unroll") for (int k = 0; k < 2; ++k) \
        acc[ai][bj][m][n] = __builtin_amdgcn_mfma_f32_16x16x32_bf16(Bt[n][k], At[m][k], acc[ai][bj][m][n], 0, 0, 0); __builtin_amdgcn_s_setprio(0); } while (0)
#define PG8_WAIT_V(n) asm volatile("s_waitcnt vmcnt(" #n ")" ::: "memory")
#define PG8_WAIT_L(n) asm volatile("s_waitcnt lgkmcnt(" #n ")" ::: "memory")
#define PG8_BAR __builtin_amdgcn_s_barrier()
#define PG8_SCHED __builtin_amdgcn_sched_barrier(0)
    Unit cur, nxt; int ui = 0;
    if (!S.next(0, cur)) return;
    f32x4 acc[2][2][4][2];
#pragma unroll
    for (int a = 0; a < 2; ++a)
#pragma unroll
        for (int b = 0; b < 2; ++b)
#pragma unroll
            for (int m = 0; m < 4; ++m)
#pragma unroll
                for (int n = 0; n < 2; ++n) acc[a][b][m][n] = (f32x4){0.f, 0.f, 0.f, 0.f};
    bf16x8 At[4][2], B0[2][2], B1[2][2];
    const char* cA = S.a_base(cur, g, tstep); const char* cB = S.b_base(cur, g, tstep);
    S.a_ready(cur);
    if constexpr (SP2) {
        PG8_STAGE(PG8_SB(0, 0), cB, voffB); PG8_STAGE(PG8_SB(0, 1), cB + hstep, voffB); PG8_STAGEA(PG8_SA(0, 0), cA, voffA); PG8_STAGEA(PG8_SA(0, 1), cA + hstep, voffA);
        if (wr == 1) PG8_BAR;
        PG8_WAIT_V(2); PG8_BAR;
        PG8_STAGE(PG8_SB(1, 0), cB + kstep, voffB); PG8_STAGEA(PG8_SA(1, 0), cA + kstep, voffA); PG8_STAGE(PG8_SB(1, 1), cB + hstep + kstep, voffB);
        PG8_WAIT_V(6); PG8_BAR;
    } else {
        PG8_STAGE(PG8_SB(0, 0), cB, voffB); PG8_STAGEA(PG8_SA(0, 0), cA, voffA); PG8_STAGE(PG8_SB(0, 1), cB + hstep, voffB); PG8_STAGEA(PG8_SA(0, 1), cA + hstep, voffA);
        if (wr == 1) PG8_BAR;
        PG8_WAIT_V(4); PG8_BAR;
        PG8_STAGE(PG8_SB(1, 0), cB + kstep, voffB); PG8_STAGEA(PG8_SA(1, 0), cA + kstep, voffA); PG8_STAGE(PG8_SB(1, 1), cB + hstep + kstep, voffB);
        PG8_WAIT_V(6); PG8_BAR;
    }
    for (;;) {
        const bool has_next = S.next(ui + 1, nxt);
        const typename Epi::Pre pre_ = E.pre(cur, wr, lane);
        const char* nA = has_next ? S.a_base(nxt, g, tstep) : cA; const char* nB = has_next ? S.b_base(nxt, g, tstep) : cB;
        for (int t = 0; t < nt; t += 2) {
            const bool last = (t == nt - 2);
            const char* a1 = cA + (size_t)(t + 1) * kstep;
            const char* a2 = last ? nA : cA + (size_t)(t + 2) * kstep; const char* b2 = last ? nB : cB + (size_t)(t + 2) * kstep;
            const char* a3 = a2 + kstep; const char* b3 = b2 + kstep;
            if (last && has_next) S.a_ready(nxt);
            if constexpr (SP2) {
            PG8_LDB(B0, 0, 0); PG8_LDB(B1, 0, 1); PG8_SCHED; PG8_LDA(At, 0, 0); PG8_STAGEA(PG8_SA(1, 1), a1 + hstep, voffA);
            PG8_WAIT_V(8); PG8_WAIT_L(0); PG8_BAR; PG8_MMA(0, 0, At, B0); PG8_MMA(0, 1, At, B1); PG8_BAR; PG8_SCHED;
            PG8_LDA(At, 0, 1); PG8_STAGE(PG8_SB(0, 0), b2, voffB); PG8_STAGE(PG8_SB(0, 1), b2 + hstep, voffB); PG8_STAGEA(PG8_SA(0, 0), a2, voffA);
            PG8_WAIT_V(8); PG8_WAIT_L(0); PG8_BAR; PG8_MMA(1, 0, At, B0); PG8_MMA(1, 1, At, B1); PG8_BAR; PG8_SCHED;
            PG8_LDB(B0, 1, 0); PG8_LDB(B1, 1, 1); PG8_SCHED; PG8_LDA(At, 1, 0); PG8_STAGEA(PG8_SA(0, 1), a2 + hstep, voffA);
            PG8_WAIT_V(8); PG8_WAIT_L(0); PG8_BAR; PG8_MMA(0, 0, At, B0); PG8_MMA(0, 1, At, B1); PG8_BAR; PG8_SCHED;
            PG8_LDA(At, 1, 1); PG8_STAGE(PG8_SB(1, 0), b3, voffB); PG8_STAGE(PG8_SB(1, 1), b3 + hstep, voffB); PG8_STAGEA(PG8_SA(1, 0), a3, voffA);
            PG8_WAIT_V(8); PG8_WAIT_L(0); PG8_BAR; PG8_MMA(1, 0, At, B0); PG8_MMA(1, 1, At, B1); PG8_BAR; PG8_SCHED;
            } else {
            PG8_LDB(B0, 0, 0); PG8_SCHED; PG8_LDA(At, 0, 0); PG8_STAGEA(PG8_SA(1, 1), a1 + hstep, voffA);
            PG8_WAIT_L(8); PG8_BAR; PG8_WAIT_L(0); PG8_MMA(0, 0, At, B0); PG8_BAR; PG8_SCHED;
            PG8_LDB(B1, 0, 1); PG8_STAGE(PG8_SB(0, 0), b2, voffB);
            PG8_BAR; PG8_WAIT_L(0); PG8_MMA(0, 1, At, B1); PG8_BAR;
            PG8_LDA(At, 0, 1); PG8_STAGEA(PG8_SA(0, 0), a2, voffA);
            PG8_BAR; PG8_WAIT_L(0); PG8_MMA(1, 0, At, B0); PG8_BAR; PG8_SCHED;
            PG8_STAGE(PG8_SB(0, 1), b2 + hstep, voffB);
            PG8_WAIT_V(6); PG8_BAR; PG8_MMA(1, 1, At, B1); PG8_BAR;
            PG8_LDB(B0, 1, 0); PG8_SCHED; PG8_LDA(At, 1, 0); PG8_STAGEA(PG8_SA(0, 1), a2 + hstep, voffA);
            PG8_WAIT_L(8); PG8_BAR; PG8_WAIT_L(0); PG8_MMA(0, 0, At, B0); PG8_BAR; PG8_SCHED;
            PG8_LDB(B1, 1, 1); PG8_STAGE(PG8_SB(1, 0), b3, voffB);
            PG8_BAR; PG8_WAIT_L(0); PG8_MMA(0, 1, At, B1); PG8_BAR;
            PG8_LDA(At, 1, 1); PG8_STAGEA(PG8_SA(1, 0), a3, voffA);
            PG8_BAR; PG8_WAIT_L(0); PG8_MMA(1, 0, At, B0); PG8_BAR; PG8_SCHED;
            PG8_STAGE(PG8_SB(1, 1), b3 + hstep, voffB);
            PG8_WAIT_V(6); PG8_BAR; PG8_MMA(1, 1, At, B1); PG8_BAR;
            }
        }
        if constexpr (ALIGN_EPI) { if (wr == 0) PG8_BAR; }
#ifdef PROBE_EPI
        const unsigned long long e0_ = __builtin_amdgcn_s_memrealtime();
#endif
        if constexpr (!Epi::AFTER_DRAIN) { E(acc, cur, wr, wc, fr, fq, pre_); S.done(cur); }
#ifdef PROBE_EPI
        if ((PROBE_EPI == 1 || PROBE_EPI == 10 + Epi::KIND) && blockIdx.x == 0 && threadIdx.x == 0) { const unsigned dt_ = (unsigned)(__builtin_amdgcn_s_memrealtime() - e0_); *(volatile PG8_LAS unsigned*)(lds + 143744) += dt_; }
#endif
        if (!has_next) break;
#pragma unroll
        for (int a = 0; a < 2; ++a)
#pragma unroll
            for (int b = 0; b < 2; ++b)
#pragma unroll
                for (int m = 0; m < 4; ++m)
#pragma unroll
                    for (int n = 0; n < 2; ++n) acc[a][b][m][n] = (f32x4){0.f, 0.f, 0.f, 0.f};
        cur = nxt; cA = nA; cB = nB; ++ui;
        if constexpr (ALIGN_EPI) { if (wr == 1) PG8_BAR; }
    }
    PG8_WAIT_V(0);
    if constexpr (!ALIGN_EPI) { if (wr == 0) PG8_BAR; }
    PG8_BAR;
    if constexpr (Epi::AFTER_DRAIN) { E.fused(acc, cur, wr, wc, fr, fq, lds, wid, lane); S.done(cur); }
#undef PG8_SA
#undef PG8_SB
#undef PG8_STAGE
#undef PG8_STAGEA
#undef PG8_LDA
#undef PG8_LDB
#undef PG8_MMA
#undef PG8_WAIT_V
#undef PG8_WAIT_L
#undef PG8_BAR
#undef PG8_SCHED
}
}
#define GAS __attribute__((address_space(1)))
#define LAS __attribute__((address_space(3)))
typedef unsigned short bf16;
typedef unsigned v4u __attribute__((ext_vector_type(4)));
typedef float f32x4 __attribute__((ext_vector_type(4)));
typedef short bf16x8 __attribute__((ext_vector_type(8)));
typedef GAS unsigned gu32;
typedef GAS unsigned long long gu64;
#define RLX_AGENT __ATOMIC_RELAXED, __HIP_MEMORY_SCOPE_AGENT
#define LDS_WAIT() asm volatile("s_waitcnt lgkmcnt(0)" ::: "memory")
#define VM_WAIT() asm volatile("s_waitcnt vmcnt(0)" ::: "memory")
__device__ __forceinline__ unsigned long long rt() { return __builtin_amdgcn_s_memrealtime(); }
__device__ __forceinline__ unsigned f2bf(float f) { unsigned u = __builtin_bit_cast(unsigned, f); return (u + 0x7fffu + ((u >> 16) & 1u)) >> 16; }
__device__ __forceinline__ unsigned pk2(float lo, float hi) { return f2bf(lo) | (f2bf(hi) << 16); }

#define XB_TMO      128
#define XB_XCNT(j)  (256  + 64 * (j))
#define XB_XSUB(j)  (1280 + 64 * (j))
#define XB_XGEN(j)  (2304 + 64 * (j))
#define XB_TOP      3328
#define XB_TOPGEN   3392
#define XCD_BAR_WORDS 3456
#define XB_SPIN_CAP (1u << 18)

__device__ __forceinline__ unsigned xb_ld(unsigned* p)              { return __hip_atomic_load(p, __ATOMIC_RELAXED, __HIP_MEMORY_SCOPE_AGENT); }
__device__ __forceinline__ unsigned xb_add(unsigned* p, unsigned v) { return __hip_atomic_fetch_add(p, v, __ATOMIC_RELAXED, __HIP_MEMORY_SCOPE_AGENT); }
__device__ __forceinline__ unsigned xb_xcc_id() { return (unsigned)__builtin_amdgcn_s_getreg((3 << 11) | 20) & 0xFu; }
#define XB_SPIN(cond, bar) do { unsigned _sp = 0; while (cond) { __builtin_amdgcn_s_sleep(1); \
    if ((++_sp & 255u) == 0u) { if (xb_ld(&(bar)[XB_TMO])) break; if (_sp > XB_SPIN_CAP) { atomicAdd(&(bar)[XB_TMO], 1u); break; } } } } while (0)

struct XcdBarrier {
    unsigned* bar; unsigned x;
    volatile LAS unsigned* st;
};

__device__ __forceinline__ XcdBarrier xcd_barrier_post(unsigned* bar, volatile LAS unsigned* st) {
    XcdBarrier b; b.bar = bar; b.x = xb_xcc_id(); b.st = st;
    if (threadIdx.x == 0) (void)xb_add(&bar[XB_XCNT(b.x)], 1u);
    return b;
}
__device__ __forceinline__ void xcd_barrier_complete(unsigned* bar, unsigned x, unsigned& nloc, unsigned& nx) {
    const unsigned G = gridDim.x * gridDim.y * gridDim.z;
    unsigned sum, cnt, mine, sp = 0u;
    for (;;) {
        sum = 0u; cnt = 0u; mine = 0u;
#pragma unroll
        for (unsigned j = 0; j < 16; ++j) { const unsigned c = xb_ld(&bar[XB_XCNT(j)]); sum += c; cnt += (c > 0u) ? 1u : 0u; mine = (j == x) ? c : mine; }
        if (sum == G) break;
        __builtin_amdgcn_s_sleep(1);
        if ((++sp & 255u) == 0u) { if (xb_ld(&bar[XB_TMO])) break; if (sp > XB_SPIN_CAP) { atomicAdd(&bar[XB_TMO], 1u); break; } }
    }
    nloc = mine > 0u ? mine : 1u; nx = cnt > 0u ? cnt : 1u;
}

__device__ __forceinline__ void xcd_barrier(const XcdBarrier& b) {
    asm volatile("s_waitcnt vmcnt(0)" ::: "memory");
    __syncthreads();
    if (threadIdx.x == 0) {
        unsigned* bar = b.bar;
        __builtin_amdgcn_s_waitcnt(0);
        unsigned nloc = b.st[0], nx = b.st[1];
        if (nloc == 0u) { xcd_barrier_complete(bar, b.x, nloc, nx); b.st[0] = nloc; b.st[1] = nx; }
#ifndef XB_EARLY_WB
#define XB_EARLY_WB 0
#endif
        if (XB_EARLY_WB) asm volatile("buffer_wbl2 sc1" ::: "memory");
        const unsigned old = xb_add(&bar[XB_XSUB(b.x)], 1u);
        const unsigned gen = old / nloc;
        if (old + 1u == (gen + 1u) * nloc) {
            __builtin_amdgcn_fence(__ATOMIC_RELEASE, "agent");
            asm volatile("s_waitcnt vmcnt(0)" ::: "memory");
            const unsigned og = xb_add(&bar[XB_TOP], 1u);
            const unsigned tg = og / nx;
            asm volatile("buffer_inv sc1" ::: "memory");
            if (og + 1u == (tg + 1u) * nx) xb_add(&bar[XB_TOPGEN], 1u);
            else XB_SPIN(xb_ld(&bar[XB_TOPGEN]) == tg, bar);
            xb_add(&bar[XB_XGEN(b.x)], 1u);
            asm volatile("s_waitcnt vmcnt(0)" ::: "memory");
        } else {
            asm volatile("buffer_inv sc1" ::: "memory");
            XB_SPIN(xb_ld(&bar[XB_XGEN(b.x)]) == gen, bar);
            asm volatile("s_waitcnt vmcnt(0)" ::: "memory");
        }
    }
    __syncthreads();
}

constexpr int NWAVES = 8;
constexpr int NB = 2, SEQ = 4096, NTOK = NB * SEQ, DM = 2048, INA = 5120, INB = 3072, DFF = 8192, MEML = 256, MEMR = NB * MEML;
constexpr int NH = 12, NMH = 4, MIXW = 1536, MEMW = 512, KVW = 512;
constexpr int A_K = 1536, A_V = 3072, A_QM = 4608;
constexpr int B_K = 1536, B_V = 2048, B_QM = 2560;
constexpr float RMS_EPS = 1e-6f;
constexpr float LOG2E = 1.4426950408889634f;
constexpr float QS64 = 0.125f * LOG2E;
constexpr float QS128 = 0.08838834764831845f * LOG2E;
constexpr float LAM_INIT0 = 0.2f;
constexpr int N_PHASES = 11;
constexpr unsigned CONV_P0 = 0x10D, CONV_P1 = 0x052, CONV_P6 = 0x2A0;
#ifndef CONV_DEPTH
#define CONV_DEPTH 2
#endif
#ifndef CONV_P1Y_N
#define CONV_P1Y_N 0
#endif
constexpr int CONV_P1Y_ITEMS = CONV_P1Y_N;
#ifndef CONV_P1X_N
#define CONV_P1X_N 0
#endif
constexpr int CONV_P1X_ITEMS = CONV_P1X_N;
#ifndef CONV_P7_N
#define CONV_P7_N 0
#endif
constexpr int CONV_P7_ITEMS = CONV_P7_N;
#ifndef CONV_P1_BACK
#define CONV_P1_BACK 768
#endif
constexpr int CONV_P1_BACK_ITEMS = CONV_P1_BACK;
#ifndef CONV_P2_N
#define CONV_P2_N 3072
#endif
constexpr int CONV_P2_ITEMS = CONV_P2_N;
constexpr int GEMM_CUS_P1 = 224, GEMM_CUS_P6 = 192;
static_assert((CONV_P0 | CONV_P1 | CONV_P6) == 0x3FF && (CONV_P0 & CONV_P1) == 0 && (CONV_P0 & CONV_P6) == 0 && (CONV_P1 & CONV_P6) == 0, "every weight matrix is converted exactly once");

constexpr size_t MiB = 1u << 20;
constexpr size_t WS_CTL = 0, CTL_ZERO_BYTES = 256 * 1024;
constexpr size_t WS_WA = 2 * MiB, WS_WB = 22 * MiB, WS_WMKV = 34 * MiB, WS_WOUT = 42 * MiB, WS_WUP = 58 * MiB, WS_WDN = 122 * MiB;
constexpr size_t WS_HN = 186 * MiB;
constexpr size_t WS_PROJ = 218 * MiB;
constexpr size_t WS_HEADS = 298 * MiB;
constexpr size_t WS_U = 330 * MiB;
constexpr size_t WS_MN = 458 * MiB;
constexpr size_t WS_MKVRAW = 462 * MiB;
constexpr size_t WS_KM = 466 * MiB;
constexpr size_t WS_VM = 467 * MiB;
constexpr size_t WS_POSMM = 468 * MiB;
constexpr size_t WS_END = 469 * MiB;
constexpr int CW_TMO = 0, CW_CODE = 1, CW_BAR = 4096;
constexpr int CW_RSQ_MLP0 = 16384, CW_RSQ_ATT1 = CW_RSQ_MLP0 + NTOK, CW_RSQ_MLP1 = CW_RSQ_ATT1 + NTOK, CW_RSQ_X = CW_RSQ_MLP1 + NTOK, CW_RSQ_M = CW_RSQ_X + NTOK;
constexpr int CW_PANEL = CW_RSQ_M + 2 * MEMR + 64;
constexpr int CW_XCC = CW_PANEL + 32 * 64;
constexpr int CW_CONVDONE = CW_XCC + 256;
static_assert((CW_CONVDONE + 64) * 4 <= (int)CTL_ZERO_BYTES, "control words inside the memset region");

constexpr int RING_OFF = 0, RING_BYTES = 131072;
constexpr int EXTRA_OFF = RING_BYTES, EXTRA_BYTES = 12288;
constexpr int LDSCTL_OFF = EXTRA_OFF + EXTRA_BYTES, MISC_OFF = LDSCTL_OFF + 320;
constexpr int LDS_BYTES = 147456;
static_assert(MISC_OFF + 128 <= LDS_BYTES, "LDS map");

struct Frame {
    LAS unsigned char* lds; unsigned char* ldsg;
    volatile LAS unsigned* MISC;
    gu32* ctl;
    int wave;
    int vcu, G, xl;
    const float* in[25]; float* out; unsigned char* ws;
};
__device__ __forceinline__ int cur_lane() { int l = (int)__builtin_amdgcn_mbcnt_hi(~0u, __builtin_amdgcn_mbcnt_lo(~0u, 0u)); asm volatile("" : "+v"(l)); return l; }
__device__ __forceinline__ float wave_sum(float v) {
#pragma unroll
    for (int o = 1; o < 64; o <<= 1) v += __shfl_xor(v, o);
    return v;
}
__device__ __forceinline__ float wave_max(float v) {
#pragma unroll
    for (int o = 1; o < 64; o <<= 1) v = fmaxf(v, __shfl_xor(v, o));
    return v;
}
__device__ __forceinline__ float bf_lo(unsigned u) { return __uint_as_float(u << 16); }
__device__ __forceinline__ float bf_hi(unsigned u) { return __uint_as_float(u & 0xffff0000u); }

struct TItem { const float* W; bf16* WT; const float* gain; int K, N, item; };
__device__ __forceinline__ void t_load(const TItem& t, f32x4 (&v)[8], int lane) {
    const int nblk = t.N / 32, kb = t.item / nblk, nb = t.item % nblk, k0 = 64 * kb, n0 = 32 * nb, r = lane >> 3, c4 = lane & 7;
#pragma unroll
    for (int i = 0; i < 8; ++i) v[i] = __builtin_nontemporal_load((const GAS f32x4*)(t.W + (size_t)(k0 + 8 * i + r) * t.N + n0 + 4 * c4));
}
__device__ __forceinline__ void t_store(const TItem& t, f32x4 (&v)[8], LAS float* scr, int lane) {
    const int nblk = t.N / 32, kb = t.item / nblk, nb = t.item % nblk, k0 = 64 * kb, n0 = 32 * nb, r = lane >> 3, c4 = lane & 7;
    if (t.gain) {
#pragma unroll
        for (int i = 0; i < 8; ++i) v[i] = v[i] * t.gain[k0 + 8 * i + r]; }
#pragma unroll
    for (int i = 0; i < 8; ++i) { LAS float* p = scr + (8 * i + r) * 33 + 4 * c4; p[0] = v[i].x; p[1] = v[i].y; p[2] = v[i].z; p[3] = v[i].w; }
    LDS_WAIT(); asm volatile("" ::: "memory");
    const int c = lane & 7;
#pragma unroll
    for (int j = 0; j < 4; ++j) { const int n = (lane >> 3) + 8 * j; const LAS float* s = scr + (8 * c) * 33 + n;
        v4u o; o.x = pk2(s[0 * 33], s[1 * 33]); o.y = pk2(s[2 * 33], s[3 * 33]); o.z = pk2(s[4 * 33], s[5 * 33]); o.w = pk2(s[6 * 33], s[7 * 33]);
        *(GAS v4u*)(t.WT + (size_t)(n0 + n) * t.K + k0 + 8 * c) = o; }
    LDS_WAIT(); asm volatile("" ::: "memory");
}
__device__ __forceinline__ void row_to_bf16(const float* xrow, bf16* orow, float* rowsq, int lane) {
    const GAS f32x4* xr = (const GAS f32x4*)xrow + lane;
    f32x4 v[8]; float s = 0.f;
#pragma unroll
    for (int j = 0; j < 8; ++j) { v[j] = xr[64 * j]; s += (v[j].x * v[j].x + v[j].y * v[j].y) + (v[j].z * v[j].z + v[j].w * v[j].w); }
    s = wave_sum(s); if (lane == 0) *rowsq = s;
    GAS unsigned long long* o8 = (GAS unsigned long long*)orow + lane;
#pragma unroll
    for (int j = 0; j < 8; ++j) o8[64 * j] = (unsigned long long)pk2(v[j].x, v[j].y) | ((unsigned long long)pk2(v[j].z, v[j].w) << 32);
}
__device__ __forceinline__ void row2_to_bf16(const float* x0, const float* x1, bf16* o0, bf16* o1, float* rq0, float* rq1, int lane) {
    const GAS f32x4* xa = (const GAS f32x4*)x0 + lane; const GAS f32x4* xb = (const GAS f32x4*)x1 + lane;
    f32x4 v[8], w[8]; float s = 0.f, t = 0.f;
#pragma unroll
    for (int j = 0; j < 8; ++j) v[j] = xa[64 * j];
#pragma unroll
    for (int j = 0; j < 8; ++j) w[j] = xb[64 * j];
#pragma unroll
    for (int j = 0; j < 8; ++j) { s += (v[j].x * v[j].x + v[j].y * v[j].y) + (v[j].z * v[j].z + v[j].w * v[j].w); t += (w[j].x * w[j].x + w[j].y * w[j].y) + (w[j].z * w[j].z + w[j].w * w[j].w); }
    s = wave_sum(s); t = wave_sum(t); if (lane == 0) { *rq0 = s; *rq1 = t; }
    GAS unsigned long long* p0 = (GAS unsigned long long*)o0 + lane; GAS unsigned long long* p1 = (GAS unsigned long long*)o1 + lane;
#pragma unroll
    for (int j = 0; j < 8; ++j) { p0[64 * j] = (unsigned long long)pk2(v[j].x, v[j].y) | ((unsigned long long)pk2(v[j].z, v[j].w) << 32);
                                  p1[64 * j] = (unsigned long long)pk2(w[j].x, w[j].y) | ((unsigned long long)pk2(w[j].z, w[j].w) << 32); }
}
__device__ __forceinline__ void phase_rows_bf16(Frame& F, const float* x, bf16* out, float* rowsq, int nrows) {
    const int gw = F.vcu * NWAVES + F.wave, NGW = F.G * NWAVES;
    for (int m = 2 * gw; m < nrows; m += 2 * NGW) row2_to_bf16(x + (size_t)m * DM, x + (size_t)(m + 1) * DM, out + (size_t)m * DM, out + (size_t)(m + 1) * DM, rowsq + m, rowsq + m + 1, cur_lane());
}
template <unsigned MASK, int DEPTH = 2> __device__ __forceinline__ void convert_weights(Frame& F, int gw, int NGW, int from_end0 = -1, int from_end1 = 0) {
    LAS float* scr = (LAS float*)(F.lds + RING_OFF + F.wave * 16384);
    bf16* const wa = (bf16*)(F.ws + WS_WA); bf16* const wb = (bf16*)(F.ws + WS_WB); bf16* const wm = (bf16*)(F.ws + WS_WMKV);
    bf16* const wo = (bf16*)(F.ws + WS_WOUT); bf16* const wu = (bf16*)(F.ws + WS_WUP); bf16* const wd = (bf16*)(F.ws + WS_WDN);
    constexpr int I_A = (DM / 64) * (INA / 32), I_B = (DM / 64) * (INB / 32), I_M = (DM / 64) * (1024 / 32), I_O = (DM / 64) * (DM / 32), I_U = (DM / 64) * (DFF / 32), I_D = (DFF / 64) * (DM / 32);
    constexpr int NITEMS = ((MASK >> 0) & 1) * I_A + ((MASK >> 1) & 1) * I_B + (((MASK >> 2) & 1) + ((MASK >> 3) & 1)) * I_M + (((MASK >> 4) & 1) + ((MASK >> 5) & 1)) * I_O
                         + (((MASK >> 6) & 1) + ((MASK >> 7) & 1)) * I_U + (((MASK >> 8) & 1) + ((MASK >> 9) & 1)) * I_D;
#define CW_TRY(bit, items, W_, K_, N_, WT_, G_) if ((MASK >> (bit)) & 1u) { if (!done && r < (items)) { t.W = (W_); t.K = (K_); t.N = (N_); t.WT = (WT_); t.gain = (G_); t.item = r; done = true; } r -= (items); }
#define CW_DECODE(IT, T) do { int r = (IT); bool done = false; TItem t{}; \
        CW_TRY(0, I_A, F.in[7], DM, INA, wa, F.in[4]) CW_TRY(1, I_B, F.in[15], DM, INB, wb, F.in[4] + DM) \
        CW_TRY(2, I_M, F.in[19], DM, 1024, wm, F.in[5]) CW_TRY(3, I_M, F.in[19] + (size_t)DM * 1024, DM, 1024, wm + (size_t)1024 * DM, F.in[5] + DM) \
        CW_TRY(4, I_O, F.in[22], DM, DM, wo, (const float*)nullptr) CW_TRY(5, I_O, F.in[22] + (size_t)DM * DM, DM, DM, wo + (size_t)DM * DM, (const float*)nullptr) \
        CW_TRY(6, I_U, F.in[23], DM, DFF, wu, F.in[6]) CW_TRY(7, I_U, F.in[23] + (size_t)DM * DFF, DM, DFF, wu + (size_t)DFF * DM, F.in[6] + DM) \
        CW_TRY(8, I_D, F.in[24], DFF, DM, wd, (const float*)nullptr) CW_TRY(9, I_D, F.in[24] + (size_t)DFF * DM, DFF, DM, wd + (size_t)DM * DFF, (const float*)nullptr) \
        T = t; } while (0)
    const int it0 = from_end0 < 0 ? 0 : NITEMS - from_end0, it1 = NITEMS - from_end1;
    if constexpr (DEPTH == 4) {
    for (int it = it0 + gw; it < it1; it += 4 * NGW) {
        const int lane = cur_lane(); const bool h1 = it + NGW < it1, h2 = it + 2 * NGW < it1, h3 = it + 3 * NGW < it1;
        TItem ta, tb_, tc, td; CW_DECODE(it, ta); CW_DECODE(h1 ? it + NGW : it, tb_); CW_DECODE(h2 ? it + 2 * NGW : it, tc); CW_DECODE(h3 ? it + 3 * NGW : it, td);
        f32x4 va[8], vb[8], vc[8], vd[8];
        t_load(ta, va, lane); if (h1) t_load(tb_, vb, lane); if (h2) t_load(tc, vc, lane); if (h3) t_load(td, vd, lane);
        t_store(ta, va, scr, lane); if (h1) t_store(tb_, vb, scr, lane); if (h2) t_store(tc, vc, scr, lane); if (h3) t_store(td, vd, scr, lane);
    }
    } else {
    for (int it = it0 + gw; it < it1; it += 2 * NGW) {
        const int lane = cur_lane(); const bool two = it + NGW < it1;
        TItem ta, tb_; CW_DECODE(it, ta); CW_DECODE(two ? it + NGW : it, tb_);
        f32x4 va[8], vb[8];
        t_load(ta, va, lane); if (two) t_load(tb_, vb, lane);
        t_store(ta, va, scr, lane); if (two) t_store(tb_, vb, scr, lane);
    }
    }
#undef CW_TRY
#undef CW_DECODE
}
__device__ __forceinline__ void p0_prologue(Frame& F) {
    const int gw = F.vcu * NWAVES + F.wave, NGW = F.G * NWAVES;
    convert_weights<CONV_P0>(F, gw, NGW, -1, F.G == 256 ? CONV_P2_ITEMS + CONV_P1X_ITEMS + CONV_P1Y_ITEMS : 0);
    if (F.G >= 256 && CONV_P1_BACK_ITEMS > 0) convert_weights<CONV_P1>(F, gw, NGW, CONV_P1_BACK_ITEMS, 0);
    phase_rows_bf16(F, F.in[0], (bf16*)(F.ws + WS_HN), (float*)(F.ctl + CW_RSQ_X), NTOK);
    phase_rows_bf16(F, F.in[1], (bf16*)(F.ws + WS_MN), (float*)(F.ctl + CW_RSQ_M), MEMR);
}

__device__ __forceinline__ int t5_bucket(int rel) {
    const int n = rel < 0 ? -rel : rel; const int side = rel > 0 ? 16 : 0;
    const int large = 8 + (n >= 12) + (n >= 16) + (n >= 23) + (n >= 32) + (n >= 46) + (n >= 64) + (n >= 91);
    return side + (n < 8 ? n : large);
}

namespace att {
typedef short bf16x8 __attribute__((ext_vector_type(8)));
typedef short s16x4 __attribute__((ext_vector_type(4)));
typedef float f32x16 __attribute__((ext_vector_type(16)));
typedef unsigned u32x4 __attribute__((ext_vector_type(4)));
typedef int i32x4 __attribute__((ext_vector_type(4)));
enum { M_DIFF = 0, M_WIN = 1, M_MEM = 2 };
#define KSWZ(row, colB) ((row) * 256 + ((colB) ^ (((row) & 15) << 4)))
#define SBAR() __builtin_amdgcn_sched_barrier(0)
constexpr int SHM_V = 16384, SHM_K = 16384;
constexpr int L_V = 0, L_K = 32768, L_XCH = 65536;
constexpr int X_FLG = 5632, X_TBM = 6144, TBM_OFF = 512;
constexpr int X_WS = 0, X_POS = 2048, X_TB = 4096, X_TMM = 5120;
constexpr int NREL = 91;
__device__ __forceinline__ int crow(int r, int hi) { return (r & 3) + 8 * (r >> 2) + 4 * hi; }
__device__ __forceinline__ unsigned cvtpk(float lo, float hi) { unsigned r; asm volatile("v_cvt_pk_bf16_f32 %0, %1, %2" : "=v"(r) : "v"(lo), "v"(hi)); return r; }
template <int K> __device__ __forceinline__ int xor_i(int v) {
  if (K < 32) return __builtin_amdgcn_ds_swizzle(v, (K << 10) | 0x1f);
  else { auto r = __builtin_amdgcn_permlane32_swap((unsigned)v, (unsigned)v, false, false); return (int)r[0] == v ? (int)r[1] : (int)r[0]; }
}
template <int K> __device__ __forceinline__ float xor_f(float v) { return __int_as_float(xor_i<K>(__float_as_int(v))); }
__device__ __forceinline__ int v_st(int k, int c) { const int kk = k; return ((kk >> 3) * 4 + (c >> 5)) * 512 + ((kk & 7) * 32 + (c & 31)) * 2; }
__device__ __forceinline__ int v_rd_base(int lane) { return ((lane & 3) << 3) | (((lane >> 2) & 3) << 6) | (((lane >> 4) & 1) << 5) | (((lane >> 5) & 1) << 8); }
constexpr int v_rd_off(int d0, int ks, int half) { return d0 * 512 + ks * 4096 + half * 2048; }
template <int OFF> __device__ __forceinline__ s16x4 tr_read(int vb) { s16x4 r; asm volatile("ds_read_b64_tr_b16 %0, %1 offset:%2" : "=&v"(r) : "v"(vb), "i"(OFF) : "memory"); return r; }
template <int D0> __device__ __forceinline__ void pv_one(f32x16& od, int vb, bf16x8 pa0, bf16x8 pa1, bf16x8 pa2, bf16x8 pa3) {
  const s16x4 l0 = tr_read<v_rd_off(D0, 0, 0)>(vb), h0 = tr_read<v_rd_off(D0, 0, 1)>(vb), l1 = tr_read<v_rd_off(D0, 1, 0)>(vb), h1 = tr_read<v_rd_off(D0, 1, 1)>(vb);
  const s16x4 l2 = tr_read<v_rd_off(D0, 2, 0)>(vb), h2 = tr_read<v_rd_off(D0, 2, 1)>(vb), l3 = tr_read<v_rd_off(D0, 3, 0)>(vb), h3 = tr_read<v_rd_off(D0, 3, 1)>(vb);
  asm volatile("s_waitcnt lgkmcnt(0)" ::: "memory"); SBAR();
#define PK(L, H) (bf16x8){L[0], L[1], L[2], L[3], H[0], H[1], H[2], H[3]}
  od = __builtin_amdgcn_mfma_f32_32x32x16_bf16(pa0, PK(l0, h0), od, 0, 0, 0);
  od = __builtin_amdgcn_mfma_f32_32x32x16_bf16(pa1, PK(l1, h1), od, 0, 0, 0);
  od = __builtin_amdgcn_mfma_f32_32x32x16_bf16(pa2, PK(l2, h2), od, 0, 0, 0);
  od = __builtin_amdgcn_mfma_f32_32x32x16_bf16(pa3, PK(l3, h3), od, 0, 0, 0);
#undef PK
}
__device__ __forceinline__ void pv_d0(f32x16* o, int vb, bf16x8 pa0, bf16x8 pa1, bf16x8 pa2, bf16x8 pa3) {
  pv_one<0>(o[0], vb, pa0, pa1, pa2, pa3); pv_one<1>(o[1], vb, pa0, pa1, pa2, pa3); pv_one<2>(o[2], vb, pa0, pa1, pa2, pa3); pv_one<3>(o[3], vb, pa0, pa1, pa2, pa3);
}
template <int ND0> __device__ __forceinline__ void qkt(f32x16& p0, f32x16& p1, const char* Ks, const bf16x8* qr, int r32, int hi, int kcolB) {
  p0 = f32x16{}; p1 = f32x16{};
#pragma unroll
  for (int d0 = 0; d0 < ND0; ++d0) { const int cb = kcolB + (d0 * 16 + hi * 8) * 2;
    const bf16x8 b0 = *reinterpret_cast<const bf16x8*>(Ks + KSWZ(r32, cb));
    const bf16x8 b1 = *reinterpret_cast<const bf16x8*>(Ks + KSWZ(32 + r32, cb));
    p0 = __builtin_amdgcn_mfma_f32_32x32x16_bf16(b0, qr[d0], p0, 0, 0, 0);
    p1 = __builtin_amdgcn_mfma_f32_32x32x16_bf16(b1, qr[d0], p1, 0, 0, 0); }
}
__device__ __forceinline__ void add_bias(f32x16& p0, f32x16& p1, const int* kp, const float* tb, int qpos, int hi) {
#pragma unroll
  for (int g = 0; g < 4; ++g) { const i32x4 ka = *reinterpret_cast<const i32x4*>(kp + 8 * g + 4 * hi), kb = *reinterpret_cast<const i32x4*>(kp + 32 + 8 * g + 4 * hi);
#pragma unroll
    for (int i = 0; i < 4; ++i) { int ia = ka[i] - qpos + NREL, ib = kb[i] - qpos + NREL; ia = ia < 0 ? 0 : (ia > 2 * NREL ? 2 * NREL : ia); ib = ib < 0 ? 0 : (ib > 2 * NREL ? 2 * NREL : ib);
      p0[4 * g + i] += tb[ia]; p1[4 * g + i] += tb[ib]; } }
}
__device__ __forceinline__ void win_mask(f32x16& p0, f32x16& p1, int dq) {
#pragma unroll
  for (int r = 0; r < 16; ++r) { const int d = dq + (r & 3) + 8 * (r >> 2);
    if ((unsigned)(d + 128) > 256u) p0[r] = -INFINITY;
    if ((unsigned)(d + 160) > 256u) p1[r] = -INFINITY; }
}
__device__ __forceinline__ void add_bias_fast(f32x16& p0, f32x16& p1, const float* tp) {
#pragma unroll
  for (int r = 0; r < 16; ++r) { p0[r] += tp[(r & 3) + 8 * (r >> 2)]; p1[r] += tp[32 + (r & 3) + 8 * (r >> 2)]; }
}
__device__ __forceinline__ void exp_half(f32x16& p) {
#pragma unroll
  for (int r = 0; r < 16; ++r) p[r] = __builtin_amdgcn_exp2f(p[r]);
}
__device__ __forceinline__ void finishSM(f32x16& p0, f32x16& p1, float& l_reg, bf16x8& pa0, bf16x8& pa1, bf16x8& pa2, bf16x8& pa3) {
  exp_half(p1);
  float ps = 0.f;
#pragma unroll
  for (int r = 0; r < 16; ++r) ps += p0[r];
#pragma unroll
  for (int r = 0; r < 16; ++r) ps += p1[r];
  l_reg += ps;
#define PK4(P, BASE, OUT) do { unsigned a0 = cvtpk(P[BASE + 0], P[BASE + 1]), a1 = cvtpk(P[BASE + 2], P[BASE + 3]);   \
    unsigned b0 = cvtpk(P[BASE + 4], P[BASE + 5]), b1 = cvtpk(P[BASE + 6], P[BASE + 7]);                              \
    u32x4 w = {a0, a1, b0, b1}; OUT = *reinterpret_cast<bf16x8*>(&w); } while (0)
  PK4(p0, 0, pa0); PK4(p0, 8, pa1); PK4(p1, 0, pa2); PK4(p1, 8, pa3);
#undef PK4
}

struct UnitArgs {
  const bf16* Q; int ldq;
  const bf16* K; const bf16* V;
  bf16* O;
  const int* posb;
  const float* relb; int h;
  int q0;
  float sinkl2;
  float lam; const float* subln;
};

template <int MODE>
__device__ __forceinline__ void attn_epilogue(f32x16 (&o)[4], float l_reg, const UnitArgs& A, char* ring, char* extra) {
  int tid = threadIdx.x; asm volatile("" : "+v"(tid));
  const int wid = __builtin_amdgcn_readfirstlane(tid >> 6), lane = tid & 63, r32 = lane & 31, hi = lane >> 5;
  const int wq = (MODE == M_DIFF) ? (wid & 3) : wid, half = (MODE == M_DIFF) ? (wid >> 2) : 0;
  float* wsf = (float*)(extra + X_WS) + wid * 64;
  { auto rr = __builtin_amdgcn_permlane32_swap(__float_as_uint(l_reg), __float_as_uint(l_reg), false, false); l_reg = __uint_as_float(rr[0]) + __uint_as_float(rr[1]); }
  if (MODE == M_WIN) l_reg += __builtin_amdgcn_exp2f(A.sinkl2);
  if (hi == 0) wsf[r32] = l_reg; asm volatile("s_waitcnt lgkmcnt(0)" ::: "memory");
  float rli[16];
#pragma unroll
  for (int r = 0; r < 16; ++r) rli[r] = __builtin_amdgcn_rcpf(wsf[crow(r, hi)]);
  if (MODE == M_DIFF) {
    float* xch = (float*)(ring + L_XCH);
    __syncthreads();
    if (half == 1) {
#pragma unroll
      for (int r = 0; r < 16; ++r)
#pragma unroll
        for (int d0 = 0; d0 < 4; ++d0) xch[(wq * 32 + crow(r, hi)) * 128 + d0 * 32 + r32] = o[d0][r] * rli[r] * A.lam;
    }
    __syncthreads();
    if (half == 0) {
      float ss[16];
#pragma unroll
      for (int r = 0; r < 16; ++r) { ss[r] = 0.f;
#pragma unroll
        for (int d0 = 0; d0 < 4; ++d0) { const float v = o[d0][r] * rli[r] - xch[(wq * 32 + crow(r, hi)) * 128 + d0 * 32 + r32]; o[d0][r] = v; ss[r] += v * v; } }
#pragma unroll
      for (int r = 0; r < 16; ++r) {
        ss[r] += xor_f<1>(ss[r]); ss[r] += xor_f<2>(ss[r]); ss[r] += xor_f<4>(ss[r]); ss[r] += xor_f<8>(ss[r]); ss[r] += xor_f<16>(ss[r]);
        ss[r] = (1.f - LAM_INIT0) / sqrtf(ss[r] * (1.f / 128.f) + RMS_EPS); }
      bf16* stg = (bf16*)(ring + wq * 8192);
#pragma unroll
      for (int d0 = 0; d0 < 4; ++d0) { const float g = A.subln[d0 * 32 + r32];
#pragma unroll
        for (int r = 0; r < 16; ++r) stg[crow(r, hi) * 128 + d0 * 32 + r32] = (bf16)f2bf(o[d0][r] * ss[r] * g); }
      asm volatile("s_waitcnt lgkmcnt(0)" ::: "memory");
#pragma unroll
      for (int i = 0; i < 8; ++i) { const int row = i * 4 + (lane >> 4), ch = lane & 15; const u32x4 v = *(const u32x4*)(stg + row * 128 + ch * 8);
        *(u32x4*)(A.O + (size_t)(wq * 32 + row) * DM + ch * 8) = v; }
    }
  } else {
    __syncthreads();
    bf16* stg = (bf16*)(ring + wq * 8192);
#pragma unroll
    for (int d0 = 0; d0 < 4; ++d0)
#pragma unroll
      for (int r = 0; r < 16; ++r) stg[crow(r, hi) * 128 + d0 * 32 + r32] = (bf16)f2bf(o[d0][r] * rli[r]);
    asm volatile("s_waitcnt lgkmcnt(0)" ::: "memory");
#pragma unroll
    for (int i = 0; i < 8; ++i) { const int row = i * 4 + (lane >> 4), ch = lane & 15; const u32x4 v = *(const u32x4*)(stg + row * 128 + ch * 8);
      *(u32x4*)(A.O + (size_t)(wq * 32 + row) * DM + ch * 8) = v; }
  }
}
constexpr int DSLOT = 32768, D_POS = 3 * DSLOT;
typedef short v4i16_t __attribute__((ext_vector_type(4)));
typedef __attribute__((address_space(3))) const char* lds_cptr;
__device__ __forceinline__ s16x4 vtr(lds_cptr p) { return __builtin_bit_cast(s16x4, __builtin_amdgcn_ds_read_tr16_b64_v4i16((__attribute__((address_space(3))) v4i16_t*)p)); }
#ifndef ATT_PRIO
#define ATT_PRIO 0
#endif
#ifndef ATT_VD
#define ATT_VD 4
#endif
constexpr int VD = ATT_VD;
template <int MODE>
__device__ __forceinline__ void attn_unit_pipe(char* ring, char* extra, const UnitArgs& A) {
  constexpr int ND0 = (MODE == M_DIFF) ? 4 : 8, LDK = (MODE == M_DIFF) ? INA : INB, NF = 2 * ND0;
  int NT = (MODE == M_DIFF) ? SEQ / 64 : 8; asm volatile("" : "+s"(NT));
  int tid = threadIdx.x; asm volatile("" : "+v"(tid));
  const int wid = __builtin_amdgcn_readfirstlane(tid >> 6), lane = tid & 63, r32 = lane & 31, hi = lane >> 5;
  const int wq = (MODE == M_DIFF) ? (wid & 3) : wid, half = (MODE == M_DIFF) ? (wid >> 2) : 0;
  const int kt0 = (MODE == M_WIN) ? A.q0 - 128 : 0;
#define KEYC(k) ((MODE == M_WIN) ? ((k) < 0 ? 0 : ((k) > SEQ - 1 ? SEQ - 1 : (k))) : (k))
  const int sr = tid >> 4, sc = (tid & 15) * 8, vst0 = v_st(sr, sc), vst1 = v_st(32 + sr, sc);
  struct { bf16x8 vs0, vs1, ks0, ks1; } sr_[1];
#define SLOADV(i, t) do { const int ka_ = KEYC(kt0 + (t) * 64 + sr), kb_ = KEYC(kt0 + (t) * 64 + 32 + sr); \
    sr_[i].vs0 = *reinterpret_cast<const bf16x8*>(A.V + (size_t)ka_ * LDK + sc); sr_[i].vs1 = *reinterpret_cast<const bf16x8*>(A.V + (size_t)kb_ * LDK + sc); } while (0)
#define SLOADK(i, t) do { const int ka_ = KEYC(kt0 + (t) * 64 + sr), kb_ = KEYC(kt0 + (t) * 64 + 32 + sr); \
    sr_[i].ks0 = *reinterpret_cast<const bf16x8*>(A.K + (size_t)ka_ * LDK + sc); sr_[i].ks1 = *reinterpret_cast<const bf16x8*>(A.K + (size_t)kb_ * LDK + sc); } while (0)
  SLOADV(0, 0); SLOADK(0, 0);
  int* posl = (int*)(ring + D_POS); float* tb = (float*)(extra + X_TB); int* tmm = (int*)(extra + X_TMM); float* tbm = (float*)(extra + X_TBM); int* flg = (int*)(extra + X_FLG);
  if (tid < 2 * NREL + 1) tb[tid] = A.relb[t5_bucket(tid - NREL) * NH + A.h] * LOG2E;
  if constexpr (MODE == M_WIN)
#pragma unroll
  for (int i = tid; i < 2 * TBM_OFF + 1; i += 512) { const int dd = i - TBM_OFF, dc = dd < -NREL ? -NREL : (dd > NREL ? NREL : dd); float v = A.relb[t5_bucket(dc) * NH + A.h] * LOG2E;
    if (MODE == M_WIN) { if (dd < -128 || dd > 128) v = -INFINITY; } tbm[i] = v; }
  bool ok_ = false;
  if constexpr (MODE == M_DIFF) {
    { const i32x4 a = *reinterpret_cast<const i32x4*>(A.posb + tid * 8), b = *reinterpret_cast<const i32x4*>(A.posb + tid * 8 + 4);
      *reinterpret_cast<i32x4*>(posl + tid * 8) = a; *reinterpret_cast<i32x4*>(posl + tid * 8 + 4) = b;
    int mn = min(min(min(a[0], a[1]), min(a[2], a[3])), min(min(b[0], b[1]), min(b[2], b[3]))), mx = max(max(max(a[0], a[1]), max(a[2], a[3])), max(max(b[0], b[1]), max(b[2], b[3])));
      mn = min(mn, xor_i<1>(mn)); mx = max(mx, xor_i<1>(mx)); mn = min(mn, xor_i<2>(mn)); mx = max(mx, xor_i<2>(mx)); mn = min(mn, xor_i<4>(mn)); mx = max(mx, xor_i<4>(mx));
      if ((tid & 7) == 0) { tmm[2 * (tid >> 3)] = mn; tmm[2 * (tid >> 3) + 1] = mx; } }
  } else { const int k_ = kt0 + tid; const int p_ = A.posb[KEYC(k_)]; posl[tid] = p_;
    ok_ = (k_ < 0 || k_ + 1 >= SEQ || tid == 511) ? true : (A.posb[k_ + 1] - p_ == 1); }
  if constexpr (MODE == M_WIN) { const bool w_ = __all(ok_); if (lane == 0) flg[wid] = w_ ? 1 : 0; }
  bf16x8 qr[ND0];
  { const bf16* Qw = A.Q + (size_t)(wq * 32 + r32) * A.ldq + half * 64 + hi * 8;
#pragma unroll
    for (int d0 = 0; d0 < ND0; ++d0) qr[d0] = *reinterpret_cast<const bf16x8*>(Qw + d0 * 16); }
  const int qpos = A.posb[A.q0 + wq * 32 + r32]; int qmin = 0, qmax = 0;
  if constexpr (MODE == M_DIFF) { int a = qpos, b = qpos;
    a = min(a, xor_i<1>(a)); b = max(b, xor_i<1>(b)); a = min(a, xor_i<2>(a)); b = max(b, xor_i<2>(b)); a = min(a, xor_i<4>(a)); b = max(b, xor_i<4>(b));
    a = min(a, xor_i<8>(a)); b = max(b, xor_i<8>(b)); a = min(a, xor_i<16>(a)); b = max(b, xor_i<16>(b));
    { auto ra = __builtin_amdgcn_permlane32_swap((unsigned)a, (unsigned)a, false, false); a = min((int)ra[0], (int)ra[1]); auto rb = __builtin_amdgcn_permlane32_swap((unsigned)b, (unsigned)b, false, false); b = max((int)rb[0], (int)rb[1]); }
    qmin = __builtin_amdgcn_readfirstlane(a); qmax = __builtin_amdgcn_readfirstlane(b); }
  const int kcolB = half * 128;
  float l_reg = 0.f; f32x16 o[4];
#pragma unroll
  for (int d = 0; d < 4; ++d)
#pragma unroll
    for (int r = 0; r < 16; ++r) o[d][r] = 0.f;
  const lds_cptr ring3 = (lds_cptr)ring;
  const lds_cptr vp0 = ring3 + v_rd_base(lane);
  const lds_cptr kp0 = ring3 + SHM_V + r32 * 256;
  const int kx0 = (kcolB + hi * 16) ^ ((r32 & 15) << 4);
#define SWRITEV(so, i) do { char* v_ = ring + (so); *(bf16x8*)(v_ + vst0) = sr_[i].vs0; *(bf16x8*)(v_ + vst1) = sr_[i].vs1; } while (0)
#define SWRITEK(so, i) do { char* k_ = ring + (so) + SHM_V; const int kc_ = sc * 2; *(bf16x8*)(k_ + KSWZ(sr, kc_)) = sr_[i].ks0; *(bf16x8*)(k_ + KSWZ(32 + sr, kc_)) = sr_[i].ks1; } while (0)
#define TILE_SETUP(t, CI, NEAR) do { NEAR = true; CI = 0.f; if constexpr (MODE == M_DIFF) { const int kmn_ = __builtin_amdgcn_readfirstlane(tmm[2 * (t)]), kmx_ = __builtin_amdgcn_readfirstlane(tmm[2 * (t) + 1]); \
    if (kmn_ - qmax >= NREL) { CI = cfar_pos; NEAR = false; } else if (kmx_ - qmin <= -NREL) { CI = cfar_neg; NEAR = false; } } } while (0)
#define RESC(CI) do { if constexpr (MODE == M_DIFF) if ((CI) != ccur) { const float f_ = __builtin_amdgcn_exp2f(ccur - (CI)); ccur = (CI); l_reg *= f_; \
      _Pragma("unroll") for (int d_ = 0; d_ < 4; ++d_) _Pragma("unroll") for (int r_ = 0; r_ < 16; ++r_) o[d_][r_] *= f_; } } while (0)
#define BIAS(C0, C1, t, NEAR) do { const int k0_ = kt0 + (t) * 64; \
    if (contig && k0_ >= 0 && k0_ < SEQ) { add_bias_fast(C0, C1, tbq + (t) * 64); } \
    else { if (NEAR) add_bias(C0, C1, posl + (t) * 64, tb, qpos, hi); \
      if constexpr (MODE == M_WIN) { win_mask(C0, C1, (k0_ < 0 || k0_ >= SEQ) ? 100000 : k0_ - (A.q0 + wq * 32 + r32) + 4 * hi); } } } while (0)
#define ROT() do { const int t_ = s_prev; s_prev = s_cur; s_cur = s_next; s_next = t_; } while (0)
#define KFRAG(SO, i) (*reinterpret_cast<const __attribute__((address_space(3))) bf16x8*>(kp0 + (SO) + ((i) & 1) * 8192 + (kx0 ^ (((i) >> 1) * 32))))
#define MF(a, b, c) __builtin_amdgcn_mfma_f32_32x32x16_bf16(a, b, c, 0, 0, 0)
#define PK4A(P, B) const unsigned a0_ = cvtpk(P[B + 0], P[B + 1]), a1_ = cvtpk(P[B + 2], P[B + 3])
#define PK4B(P, B, OUT) do { const unsigned b0_ = cvtpk(P[B + 4], P[B + 5]), b1_ = cvtpk(P[B + 6], P[B + 7]); u32x4 w_ = {a0_, a1_, b0_, b1_}; OUT = *reinterpret_cast<bf16x8*>(&w_); } while (0)
#define KR(i) (*((i) % 4 == 0 ? &ka_ : (i) % 4 == 1 ? &kb_ : (i) % 4 == 2 ? &kc_ : &kd_))
#define XS_N(s, C0, C1, SO) do { if (2 * (s) + 3 < NF) KR(2 * (s) + 3) = KFRAG(SO, 2 * (s) + 3); C0 = MF(KR(2 * (s)), qr[s], (s) == 0 ? z_ : C0); SBAR(); \
    if (2 * (s) + 4 < NF) KR(2 * (s) + 4) = KFRAG(SO, 2 * (s) + 4); C1 = MF(KR(2 * (s) + 1), qr[s], (s) == 0 ? z_ : C1); SBAR(); } while (0)
#define XS_F(s, C0, C1, SO, P, B, OUT) do { if (2 * (s) + 3 < NF) KR(2 * (s) + 3) = KFRAG(SO, 2 * (s) + 3); C0 = MF(KR(2 * (s)), qr[s], (s) == 0 ? z_ : C0); PK4A(P, B); SBAR(); \
    if (2 * (s) + 4 < NF) KR(2 * (s) + 4) = KFRAG(SO, 2 * (s) + 4); C1 = MF(KR(2 * (s) + 1), qr[s], (s) == 0 ? z_ : C1); PK4B(P, B, OUT); SBAR(); } while (0)
#define XPART(C0, C1, P0, P1, SO, FIN) do { const f32x16 z_ = {}; bf16x8 ka_ = KFRAG(SO, 0), kb_ = KFRAG(SO, 1), kc_ = KFRAG(SO, 2), kd_; SBAR(); \
    if constexpr (MODE == M_DIFF) { \
      if (FIN) { XS_F(0, C0, C1, SO, P0, 0, pa0); XS_F(1, C0, C1, SO, P0, 8, pa1); XS_F(2, C0, C1, SO, P1, 0, pa2); XS_F(3, C0, C1, SO, P1, 8, pa3); } \
      else { XS_N(0, C0, C1, SO); XS_N(1, C0, C1, SO); XS_N(2, C0, C1, SO); XS_N(3, C0, C1, SO); } \
    } else { \
      if (FIN) { XS_F(0, C0, C1, SO, P0, 0, pa0); XS_N(1, C0, C1, SO); XS_F(2, C0, C1, SO, P0, 8, pa1); XS_N(3, C0, C1, SO); XS_F(4, C0, C1, SO, P1, 0, pa2); XS_N(5, C0, C1, SO); XS_F(6, C0, C1, SO, P1, 8, pa3); XS_N(7, C0, C1, SO); } \
      else { XS_N(0, C0, C1, SO); XS_N(1, C0, C1, SO); XS_N(2, C0, C1, SO); XS_N(3, C0, C1, SO); XS_N(4, C0, C1, SO); XS_N(5, C0, C1, SO); XS_N(6, C0, C1, SO); XS_N(7, C0, C1, SO); } \
    } } while (0)
#define VLO(VP, i) vtr((VP) + v_rd_off((i) >> 2, (i) & 3, 0))
#define VHI(VP, i) vtr((VP) + v_rd_off((i) >> 2, (i) & 3, 1))
#define VPK(L, H) (bf16x8){L[0], L[1], L[2], L[3], H[0], H[1], H[2], H[3]}
#define PAK(i) (((i) & 3) == 0 ? pa0 : ((i) & 3) == 1 ? pa1 : ((i) & 3) == 2 ? pa2 : pa3)
#define FADD(a, b) ({ float r_; asm("v_add_f32_e32 %0, %1, %2" : "=v"(r_) : "v"(a), "v"(b)); r_; })
#define YG(i, C0, C1, VP, DOEXP, EXTRA) do { if ((i) + VD - 1 < 16) { vl_[((i) + VD - 1) % VD] = VLO(VP, (i) + VD - 1); vh_[((i) + VD - 1) % VD] = VHI(VP, (i) + VD - 1); } \
    o[(i) >> 2] = MF(PAK(i), VPK(vl_[(i) % VD], vh_[(i) % VD]), o[(i) >> 2]); \
    if (DOEXP) { C0[i] = __builtin_amdgcn_exp2f(C0[i]); C1[i] = __builtin_amdgcn_exp2f(C1[i]); if ((i) > 0) { sA_ = FADD(sA_, C0[(i) - 1]); sB_ = FADD(sB_, C1[(i) - 1]); } } \
    EXTRA; SBAR(); } while (0)
#define NOP_ do { } while (0)
#define YPART(C0, C1, PSN, SOV, DOEXP, STG) do { const lds_cptr vp_ = vp0 + (SOV); float sA_ = 0.f, sB_ = 0.f; s16x4 vl_[VD], vh_[VD]; \
    _Pragma("unroll") for (int q_ = 0; q_ < VD - 1; ++q_) { vl_[q_] = vtr(vp_ + v_rd_off(q_ >> 2, q_ & 3, 0)); vh_[q_] = vtr(vp_ + v_rd_off(q_ >> 2, q_ & 3, 1)); } SBAR(); \
    YG(0, C0, C1, vp_, DOEXP, NOP_); YG(1, C0, C1, vp_, DOEXP, NOP_); YG(2, C0, C1, vp_, DOEXP, NOP_); YG(3, C0, C1, vp_, DOEXP, NOP_); \
    YG(4, C0, C1, vp_, DOEXP, NOP_); YG(5, C0, C1, vp_, DOEXP, NOP_); YG(6, C0, C1, vp_, DOEXP, NOP_); YG(7, C0, C1, vp_, DOEXP, NOP_); \
    YG(8, C0, C1, vp_, DOEXP, STG(0)); YG(9, C0, C1, vp_, DOEXP, STG(1)); YG(10, C0, C1, vp_, DOEXP, STG(2)); YG(11, C0, C1, vp_, DOEXP, STG(3)); \
    YG(12, C0, C1, vp_, DOEXP, STG(4)); YG(13, C0, C1, vp_, DOEXP, STG(5)); YG(14, C0, C1, vp_, DOEXP, STG(6)); YG(15, C0, C1, vp_, DOEXP, STG(7)); \
    if (DOEXP) { sA_ = FADD(sA_, C0[15]); sB_ = FADD(sB_, C1[15]); PSN = sA_ + sB_; } } while (0)
  f32x16 pA0, pA1, pB0, pB1; bf16x8 pa0, pa1, pa2, pa3; float ciA, ciB, psA = 0.f, psB = 0.f; bool nearA, nearB;
  int ta = 0; if constexpr (MODE == M_WIN) { ta = wq >> 1; asm volatile("" : "+s"(ta)); }
  const int tend = (MODE == M_WIN) ? ta + 6 : NT;
#define STAGE_STEP(t) do { SWRITEV(s_next, 0); SLOADV(0, ((t) + 2 < NT ? (t) + 2 : NT - 1)); SWRITEK(s_next, 0); SLOADK(0, ((t) + 2 < NT ? (t) + 2 : NT - 1)); __syncthreads(); ROT(); } while (0)
  int s_prev = 2 * DSLOT, s_cur = 0, s_next = DSLOT;
  SWRITEV(0, 0); SWRITEK(0, 0); SLOADV(0, 1); SLOADK(0, 1);
  __syncthreads();
  const float cfar_pos = (MODE == M_DIFF) ? tb[2 * NREL] : 0.f, cfar_neg = (MODE == M_DIFF) ? tb[0] : 0.f;
#ifndef PROBE_NOCONTIG
#define PROBE_NOCONTIG 0
#endif
  const bool contig = (MODE == M_WIN) && !PROBE_NOCONTIG && __builtin_amdgcn_readfirstlane(flg[0] & flg[1] & flg[2] & flg[3] & flg[4] & flg[5] & flg[6] & flg[7]) != 0;
  const float* tbq = tbm + (TBM_OFF + kt0 - (A.q0 + wq * 32 + r32) + 4 * hi);
  float ccur = 0.f;
  if constexpr (MODE == M_WIN) { _Pragma("nounroll") for (int t = 0; t < ta; ++t) STAGE_STEP(t); }
  TILE_SETUP(ta, ciA, nearA); XPART(pA0, pA1, pA0, pA1, s_cur, false);
  BIAS(pA0, pA1, ta, nearA);
  exp_half(pA0); exp_half(pA1);
  { float t_ = 0.f;
#pragma unroll
    for (int r = 0; r < 16; ++r) t_ += pA0[r] + pA1[r];
    psA = t_; }
  SWRITEV(s_next, 0); SWRITEK(s_next, 0); SLOADV(0, (ta + 2 < NT ? ta + 2 : NT - 1)); SLOADK(0, (ta + 2 < NT ? ta + 2 : NT - 1)); __syncthreads(); ROT();
#define STG_(SI, TW, TL, k) do { if ((k) == 0) SWRITEV(s_next, SI); if ((k) == 1) SLOADV(SI, TL); if ((k) == 2) SWRITEK(s_next, SI); if ((k) == 3) SLOADK(SI, TL); } while (0)
#define STG_A(k) STG_(0, j + 1, (j + 2 < NT ? j + 2 : NT - 1), k)
#define STG_B(k) STG_(0, j + 2, (j + 3 < NT ? j + 3 : NT - 1), k)
#define STG_N(k) NOP_
  if (ATT_PRIO && wid >= 4) __builtin_amdgcn_s_setprio(1);
  _Pragma("nounroll") for (int j = ta + 1; j + 1 < tend; j += 2) {
    TILE_SETUP(j, ciB, nearB); XPART(pB0, pB1, pA0, pA1, s_cur, true);
    RESC(ciA); l_reg += psA; BIAS(pB0, pB1, j, nearB);
    YPART(pB0, pB1, psB, s_prev, true, STG_A);
    __syncthreads(); ROT();
    TILE_SETUP(j + 1, ciA, nearA); XPART(pA0, pA1, pB0, pB1, s_cur, true);
    RESC(ciB); l_reg += psB; BIAS(pA0, pA1, j + 1, nearA);
    YPART(pA0, pA1, psA, s_prev, true, STG_B);
    __syncthreads(); ROT();
  }
  TILE_SETUP(tend - 1, ciB, nearB); XPART(pB0, pB1, pA0, pA1, s_cur, true);
  RESC(ciA); l_reg += psA; BIAS(pB0, pB1, tend - 1, nearB);
  YPART(pB0, pB1, psB, s_prev, true, STG_N);
  { PK4A(pB0, 0); PK4B(pB0, 0, pa0); } { PK4A(pB0, 8); PK4B(pB0, 8, pa1); } { PK4A(pB1, 0); PK4B(pB1, 0, pa2); } { PK4A(pB1, 8); PK4B(pB1, 8, pa3); }
  RESC(ciB); l_reg += psB;
  YPART(pA0, pA1, psA, s_cur, false, STG_N);
  if constexpr (MODE == M_WIN) { _Pragma("nounroll") for (int t = tend - 1; t < NT; ++t) STAGE_STEP(t); }
  if (ATT_PRIO && wid >= 4) __builtin_amdgcn_s_setprio(0);
  attn_epilogue<MODE>(o, l_reg, A, ring, extra);
  asm volatile("s_waitcnt lgkmcnt(0)" ::: "memory");
  __syncthreads();
#undef KEYC
#undef BIAS
#undef KR
#undef XS_N
#undef XS_F
#undef SLOADV
#undef SLOADK
#undef SWRITEV
#undef SWRITEK
#undef TILE_SETUP
#undef STAGE_STEP
#undef RESC
#undef ROT
#undef KFRAG
#undef MF
#undef PK4A
#undef PK4B
#undef XPART
#undef VLO
#undef VHI
#undef VPK
#undef PAK
#undef YG
#undef FADD
#undef NOP_
#undef YPART
#undef STG_
#undef STG_A
#undef STG_B
#undef STG_N
}
template <int MODE>
__device__ __forceinline__ void attn_unit_simple(char* ring, char* extra, const UnitArgs& A) {
  constexpr int ND0 = 8, LDK = (MODE == M_WIN) ? INB : 512;
  int NT = (MODE == M_WIN) ? 8 : MEML / 64; asm volatile("" : "+s"(NT));
  int tid = threadIdx.x; asm volatile("" : "+v"(tid));
  const int wid = __builtin_amdgcn_readfirstlane(tid >> 6), lane = tid & 63, r32 = lane & 31, hi = lane >> 5;
  const int wq = wid;
  char* V_lds = ring + L_V; char* K_lds = ring + L_K;
  int* posl = (int*)(extra + X_POS); float* tb = (float*)(extra + X_TB);
  const int kt0 = (MODE == M_WIN) ? A.q0 - 128 : 0;
#define KEYC(k) ((MODE == M_WIN) ? ((k) < 0 ? 0 : ((k) > SEQ - 1 ? SEQ - 1 : (k))) : (k))
  if (MODE == M_WIN) { if (tid < 2 * NREL + 1) tb[tid] = A.relb[t5_bucket(tid - NREL) * NH + A.h] * LOG2E; posl[tid] = A.posb[KEYC(kt0 + tid)]; }
  bf16x8 qr[ND0];
  { const bf16* Qw = A.Q + (size_t)(wq * 32 + r32) * A.ldq + hi * 8;
#pragma unroll
    for (int d0 = 0; d0 < ND0; ++d0) qr[d0] = *reinterpret_cast<const bf16x8*>(Qw + d0 * 16); }
  int qpos = 0; if (MODE == M_WIN) qpos = A.posb[A.q0 + wq * 32 + r32];
  float l_reg = 0.f; f32x16 o[4];
#pragma unroll
  for (int d = 0; d < 4; ++d)
#pragma unroll
    for (int r = 0; r < 16; ++r) o[d][r] = 0.f;
  const int sr = tid >> 4, sc = (tid & 15) * 8, vst0 = v_st(sr, sc), vst1 = v_st(32 + sr, sc);
  const int vb0 = (int)(uintptr_t)V_lds + v_rd_base(lane);
  bf16x8 vs0, vs1, ks0, ks1;
#define SLOAD(t) do { const int k0_ = kt0 + (t) * 64; const int ka_ = KEYC(k0_ + sr), kb_ = KEYC(k0_ + 32 + sr); \
    vs0 = *reinterpret_cast<const bf16x8*>(A.V + (size_t)ka_ * LDK + sc); vs1 = *reinterpret_cast<const bf16x8*>(A.V + (size_t)kb_ * LDK + sc); \
    ks0 = *reinterpret_cast<const bf16x8*>(A.K + (size_t)ka_ * LDK + sc); ks1 = *reinterpret_cast<const bf16x8*>(A.K + (size_t)kb_ * LDK + sc); } while (0)
#define SWRITE(b) do { *(bf16x8*)(V_lds + (b) * SHM_V + vst0) = vs0; *(bf16x8*)(V_lds + (b) * SHM_V + vst1) = vs1; const int kc_ = sc * 2; \
    *(bf16x8*)(K_lds + (b) * SHM_K + KSWZ(sr, kc_)) = ks0; *(bf16x8*)(K_lds + (b) * SHM_K + KSWZ(32 + sr, kc_)) = ks1; } while (0)
  SLOAD(0); SWRITE(0); __syncthreads();
  _Pragma("nounroll") for (int t = 0; t < NT; ++t) {
    const int b = t & 1;
    if (t + 1 < NT) SLOAD(t + 1);
    f32x16 p0, p1; bf16x8 pa0, pa1, pa2, pa3;
    qkt<ND0>(p0, p1, K_lds + b * SHM_K, qr, r32, hi, 0);
    if (MODE == M_WIN) { add_bias(p0, p1, posl + t * 64, tb, qpos, hi);
      const int k0_ = kt0 + t * 64; const int dq = (k0_ < 0 || k0_ >= SEQ) ? 100000 : k0_ - (A.q0 + wq * 32 + r32) + 4 * hi; win_mask(p0, p1, dq); }
    exp_half(p0); finishSM(p0, p1, l_reg, pa0, pa1, pa2, pa3); SBAR();
    pv_d0(o, vb0 + b * SHM_V, pa0, pa1, pa2, pa3);
    if (t + 1 < NT) SWRITE(b ^ 1);
    __syncthreads();
  }
  attn_epilogue<MODE>(o, l_reg, A, ring, extra);
  asm volatile("s_waitcnt lgkmcnt(0)" ::: "memory");
  __syncthreads();
#undef KEYC
#undef SLOAD
#undef SWRITE
}
#undef KSWZ
#undef SBAR
}
__device__ __forceinline__ int panel_of(int c) { return 4 * (c % 8) + (c / 8) % 4; }
__device__ __forceinline__ bool panel_same_xcd(gu32* ctl) {
    const int c = (int)blockIdx.x; bool same = true; const unsigned mine = xb_ld((unsigned*)(ctl + CW_XCC + c));
#pragma unroll
    for (int m = 0; m < 8; ++m) { const unsigned o = xb_ld((unsigned*)(ctl + CW_XCC + (c % 8) + 8 * ((c / 8) % 4 + 4 * m))); same = same && (o == mine) && (o != 0u); }
    return __builtin_amdgcn_readfirstlane(same ? 1 : 0) != 0;
}
__device__ __forceinline__ void panel_barrier(gu32* ctl, unsigned target, bool same_xcd) {
    asm volatile("s_waitcnt vmcnt(0)" ::: "memory");
    __syncthreads();
    if (threadIdx.x == 0) {
        unsigned* cnt = (unsigned*)(ctl + CW_PANEL + 64 * panel_of((int)blockIdx.x));
        if (same_xcd) {
            asm volatile("buffer_inv sc1" ::: "memory");
            (void)xb_add(cnt, 1u);
            unsigned sp = 0;
            while (xb_ld(cnt) < target) { __builtin_amdgcn_s_sleep(1); if (++sp > (1u << 22)) break; }
            asm volatile("s_waitcnt vmcnt(0)" ::: "memory");
        } else {
            __builtin_amdgcn_fence(__ATOMIC_RELEASE, "agent");
            asm volatile("s_waitcnt vmcnt(0)" ::: "memory");
            (void)xb_add(cnt, 1u);
            unsigned sp = 0;
            while (xb_ld(cnt) < target) { __builtin_amdgcn_s_sleep(1); if (++sp > (1u << 22)) break; }
            __builtin_amdgcn_fence(__ATOMIC_ACQUIRE, "agent");
            asm volatile("s_waitcnt vmcnt(0)" ::: "memory");
        }
    }
    __syncthreads();
}


__device__ __forceinline__ void mem_units(Frame& F, int layer, int ldq, int qm_col, int cu_off, int xl = 0) {
    char* ring = (char*)F.ldsg + RING_OFF; char* extra = (char*)F.ldsg + EXTRA_OFF;
    const bf16* proj = (const bf16*)(F.ws + WS_PROJ); bf16* heads = (bf16*)(F.ws + WS_HEADS);
#ifndef REP_MEM
#define REP_MEM 1
#endif
    const int pc_ = panel_of((int)blockIdx.x), mm_ = (int)blockIdx.x / 32;
    for (int uu = xl ? (mm_ >= 4 ? 0 : REP_MEM * NB * NMH * (SEQ / 256)) : (F.vcu + F.G - cu_off % F.G) % F.G; uu < REP_MEM * NB * NMH * (SEQ / 256); uu += xl ? REP_MEM * NB * NMH * (SEQ / 256) : F.G) { const int u = uu % (NB * NMH * (SEQ / 256));
        int qb = u % (SEQ / 256), bh = u / (SEQ / 256), b = bh / NMH, hm = bh % NMH; if (xl) { b = pc_ / (SEQ / 256); qb = pc_ % (SEQ / 256); hm = mm_ - 4; } const size_t tok0 = (size_t)b * SEQ + qb * 256;
        att::UnitArgs A{};
        A.Q = proj + tok0 * ldq + qm_col + hm * 128; A.ldq = ldq;
        A.K = (const bf16*)(F.ws + WS_KM) + (size_t)(layer * MEMR + b * MEML) * 512 + hm * 128; A.V = (const bf16*)(F.ws + WS_VM) + (size_t)(layer * MEMR + b * MEML) * 512 + hm * 128;
        A.O = heads + tok0 * DM + MIXW + hm * 128; A.posb = nullptr; A.relb = nullptr; A.h = 0; A.q0 = qb * 256; A.sinkl2 = 0.f; A.lam = 0.f; A.subln = nullptr;
        att::attn_unit_simple<att::M_MEM>(ring, extra, A);
    }
}
__device__ __forceinline__ void phase_attn_a(Frame& F) {
    char* ring = (char*)F.ldsg + RING_OFF; char* extra = (char*)F.ldsg + EXTRA_OFF;
    const bf16* proj = (const bf16*)(F.ws + WS_PROJ); bf16* heads = (bf16*)(F.ws + WS_HEADS);
    {
        float lam; { const float a = wave_sum(F.in[10][cur_lane()] * F.in[11][cur_lane()]), b = wave_sum(F.in[12][cur_lane()] * F.in[13][cur_lane()]); lam = expf(a) - expf(b) + LAM_INIT0; }
#ifndef REP_DIFF
#define REP_DIFF 1
#endif
        const int pc_ = panel_of((int)blockIdx.x), mm_ = (int)blockIdx.x / 32, nU_ = REP_DIFF * NB * NH * (SEQ / 128);
        for (int uu = F.xl ? 0 : F.vcu; uu < nU_; uu += F.xl ? nU_ / 3 : F.G) { const int u = uu % (NB * NH * (SEQ / 128));
            int qb = u % (SEQ / 128), bh = u / (SEQ / 128), b = bh / NH, h = bh % NH; if (F.xl) { b = pc_ / (SEQ / 256); qb = 2 * (pc_ % (SEQ / 256)) + (mm_ >> 2); h = (mm_ & 3) + 4 * (uu / (nU_ / 3)); }
            const size_t tok0 = (size_t)b * SEQ + qb * 128;
            att::UnitArgs A{};
            A.Q = proj + tok0 * INA + h * 128; A.ldq = INA;
            A.K = proj + (size_t)b * SEQ * INA + A_K + h * 128; A.V = proj + (size_t)b * SEQ * INA + A_V + h * 128;
            A.O = heads + tok0 * DM + h * 128; A.posb = (const int*)F.in[2] + b * SEQ; A.relb = F.in[3]; A.h = h; A.q0 = qb * 128;
            A.sinkl2 = 0.f; A.lam = lam; A.subln = F.in[14];
            att::attn_unit_pipe<att::M_DIFF>(ring, extra, A);
        }
    }
    mem_units(F, 0, INA, A_QM, (NB * NH * (SEQ / 128)) % F.G, F.xl);
    if (F.G == 256 && (F.xl ? (int)blockIdx.x < 128 : F.vcu >= 128)) { convert_weights<CONV_P0>(F, (F.xl ? (int)blockIdx.x : F.vcu - 128) * NWAVES + F.wave, 128 * NWAVES, CONV_P2_ITEMS, 0);
        if (F.xl) { asm volatile("s_waitcnt vmcnt(0)" ::: "memory"); __syncthreads();
            if (threadIdx.x == 0) { __builtin_amdgcn_fence(__ATOMIC_RELEASE, "agent"); asm volatile("s_waitcnt vmcnt(0)" ::: "memory"); (void)xb_add((unsigned*)(F.ctl + CW_CONVDONE), 1u); } } }
}
__device__ __forceinline__ void phase_attn_b(Frame& F) {
    char* ring = (char*)F.ldsg + RING_OFF; char* extra = (char*)F.ldsg + EXTRA_OFF;
    const bf16* proj = (const bf16*)(F.ws + WS_PROJ); bf16* heads = (bf16*)(F.ws + WS_HEADS);
    {
#ifndef REP_WIN
#define REP_WIN 1
#endif
        const int pc_ = panel_of((int)blockIdx.x), mm_ = (int)blockIdx.x / 32, nU_ = REP_WIN * NB * NH * (SEQ / 256);
        for (int uu = F.xl ? (mm_ < 4 ? 0 : nU_ / 2) : F.vcu; uu < nU_; uu += F.xl ? nU_ / 2 : F.G) { const int u = uu % (NB * NH * (SEQ / 256));
            int qb = u % (SEQ / 256), bh = u / (SEQ / 256), b = bh / NH, h = bh % NH; if (F.xl) { b = pc_ / (SEQ / 256); qb = pc_ % (SEQ / 256); h = mm_ + (uu == 0 ? 8 : 0); }
            const int kvh = h / 3; const size_t tok0 = (size_t)b * SEQ + qb * 256;
            att::UnitArgs A{};
            A.Q = proj + tok0 * INB + h * 128; A.ldq = INB;
            A.K = proj + (size_t)b * SEQ * INB + B_K + kvh * 128; A.V = proj + (size_t)b * SEQ * INB + B_V + kvh * 128;
            A.O = heads + tok0 * DM + h * 128; A.posb = (const int*)F.in[2] + b * SEQ; A.relb = F.in[3]; A.h = h; A.q0 = qb * 256;
            A.sinkl2 = F.in[18][h] * LOG2E; A.lam = 0.f; A.subln = nullptr;
            att::attn_unit_pipe<att::M_WIN>(ring, extra, A);
        }
    }
    mem_units(F, 1, INB, B_QM, (NB * NH * (SEQ / 256)) % F.G, F.xl);
    if (F.G == 256 && F.vcu >= 128) convert_weights<CONV_P6>(F, (F.vcu - 128) * NWAVES + F.wave, 128 * NWAVES, CONV_P7_ITEMS, 0);
}

struct Args { const float* in[25]; float* out; unsigned char* ws; int ph_lo, ph_hi, li, pad; };
__global__ void __launch_bounds__(NWAVES * 64, 2) mk_fwd(Args args) {
    extern __shared__ __attribute__((aligned(16))) unsigned char lds[];
    Frame F;
    F.lds = (LAS unsigned char*)lds; F.ldsg = lds;
    F.MISC = (volatile LAS unsigned*)(F.lds + MISC_OFF);
    F.wave = __builtin_amdgcn_readfirstlane((int)threadIdx.x >> 6);
    F.G = gridDim.x; { const int bx = blockIdx.x; F.vcu = (F.G % 8 == 0) ? (bx % 8) * (F.G / 8) + bx / 8 : bx; }
    F.ws = args.ws; F.out = args.out; F.ctl = (gu32*)(args.ws + WS_CTL);
#pragma unroll
    for (int i = 0; i < 25; ++i) F.in[i] = args.in[i];
    for (int u = (F.wave * 64 + cur_lane()); u < (LDS_BYTES - LDSCTL_OFF) / 4; u += NWAVES * 64) ((LAS unsigned*)(F.lds + LDSCTL_OFF))[u] = 0u;
    if (threadIdx.x == 0 && blockIdx.x < 256) __hip_atomic_store((unsigned*)(F.ctl + CW_XCC + blockIdx.x), 1u + xb_xcc_id(), __ATOMIC_RELAXED, __HIP_MEMORY_SCOPE_AGENT);
    __syncthreads();
    const bool single = (args.ph_hi - args.ph_lo) > 1;
    XcdBarrier bar; bar.bar = (unsigned*)(F.ctl + CW_BAR); bar.x = 0; bar.st = nullptr;
    if (single) bar = xcd_barrier_post((unsigned*)(F.ctl + CW_BAR), F.MISC + 8);
    const int lo = args.ph_lo, hi = args.ph_hi;
#define IN(k) (lo <= (k) && (k) < hi)
#ifndef REP_PHASE
#define REP_PHASE -1
#endif
#define REPS(k) for (int rep_ = 0; rep_ < ((REP_PHASE) == (k) ? 2 : 1); ++rep_)
#ifndef PROBE_PHASE
#define PROBE_PHASE -1
#endif
    unsigned long long tpa_ = 0, tpb_ = 0;
#ifndef PROBE_CLK
#define PROBE_CLK 0
#endif
    unsigned long long tca_ = 0, tcb_ = 0;
#define TP_A(k) do { if ((PROBE_PHASE) == (k)) { tpa_ = rt(); if (PROBE_CLK) tca_ = __builtin_amdgcn_s_memtime(); } } while (0)
#define TP_B(k) do { if ((PROBE_PHASE) == (k)) { tpb_ = rt(); if (PROBE_CLK) tcb_ = __builtin_amdgcn_s_memtime(); } } while (0)
#ifndef UP_ALIGN
#define UP_ALIGN true
#endif
#ifndef PROBE_2BAR
#define PROBE_2BAR 0
#endif
#define SEAM(k) do { if (IN(k) && IN((k) + 1)) { xcd_barrier(bar); if (PROBE_2BAR) xcd_barrier(bar); } } while (0)
#ifndef PANEL_SEAMS
#define PANEL_SEAMS 1
#endif
#define PSEAM(k, target) do { if (IN(k) && IN((k) + 1)) { if (XL) panel_barrier(F.ctl, target, same_xcd); else xcd_barrier(bar); } } while (0)
    bf16* const XB = (bf16*)(F.ws + WS_HN);
    bf16* const PROJ = (bf16*)(F.ws + WS_PROJ); bf16* const HEADS = (bf16*)(F.ws + WS_HEADS); bf16* const U = (bf16*)(F.ws + WS_U);
    bf16* const WA = (bf16*)(F.ws + WS_WA); bf16* const WB = (bf16*)(F.ws + WS_WB); bf16* const WM = (bf16*)(F.ws + WS_WMKV);
    bf16* const WO = (bf16*)(F.ws + WS_WOUT); bf16* const WU = (bf16*)(F.ws + WS_WUP); bf16* const WD = (bf16*)(F.ws + WS_WDN);

    float* const RSQ_X = (float*)(F.ctl + CW_RSQ_X); float* const RSQ_M = (float*)(F.ctl + CW_RSQ_M);
    float* const RSQ_MLP0 = (float*)(F.ctl + CW_RSQ_MLP0); float* const RSQ_ATT1 = (float*)(F.ctl + CW_RSQ_ATT1); float* const RSQ_MLP1 = (float*)(F.ctl + CW_RSQ_MLP1);
    LAS float* const XB_LDS = (LAS float*)(F.lds + EXTRA_OFF);
    LAS float* const XG = (LAS float*)(F.lds + EXTRA_OFF + 8192);
    constexpr float INVK = 1.f / DM;
    const int XL = (PANEL_SEAMS && F.G == 256 && single && lo == 0) ? 1 : 0; F.xl = XL;
    TP_A(0); if (IN(0)) REPS(0) { p0_prologue(F); } SEAM(0); TP_B(0);
#ifndef PROBE_FORCE_NOTSAME
#define PROBE_FORCE_NOTSAME 0
#endif
    const bool same_xcd = (XL && !PROBE_FORCE_NOTSAME) ? panel_same_xcd(F.ctl) : false;
    TP_A(1); if (IN(1)) REPS(1) {
        const int ncu = F.G >= 256 ? GEMM_CUS_P1 : F.G;
        if ((int)blockIdx.x >= ncu) { convert_weights<CONV_P1, CONV_DEPTH>(F, ((int)blockIdx.x - ncu) * NWAVES + F.wave, (F.G - ncu) * NWAVES, -1, CONV_P1_BACK_ITEMS);
                                      if (CONV_P1Y_ITEMS > 0) convert_weights<CONV_P0, CONV_DEPTH>(F, ((int)blockIdx.x - ncu) * NWAVES + F.wave, (F.G - ncu) * NWAVES, CONV_P2_ITEMS + CONV_P1X_ITEMS + CONV_P1Y_ITEMS, CONV_P2_ITEMS + CONV_P1X_ITEMS);
                                      } else {
        pg8::Gemm g{XB, WA, NTOK, INA, DM}; pg8::ComboOrder S; S.init(NTOK, INA, ncu, (int)blockIdx.x); S.A2 = (const bf16*)(F.ws + WS_MN); S.B2 = WM; S.nx = 16;
        if ((F.wave * 64 + cur_lane()) < 128) { const int t = (F.wave * 64 + cur_lane()); XG[t] = F.in[8][t & 63]; XG[128 + t] = F.in[9][t & 63]; XG[256 + t] = 1.f; XG[384 + t] = F.in[20][t]; XG[512 + t] = F.in[21][t]; XG[640 + t] = F.in[21][128 + t]; }
        __syncthreads();
        pg8::EpiProj<0> E{PROJ, INA, RSQ_X, INVK, (bf16*)(F.ws + WS_KM), (bf16*)(F.ws + WS_VM), RSQ_M, XB_LDS, XG, QS64, QS128};
        pg8::gemm_phase<pg8::EpiProj<0>, pg8::ComboOrder, true, true>(F.lds + RING_OFF, g, S, E);
        { const int nu = (NTOK / 256) * (INA / 256) + 16, nfull = nu % ncu;
          if (F.G >= 256 && CONV_P1X_ITEMS > 0 && nfull > 0 && (int)blockIdx.x >= nfull) { asm volatile("s_waitcnt vmcnt(0)" ::: "memory"); __syncthreads();
              convert_weights<CONV_P0>(F, ((int)blockIdx.x - nfull) * NWAVES + F.wave, (ncu - nfull) * NWAVES, CONV_P2_ITEMS + CONV_P1X_ITEMS, CONV_P2_ITEMS); } } }
        if (F.G < 256) convert_weights<CONV_P1>(F, F.vcu * NWAVES + F.wave, F.G * NWAVES);
    } SEAM(1); TP_B(1);
    TP_A(2); if (IN(2)) REPS(2) { phase_attn_a(F); } PSEAM(2, 8u); TP_B(2);
    TP_A(3); if (IN(3)) REPS(3) {
        pg8::Gemm g{HEADS, WO, NTOK, DM, DM}; pg8::StaticOrder S; S.init(NTOK, DM, F.G, (int)blockIdx.x, XL);
        pg8::EpiRes<false, false> E{XB, XB, DM, RSQ_MLP0};
        pg8::gemm_phase<pg8::EpiRes<false, false>, pg8::StaticOrder, false, true>(F.lds + RING_OFF, g, S, E);
    } PSEAM(3, 16u); TP_B(3);
    TP_A(4); if (IN(4)) REPS(4) {
        pg8::Gemm g{XB, WU, NTOK, DFF, DM}; pg8::StaticOrder S; S.init(NTOK, DFF, F.G, (int)blockIdx.x, XL);
        pg8::EpiUp E{U, DFF, RSQ_MLP0, INVK};
        pg8::gemm_phase<pg8::EpiUp, pg8::StaticOrder, UP_ALIGN, true>(F.lds + RING_OFF, g, S, E);
    }
    if (XL && IN(4) && IN(5) && threadIdx.x == 0) {
        unsigned sp = 0; while (xb_ld((unsigned*)(F.ctl + CW_CONVDONE)) < 128u) { __builtin_amdgcn_s_sleep(1); if (++sp > (1u << 22)) break; } }
    PSEAM(4, 24u); TP_B(4);
    TP_A(5); if (IN(5)) REPS(5) {
        pg8::Gemm g{U, WD, NTOK, DM, DFF}; pg8::StaticOrder S; S.init(NTOK, DM, F.G, (int)blockIdx.x, XL);
        pg8::EpiRes<false, false> E{XB, XB, DM, RSQ_ATT1};
        pg8::gemm_phase<pg8::EpiRes<false, false>, pg8::StaticOrder, false, true>(F.lds + RING_OFF, g, S, E);
    } PSEAM(5, 32u); TP_B(5);
    TP_A(6); if (IN(6)) REPS(6) {
        const int ncu = F.G >= 256 ? GEMM_CUS_P6 : F.G;
        if ((int)blockIdx.x >= ncu) { convert_weights<CONV_P6, CONV_DEPTH>(F, ((int)blockIdx.x - ncu) * NWAVES + F.wave, (F.G - ncu) * NWAVES, -1, F.G == 256 ? CONV_P7_ITEMS : 0); } else {
        pg8::Gemm g{XB, WB, NTOK, INB, DM}; pg8::ComboOrder S; S.init(NTOK, INB, ncu, (int)blockIdx.x, XL); S.A2 = (const bf16*)(F.ws + WS_MN); S.B2 = WM; S.nx = 0;
        if ((F.wave * 64 + cur_lane()) < 128) { const int t = (F.wave * 64 + cur_lane()); XG[t] = F.in[16][t]; XG[128 + t] = F.in[17][t]; XG[256 + t] = 1.f; XG[384 + t] = F.in[20][128 + t]; XG[512 + t] = F.in[21][t]; XG[640 + t] = F.in[21][128 + t]; }
        __syncthreads();
        pg8::EpiProj<1> E{PROJ, INB, RSQ_ATT1, INVK, (bf16*)(F.ws + WS_KM), (bf16*)(F.ws + WS_VM), RSQ_M, XB_LDS, XG, QS64, QS128};
        pg8::gemm_phase<pg8::EpiProj<1>, pg8::ComboOrder, true, true>(F.lds + RING_OFF, g, S, E); }
        if (F.G < 256) convert_weights<CONV_P6>(F, F.vcu * NWAVES + F.wave, F.G * NWAVES);
    } SEAM(6); TP_B(6);
    TP_A(7); if (IN(7)) REPS(7) { phase_attn_b(F); } PSEAM(7, 40u); TP_B(7);
    TP_A(8); if (IN(8)) REPS(8) {
        pg8::Gemm g{HEADS, WO + (size_t)DM * DM, NTOK, DM, DM}; pg8::StaticOrder S; S.init(NTOK, DM, F.G, (int)blockIdx.x, XL);
        pg8::EpiRes<false, false> E{XB, XB, DM, RSQ_MLP1};
        pg8::gemm_phase<pg8::EpiRes<false, false>, pg8::StaticOrder, false, true>(F.lds + RING_OFF, g, S, E);
    } PSEAM(8, 48u); TP_B(8);
    TP_A(9); if (IN(9)) REPS(9) {
        pg8::Gemm g{XB, WU + (size_t)DFF * DM, NTOK, DFF, DM}; pg8::StaticOrder S; S.init(NTOK, DFF, F.G, (int)blockIdx.x, XL);
        pg8::EpiUp E{U, DFF, RSQ_MLP1, INVK};
        pg8::gemm_phase<pg8::EpiUp, pg8::StaticOrder, UP_ALIGN, true>(F.lds + RING_OFF, g, S, E);
    } PSEAM(9, 56u); TP_B(9);
    TP_A(10); if (IN(10)) REPS(10) {
        pg8::Gemm g{U, WD + (size_t)DM * DFF, NTOK, DM, DFF}; pg8::StaticOrder S; S.init(NTOK, DM, F.G, (int)blockIdx.x, XL);
        pg8::EpiRes<false, true> E{XB, F.out, DM, nullptr};
        pg8::gemm_phase<pg8::EpiRes<false, true>, pg8::StaticOrder, false, true>(F.lds + RING_OFF, g, S, E);
    }
    if ((PROBE_PHASE) >= 0) { if ((PROBE_PHASE) == N_PHASES - 1) tpb_ = rt(); if (blockIdx.x == 0) { const unsigned long long t0_ = rt(), d_ = PROBE_CLK ? (tcb_ - tca_) * 1000ull / (tpb_ - tpa_) : 8ull * (tpb_ - tpa_); while (rt() - t0_ < d_) __builtin_amdgcn_s_sleep(8); } }
#ifdef PROBE_EPI
    if (blockIdx.x == 0) { const unsigned long long t0_ = rt(), d_ = 8ull * F.MISC[16]; while (rt() - t0_ < d_) __builtin_amdgcn_s_sleep(8); }
#endif
#undef IN
#undef SEAM
}

#ifndef MK_ONE_LAUNCH
#define MK_ONE_LAUNCH 1
#endif
extern "C" void kernel_launch(void* const* d_in, const int* in_sizes, int n_in, void* d_out, int out_size, void* d_ws, size_t ws_size, hipStream_t stream) {
    static int grid = 0;
    if (grid == 0) {
        if (n_in != 25 || in_sizes[0] != NTOK * DM || out_size != NTOK * DM || ws_size < WS_END) { fprintf(stderr, "kernel_launch: unexpected shapes: n_in %d in0 %d out %d ws %zu (need %zu)\n", n_in, n_in > 0 ? in_sizes[0] : -1, out_size, ws_size, (size_t)WS_END); grid = -1; return; }
        int dev = 0, cus = 0;
        if (hipGetDevice(&dev) != hipSuccess || hipDeviceGetAttribute(&cus, hipDeviceAttributeMultiprocessorCount, dev) != hipSuccess) { fprintf(stderr, "kernel_launch: device query failed\n"); grid = -1; return; }
        if (hipFuncSetAttribute((const void*)mk_fwd, hipFuncAttributeMaxDynamicSharedMemorySize, LDS_BYTES) != hipSuccess) { fprintf(stderr, "kernel_launch: hipFuncSetAttribute failed\n"); grid = -1; return; }
        int per_cu = 0;
        if (hipOccupancyMaxActiveBlocksPerMultiprocessor(&per_cu, (const void*)mk_fwd, NWAVES * 64, LDS_BYTES) != hipSuccess || per_cu < 1) fprintf(stderr, "kernel_launch: note: occupancy query reports %d workgroups per CU\n", per_cu);
        (void)hipGetLastError();
        grid = cus;
    }
    if (grid < 0) return;
    if (hipMemsetAsync((char*)d_ws + WS_CTL, 0, CTL_ZERO_BYTES, stream) != hipSuccess) { fprintf(stderr, "kernel_launch: hipMemsetAsync failed\n"); return; }
    Args a{};
    for (int i = 0; i < 25; ++i) a.in[i] = (const float*)d_in[i];
    a.out = (float*)d_out; a.ws = (unsigned char*)d_ws;
#if MK_ONE_LAUNCH
    a.ph_lo = 0; a.ph_hi = N_PHASES; a.li = 0;
    hipLaunchKernelGGL(mk_fwd, dim3(grid), dim3(NWAVES * 64), LDS_BYTES, stream, a);
#else
    for (int p = 0; p < N_PHASES; ++p) { a.ph_lo = p; a.ph_hi = p + 1; a.li = p; hipLaunchKernelGGL(mk_fwd, dim3(grid), dim3(NWAVES * 64), LDS_BYTES, stream, a); }
#endif
    const hipError_t le = hipPeekAtLastError();
    if (le != hipSuccess) fprintf(stderr, "kernel_launch: launch failed: %s\n", hipGetErrorName(le));
}
```

```cpp
#include <hip/hip_runtime.h>
#include <cstdio>
#include <cstdint>
namespace pg8 {
#define PG8_LAS __attribute__((address_space(3)))
typedef unsigned short bf16_t;
typedef short bf16x8 __attribute__((ext_vector_type(8)));
typedef float f32x4 __attribute__((ext_vector_type(4)));
typedef unsigned u32x4 __attribute__((ext_vector_type(4)));
constexpr int BM = 256, BK = 64, HALF = 128, HTB = HALF * BK * 2  , STAGE_BYTES = 8 * HTB, NXCD = 8, WGM = 8;

__host__ __device__ __forceinline__ int lds_byte(int r, int c) { const int st = (r >> 4) * 2 + (c >> 5), rr = r & 15, cc = c & 31, ob = rr * 64 + cc * 2; return st * 1024 + (ob ^ (((ob >> 9) & 1) << 5)); }
__host__ __device__ __forceinline__ void stage_rc(int b, int& R, int& C) { const int st = b / 1024, sb = b % 1024, swz = sb ^ (((sb >> 9) & 1) << 5); R = (st >> 1) * 16 + swz / 64; C = (st & 1) * 32 + (swz % 64) / 2; }
__host__ __device__ __forceinline__ int perm32(int rho) { const int n = rho >> 4, i = rho & 15; return 8 * (i >> 2) + 4 * n + (i & 3); }

struct Unit { int pm, pn, kind; };
struct Gemm { const bf16_t* A; const bf16_t* Bt; int M, N, K; };

struct StaticOrder {
    int nM, nN, nwg, G, c, xl;
    __host__ __device__ void init(int M, int N, int G_, int c_, int xl_ = 0) { nM = M / BM; nN = N / BM; nwg = nM * nN; G = G_; c = c_; xl = xl_; }
    __host__ __device__ bool next(int i, Unit& u) const {
        const long L = (long)i * G + c; if (L >= nwg) return false;
        int pm, pn;
        if (xl) { const int xcd = (int)L % NXCD, off = (int)L / NXCD, P = nM / NXCD; pm = P * xcd + off % P; pn = off / P; }
        else {
            int wgid = (int)L; { const int q = nwg / NXCD, r = nwg % NXCD, xcd = wgid % NXCD, off = wgid / NXCD; wgid = (xcd < r ? xcd * (q + 1) : r * (q + 1) + (xcd - r) * q) + off; }
            const int nig = WGM * nN, gid = wgid / nig, fm = gid * WGM, gsz = (nM - fm) < WGM ? (nM - fm) : WGM;
            pm = fm + ((wgid % nig) % gsz); pn = (wgid % nig) / gsz; }
        u.pm = pm; u.pn = pn; u.kind = 0; return true;
    }
    __device__ __forceinline__ const char* a_base(const Unit& u, const Gemm& g, size_t tstep) const { return (const char*)g.A + (size_t)u.pm * tstep; }
    __device__ __forceinline__ const char* b_base(const Unit& u, const Gemm& g, size_t tstep) const { return (const char*)g.Bt + (size_t)u.pn * tstep; }
    __device__ __forceinline__ void a_ready(const Unit&) const {}
    __device__ __forceinline__ void done(const Unit&) const {}
};
struct ComboOrder : StaticOrder {
    const bf16_t* A2; const bf16_t* B2; int nx;
    __device__ bool next(int i, Unit& u) const {
        const long L = (long)i * G + c; if (L >= nwg + nx) return false;
        int pm, pn, kind;
        if (L < nwg) { Unit t; StaticOrder::next(i, t); pm = t.pm; pn = t.pn; kind = 0; }
        else { const int e = (int)(L - nwg), r = e & 7; pm = r & 1; pn = r >> 1; kind = 1 + (e >> 3); }
        u.pm = pm; u.pn = pn; u.kind = kind; return true;
    }
    __device__ __forceinline__ const char* a_base(const Unit& u, const Gemm& g, size_t tstep) const { return u.kind == 0 ? (const char*)g.A + (size_t)u.pm * tstep : (const char*)A2 + (size_t)u.pm * tstep; }
    __device__ __forceinline__ const char* b_base(const Unit& u, const Gemm& g, size_t tstep) const { return u.kind == 0 ? (const char*)g.Bt + (size_t)u.pn * tstep : (const char*)B2 + (size_t)((u.kind - 1) * 4 + u.pn) * tstep; }
};


__device__ __forceinline__ float xsum_rows(float v) {
    const auto r = __builtin_amdgcn_permlane16_swap(__float_as_uint(v), __float_as_uint(v), false, false); const float t = __uint_as_float(r[0]) + __uint_as_float(r[1]);
    const auto q = __builtin_amdgcn_permlane32_swap(__float_as_uint(t), __float_as_uint(t), false, false); return __uint_as_float(q[0]) + __uint_as_float(q[1]);
}
__device__ __forceinline__ void rows4(float v, float (&o)[4]) {
    const auto r = __builtin_amdgcn_permlane16_swap(__float_as_uint(v), __float_as_uint(v), false, false);
    const auto p = __builtin_amdgcn_permlane32_swap(r[0], r[0], false, false);
    const auto q = __builtin_amdgcn_permlane32_swap(r[1], r[1], false, false);
    o[0] = __uint_as_float(p[0]); o[1] = __uint_as_float(q[0]); o[2] = __uint_as_float(p[1]); o[3] = __uint_as_float(q[1]);
}
struct PreNone {}; struct PreRows { float a, b; };
__device__ __forceinline__ unsigned cvt_pk_bf16(float lo, float hi) { unsigned r; asm volatile("v_cvt_pk_bf16_f32 %0, %1, %2" : "=v"(r) : "v"(lo), "v"(hi)); return r; }

template <int ACT  > struct EpiBf16 {
    static constexpr bool PERM = true, AFTER_DRAIN = false;
    bf16_t* O; int ldc;
    __device__ __forceinline__ void operator()(const f32x4 (&acc)[2][2][4][2], const Unit& u, int wr, int wc, int fr, int fq) const {
        asm volatile("" : "+v"(fr), "+v"(fq));
        const int row0 = u.pm * BM + wr * 64 + fr; const int col0 = u.pn * BM + wc * 32 + 8 * fq;
#pragma unroll
        for (int ai = 0; ai < 2; ++ai)
#pragma unroll
            for (int m = 0; m < 4; ++m) { bf16_t* rowp = O + (size_t)(row0 + ai * HALF + m * 16) * ldc + col0;
#pragma unroll
                for (int bj = 0; bj < 2; ++bj) { f32x4 v0 = acc[ai][bj][m][0], v1 = acc[ai][bj][m][1];
                    if (ACT == 1) {
#pragma unroll
                        for (int j = 0; j < 4; ++j) { const float a = fmaxf(v0[j], 0.f), b = fmaxf(v1[j], 0.f); v0[j] = a * a; v1[j] = b * b; } }
                    u32x4 w; w.x = cvt_pk_bf16(v0[0], v0[1]); w.y = cvt_pk_bf16(v0[2], v0[3]); w.z = cvt_pk_bf16(v1[0], v1[1]); w.w = cvt_pk_bf16(v1[2], v1[3]);
                    *(u32x4*)(rowp + bj * HALF) = w; } }
    }
};
struct EpiF32 {
    static constexpr bool PERM = false, AFTER_DRAIN = false;
    float* C; int ldc;
    __device__ __forceinline__ void operator()(const f32x4 (&acc)[2][2][4][2], const Unit& u, int wr, int wc, int fr, int fq) const {
        asm volatile("" : "+v"(fr), "+v"(fq));
        const int row0 = u.pm * BM + wr * 64 + fr, col0 = u.pn * BM + wc * 32 + 4 * fq;
#pragma unroll
        for (int ai = 0; ai < 2; ++ai)
#pragma unroll
            for (int m = 0; m < 4; ++m) { float* rowp = C + (size_t)(row0 + ai * HALF + m * 16) * ldc + col0;
#pragma unroll
                for (int bj = 0; bj < 2; ++bj)
#pragma unroll
                    for (int n = 0; n < 2; ++n) *(f32x4*)(rowp + bj * HALF + n * 16) = acc[ai][bj][m][n]; }
    }
};
struct EpiResF32 {
    static constexpr bool PERM = false, AFTER_DRAIN = false;
    const float* base; float* out; int ldc;
    __device__ __forceinline__ void operator()(const f32x4 (&acc)[2][2][4][2], const Unit& u, int wr, int wc, int fr, int fq) const {
        asm volatile("" : "+v"(fr), "+v"(fq));
        const int row0 = u.pm * BM + wr * 64 + fr, col0 = u.pn * BM + wc * 32 + 4 * fq;
#pragma unroll
        for (int ai = 0; ai < 2; ++ai)
#pragma unroll
            for (int m = 0; m < 4; ++m) { const size_t off = (size_t)(row0 + ai * HALF + m * 16) * ldc + col0;
#pragma unroll
                for (int bj = 0; bj < 2; ++bj)
#pragma unroll
                    for (int n = 0; n < 2; ++n) { const f32x4 b = *(const f32x4*)(base + off + bj * HALF + n * 16); *(f32x4*)(out + off + bj * HALF + n * 16) = b + acc[ai][bj][m][n]; } }
    }
};

constexpr float NORM_EPS = 1e-6f;
template <bool BASEF32, bool OUTF32> struct EpiRes {
    static constexpr bool PERM = true, AFTER_DRAIN = false; static constexpr int KIND = OUTF32 ? 3 : 0;
    const void* base; void* out; int ldc; float* rowsq;
    typedef PreNone Pre; __device__ __forceinline__ Pre pre(const Unit&, int, int) const { return Pre{}; }
    __device__ __forceinline__ void operator()(f32x4 (&acc)[2][2][4][2], const Unit& u, int wr, int wc, int fr, int fq, const Pre&) const {
        asm volatile("" : "+v"(fr), "+v"(fq));
        const int row0 = u.pm * BM + wr * 64 + fr, col0 = u.pn * BM + wc * 32 + 8 * fq;
        u32x4 bb[2][4][2];
        if (!BASEF32) {
#pragma unroll
            for (int ai = 0; ai < 2; ++ai)
#pragma unroll
                for (int m = 0; m < 4; ++m)
#pragma unroll
                    for (int bj = 0; bj < 2; ++bj) bb[ai][m][bj] = *(const u32x4*)((const bf16_t*)base + (size_t)(row0 + ai * HALF + m * 16) * ldc + col0 + bj * HALF); }
#pragma unroll
        for (int ai = 0; ai < 2; ++ai)
#pragma unroll
            for (int m = 0; m < 4; ++m) { const int row = row0 + ai * HALF + m * 16; const size_t off = (size_t)row * ldc + col0; float ss = 0.f;
#pragma unroll
                for (int bj = 0; bj < 2; ++bj) { f32x4 v0, v1;
                    if (BASEF32) { v0 = *(const f32x4*)((const float*)base + off + bj * HALF); v1 = *(const f32x4*)((const float*)base + off + bj * HALF + 4); }
                    else { const u32x4 b = bb[ai][m][bj];
                        v0 = (f32x4){__uint_as_float(b.x << 16), __uint_as_float(b.x & 0xffff0000u), __uint_as_float(b.y << 16), __uint_as_float(b.y & 0xffff0000u)};
                        v1 = (f32x4){__uint_as_float(b.z << 16), __uint_as_float(b.z & 0xffff0000u), __uint_as_float(b.w << 16), __uint_as_float(b.w & 0xffff0000u)}; }
                    v0 = v0 + acc[ai][bj][m][0]; v1 = v1 + acc[ai][bj][m][1];
                    if (OUTF32) { *(f32x4*)((float*)out + off + bj * HALF) = v0; *(f32x4*)((float*)out + off + bj * HALF + 4) = v1; }
                    else { ss += (v0[0] * v0[0] + v0[1] * v0[1]) + (v0[2] * v0[2] + v0[3] * v0[3]) + (v1[0] * v1[0] + v1[1] * v1[1]) + (v1[2] * v1[2] + v1[3] * v1[3]);
                        u32x4 w; w.x = cvt_pk_bf16(v0[0], v0[1]); w.y = cvt_pk_bf16(v0[2], v0[3]); w.z = cvt_pk_bf16(v1[0], v1[1]); w.w = cvt_pk_bf16(v1[2], v1[3]);
                        *(u32x4*)((bf16_t*)out + off + bj * HALF) = w; } }
                if (!OUTF32) { ss = xsum_rows(ss);
                    if (fq == 0) __hip_atomic_fetch_add(rowsq + row, ss, __ATOMIC_RELAXED, __HIP_MEMORY_SCOPE_AGENT); } }
    }
};
struct EpiUp {
    static constexpr bool PERM = true, AFTER_DRAIN = false; static constexpr int KIND = 1;
    bf16_t* O; int ldc; const float* rowsq; float invk;
    typedef PreRows Pre;
    __device__ __forceinline__ Pre pre(const Unit& u, int wr, int lane) const { const float* p = rowsq + u.pm * BM + wr * 64 + lane;
        return Pre{__hip_atomic_load(p, __ATOMIC_RELAXED, __HIP_MEMORY_SCOPE_AGENT), __hip_atomic_load(p + HALF, __ATOMIC_RELAXED, __HIP_MEMORY_SCOPE_AGENT)}; }
    __device__ __forceinline__ void operator()(f32x4 (&acc)[2][2][4][2], const Unit& u, int wr, int wc, int fr, int fq, const Pre& pr) const {
        asm volatile("" : "+v"(fr), "+v"(fq));
        const int row0 = u.pm * BM + wr * 64 + fr; const int col0 = u.pn * BM + wc * 32 + 8 * fq;
        float rq[2][4]; rows4(pr.a, rq[0]); rows4(pr.b, rq[1]);
#pragma unroll
        for (int ai = 0; ai < 2; ++ai)
#pragma unroll
            for (int m = 0; m < 4; ++m)
#pragma unroll
                for (int bj = 0; bj < 2; ++bj)
#pragma unroll
                    for (int n = 0; n < 2; ++n)
#pragma unroll
                        for (int j = 0; j < 4; ++j) { const float a = fmaxf(acc[ai][bj][m][n][j], 0.f); acc[ai][bj][m][n][j] = a * a; }
#pragma unroll
        for (int ai = 0; ai < 2; ++ai)
#pragma unroll
            for (int m = 0; m < 4; ++m) { const int row = row0 + ai * HALF + m * 16; bf16_t* rowp = O + (size_t)row * ldc + col0;
                const float rs2 = __builtin_amdgcn_rcpf(rq[ai][m] * invk + NORM_EPS);
#pragma unroll
                for (int bj = 0; bj < 2; ++bj) { f32x4 v0 = acc[ai][bj][m][0] * rs2, v1 = acc[ai][bj][m][1] * rs2;
                    u32x4 w; w.x = cvt_pk_bf16(v0[0], v0[1]); w.y = cvt_pk_bf16(v0[2], v0[3]); w.z = cvt_pk_bf16(v1[0], v1[1]); w.w = cvt_pk_bf16(v1[2], v1[3]);
                    *(u32x4*)(rowp + bj * HALF) = w; } }
    }
};
template <int LAYER> struct EpiProj {
    static constexpr bool PERM = true, AFTER_DRAIN = false; static constexpr int KIND = 2;
    bf16_t* O; int ldc; const float* rowsq; float invk;
    bf16_t* KM; bf16_t* VM; const float* rowsq_m;
    PG8_LAS float* xb; PG8_LAS const float* xg;
    float qs64, qs128;
    typedef PreRows Pre;
    __device__ __forceinline__ Pre pre(const Unit& u, int wr, int lane) const { const float* p = (u.kind == 0 ? rowsq : rowsq_m) + u.pm * BM + wr * 64 + lane;
        return Pre{__hip_atomic_load(p, __ATOMIC_RELAXED, __HIP_MEMORY_SCOPE_AGENT), __hip_atomic_load(p + HALF, __ATOMIC_RELAXED, __HIP_MEMORY_SCOPE_AGENT)}; }
    __device__ __forceinline__ void operator()(f32x4 (&acc)[2][2][4][2], const Unit& u, int wr, int wc, int fr, int fq, const Pre& pr) const {
        asm volatile("" : "+v"(fr), "+v"(fq));
        bf16_t* ob; int ld, colt, cls, q; const float* rq; float mult;
        if (u.kind == 0) { ob = O + (size_t)(u.pm * BM) * ldc; ld = ldc; colt = u.pn * BM; rq = rowsq + u.pm * BM;
            if (LAYER == 0) { q = u.pn < 6 ? 0 : (u.pn < 12 ? 1 : (u.pn < 18 ? 2 : 3)); cls = q < 2 ? 1 : (q == 2 ? 0 : 2); mult = q == 0 ? qs64 : (q == 3 ? qs128 : 1.f); }
            else { q = u.pn < 6 ? 0 : (u.pn < 8 ? 1 : (u.pn < 10 ? 2 : 3)); cls = q == 2 ? 0 : 2; mult = (q == 0 || q == 3) ? qs128 : 1.f; } }
        else { const int l = u.kind - 1; const bool isk = u.pn < 2; ob = (isk ? KM : VM) + (size_t)(l * 512 + u.pm * BM) * 512; ld = 512; colt = (u.pn & 1) * BM; rq = rowsq_m + u.pm * BM;
               cls = isk ? 2 : 0; q = 4 + l; mult = 1.f; }
        const int rl0 = wr * 64 + fr;
        float rqv[2][4]; rows4(pr.a, rqv[0]); rows4(pr.b, rqv[1]);
        f32x4 g0 = {1.f, 1.f, 1.f, 1.f}, g1 = g0;
        if (cls != 0) {
            float sv[2][4][2];
#pragma unroll
            for (int ai = 0; ai < 2; ++ai)
#pragma unroll
                for (int m = 0; m < 4; ++m)
#pragma unroll
                    for (int bj = 0; bj < 2; ++bj) { const f32x4 a = acc[ai][bj][m][0], b = acc[ai][bj][m][1];
                        const float s = (a[0] * a[0] + a[1] * a[1]) + (a[2] * a[2] + a[3] * a[3]) + (b[0] * b[0] + b[1] * b[1]) + (b[2] * b[2] + b[3] * b[3]);
                        sv[ai][m][bj] = xsum_rows(s); }
            if (fq == 0) {
#pragma unroll
                for (int ai = 0; ai < 2; ++ai)
#pragma unroll
                    for (int m = 0; m < 4; ++m) { const float rs2 = __builtin_amdgcn_rcpf(rqv[ai][m] * invk + NORM_EPS);
#pragma unroll
                        for (int bj = 0; bj < 2; ++bj) xb[(rl0 + ai * HALF + m * 16) * 8 + bj * 4 + wc] = sv[ai][m][bj] * rs2; } }
            asm volatile("s_waitcnt lgkmcnt(0)" ::: "memory"); __builtin_amdgcn_s_barrier(); asm volatile("" ::: "memory");
            const float invn = cls == 1 ? (1.f / 64.f) : (1.f / 128.f);
            const float w01 = (cls == 2 || wc < 2) ? 1.f : 0.f, w23 = (cls == 2 || wc >= 2) ? 1.f : 0.f;
            f32x4 pv[2][4][2];
#pragma unroll
            for (int ai = 0; ai < 2; ++ai)
#pragma unroll
                for (int m = 0; m < 4; ++m)
#pragma unroll
                    for (int bj = 0; bj < 2; ++bj) pv[ai][m][bj] = *(const PG8_LAS f32x4*)(xb + (rl0 + ai * HALF + m * 16) * 8 + bj * 4);
#pragma unroll
            for (int ai = 0; ai < 2; ++ai)
#pragma unroll
                for (int m = 0; m < 4; ++m) { const float rs = __builtin_amdgcn_rsqf(rqv[ai][m] * invk + NORM_EPS);
#pragma unroll
                    for (int bj = 0; bj < 2; ++bj) { const f32x4 p = pv[ai][m][bj];
                        const float s = w01 * (p[0] + p[1]) + w23 * (p[2] + p[3]);
                        const float f = mult * __builtin_amdgcn_rsqf(s * invn + NORM_EPS) * rs;
                        acc[ai][bj][m][0] *= f; acc[ai][bj][m][1] *= f; } }
            PG8_LAS const float* gp = xg + q * 128 + (cls == 1 ? 32 * (wc & 1) : 32 * wc) + 8 * fq;
            g0 = *(PG8_LAS const f32x4*)gp; g1 = *(PG8_LAS const f32x4*)(gp + 4);
        } else {
#pragma unroll
            for (int ai = 0; ai < 2; ++ai)
#pragma unroll
                for (int m = 0; m < 4; ++m) { const float rs = __builtin_amdgcn_rsqf(rqv[ai][m] * invk + NORM_EPS);
#pragma unroll
                    for (int bj = 0; bj < 2; ++bj) { acc[ai][bj][m][0] *= rs; acc[ai][bj][m][1] *= rs; } }
        }
#pragma unroll
        for (int ai = 0; ai < 2; ++ai)
#pragma unroll
            for (int m = 0; m < 4; ++m) { bf16_t* rowp = ob + (size_t)(rl0 + ai * HALF + m * 16) * ld + colt + wc * 32 + 8 * fq;
#pragma unroll
                for (int bj = 0; bj < 2; ++bj) { const f32x4 v0 = acc[ai][bj][m][0] * g0, v1 = acc[ai][bj][m][1] * g1;
                    u32x4 w; w.x = cvt_pk_bf16(v0[0], v0[1]); w.y = cvt_pk_bf16(v0[2], v0[3]); w.z = cvt_pk_bf16(v1[0], v1[1]); w.w = cvt_pk_bf16(v1[2], v1[3]);
                    *(u32x4*)(rowp + bj * HALF) = w; } }
    }
};

template <class Epi, class Sched, bool ALIGN_EPI = false, bool SP2 = false, bool A_SC1 = false>
__device__ __forceinline__ void gemm_phase(PG8_LAS unsigned char* lds, const Gemm g, const Sched& S, const Epi& E) {
    const int tid = threadIdx.x, wid = __builtin_amdgcn_readfirstlane(tid >> 6), lane = tid & 63, wr = wid >> 2, wc = wid & 3, fr = lane & 15, fq = lane >> 4;
    const int K = g.K, nt = K / BK;
    unsigned voffA[2], voffB[2];
#pragma unroll
    for (int i = 0; i < 2; ++i) { int R, C; stage_rc(tid * 16 + i * 8192, R, C); const int Rb = Epi::PERM ? ((R & ~31) + perm32(R & 31)) : R;
        voffA[i] = (unsigned)(R * K + C) * 2u; voffB[i] = (unsigned)(Rb * K + C) * 2u; }
    const size_t kstep = (size_t)(BK * 2);
    const size_t hstep = (size_t)HALF * K * 2;
    const size_t tstep = 2 * hstep;
    const unsigned ldsw = (unsigned)wid * 1024u;
    const int aoff = lds_byte(wr * 64 + fr, fq * 8), boff = lds_byte(wc * 32 + fr, fq * 8);
#define PG8_SA(b, h) (((b) * 2 + (h)) * HTB)
#define PG8_SB(b, h) ((4 + (b) * 2 + (h)) * HTB)
#ifndef PG8_B_AUX
#define PG8_B_AUX 0
#endif
#ifndef PG8_A_AUX
#define PG8_A_AUX 0
#endif
#define PG8_STAGE(bufoff, gbase, voff) do { _Pragma("unroll") for (int _i = 0; _i < 2; ++_i) \
        __builtin_amdgcn_global_load_lds((const unsigned*)((const char*)(gbase) + (voff)[_i]), (PG8_LAS unsigned*)(lds + (bufoff) + ldsw + _i * 8192), 16, 0, PG8_B_AUX); } while (0)
#define PG8_STAGEA(bufoff, gbase, voff) do { _Pragma("unroll") for (int _i = 0; _i < 2; ++_i) \
        __builtin_amdgcn_global_load_lds((const unsigned*)((const char*)(gbase) + (voff)[_i]), (PG8_LAS unsigned*)(lds + (bufoff) + ldsw + _i * 8192), 16, 0, A_SC1 ? 16 : PG8_A_AUX); } while (0)
#define PG8_LDA(dst, b, h) do { _Pragma("unroll") for (int m = 0; m < 4; ++m) _Pragma("unroll") for (int k = 0; k < 2; ++k) dst[m][k] = *(const PG8_LAS bf16x8*)(lds + PG8_SA(b, h) + aoff + m * 2048 + k * 1024); } while (0)
#define PG8_LDB(dst, b, h) do { _Pragma("unroll") for (int n = 0; n < 2; ++n) _Pragma("unroll") for (int k = 0; k < 2; ++k) dst[n][k] = *(const PG8_LAS bf16x8*)(lds + PG8_SB(b, h) + boff + n * 2048 + k * 1024); } while (0)
#define PG8_MMA(ai, bj, At, Bt) do { __builtin_amdgcn_s_setprio(1); _Pragma("unroll") for (int m = 0; m < 4; ++m) _Pragma("unroll") for (int n = 0; n < 2; ++n) _Pragma("unroll") for (int k = 0; k < 2; ++k) \
        acc[ai][bj][m][n] = __builtin_amdgcn_mfma_f32_16x16x32_bf16(Bt[n][k], At[m][k], acc[ai][bj][m][n], 0, 0, 0); __builtin_amdgcn_s_setprio(0); } while (0)
#define PG8_WAIT_V(n) asm volatile("s_waitcnt vmcnt(" #n ")" ::: "memory")
#define PG8_WAIT_L(n) asm volatile("s_waitcnt lgkmcnt(" #n ")" ::: "memory")
#define PG8_BAR __builtin_amdgcn_s_barrier()
#define PG8_SCHED __builtin_amdgcn_sched_barrier(0)
    Unit cur, nxt; int ui = 0;
    if (!S.next(0, cur)) return;
    f32x4 acc[2][2][4][2];
#pragma unroll
    for (int a = 0; a < 2; ++a)
#pragma unroll
        for (int b = 0; b < 2; ++b)
#pragma unroll
            for (int m = 0; m < 4; ++m)
#pragma unroll
                for (int n = 0; n < 2; ++n) acc[a][b][m][n] = (f32x4){0.f, 0.f, 0.f, 0.f};
    bf16x8 At[4][2], B0[2][2], B1[2][2];
    const char* cA = S.a_base(cur, g, tstep); const char* cB = S.b_base(cur, g, tstep);
    S.a_ready(cur);
    if constexpr (SP2) {
        PG8_STAGE(PG8_SB(0, 0), cB, voffB); PG8_STAGE(PG8_SB(0, 1), cB + hstep, voffB); PG8_STAGEA(PG8_SA(0, 0), cA, voffA); PG8_STAGEA(PG8_SA(0, 1), cA + hstep, voffA);
        if (wr == 1) PG8_BAR;
        PG8_WAIT_V(2); PG8_BAR;
        PG8_STAGE(PG8_SB(1, 0), cB + kstep, voffB); PG8_STAGEA(PG8_SA(1, 0), cA + kstep, voffA); PG8_STAGE(PG8_SB(1, 1), cB + hstep + kstep, voffB);
        PG8_WAIT_V(6); PG8_BAR;
    } else {
        PG8_STAGE(PG8_SB(0, 0), cB, voffB); PG8_STAGEA(PG8_SA(0, 0), cA, voffA); PG8_STAGE(PG8_SB(0, 1), cB + hstep, voffB); PG8_STAGEA(PG8_SA(0, 1), cA + hstep, voffA);
        if (wr == 1) PG8_BAR;
        PG8_WAIT_V(4); PG8_BAR;
        PG8_STAGE(PG8_SB(1, 0), cB + kstep, voffB); PG8_STAGEA(PG8_SA(1, 0), cA + kstep, voffA); PG8_STAGE(PG8_SB(1, 1), cB + hstep + kstep, voffB);
        PG8_WAIT_V(6); PG8_BAR;
    }
    for (;;) {
        const bool has_next = S.next(ui + 1, nxt);
        const typename Epi::Pre pre_ = E.pre(cur, wr, lane);
        const char* nA = has_next ? S.a_base(nxt, g, tstep) : cA; const char* nB = has_next ? S.b_base(nxt, g, tstep) : cB;
        for (int t = 0; t < nt; t += 2) {
            const bool last = (t == nt - 2);
            const char* a1 = cA + (size_t)(t + 1) * kstep;
            const char* a2 = last ? nA : cA + (size_t)(t + 2) * kstep; const char* b2 = last ? nB : cB + (size_t)(t + 2) * kstep;
            const char* a3 = a2 + kstep; const char* b3 = b2 + kstep;
            if (last && has_next) S.a_ready(nxt);
            if constexpr (SP2) {
            PG8_LDB(B0, 0, 0); PG8_LDB(B1, 0, 1); PG8_SCHED; PG8_LDA(At, 0, 0); PG8_STAGEA(PG8_SA(1, 1), a1 + hstep, voffA);
            PG8_WAIT_V(8); PG8_WAIT_L(0); PG8_BAR; PG8_MMA(0, 0, At, B0); PG8_MMA(0, 1, At, B1); PG8_BAR; PG8_SCHED;
            PG8_LDA(At, 0, 1); PG8_STAGE(PG8_SB(0, 0), b2, voffB); PG8_STAGE(PG8_SB(0, 1), b2 + hstep, voffB); PG8_STAGEA(PG8_SA(0, 0), a2, voffA);
            PG8_WAIT_V(8); PG8_WAIT_L(0); PG8_BAR; PG8_MMA(1, 0, At, B0); PG8_MMA(1, 1, At, B1); PG8_BAR; PG8_SCHED;
            PG8_LDB(B0, 1, 0); PG8_LDB(B1, 1, 1); PG8_SCHED; PG8_LDA(At, 1, 0); PG8_STAGEA(PG8_SA(0, 1), a2 + hstep, voffA);
            PG8_WAIT_V(8); PG8_WAIT_L(0); PG8_BAR; PG8_MMA(0, 0, At, B0); PG8_MMA(0, 1, At, B1); PG8_BAR; PG8_SCHED;
            PG8_LDA(At, 1, 1); PG8_STAGE(PG8_SB(1, 0), b3, voffB); PG8_STAGE(PG8_SB(1, 1), b3 + hstep, voffB); PG8_STAGEA(PG8_SA(1, 0), a3, voffA);
            PG8_WAIT_V(8); PG8_WAIT_L(0); PG8_BAR; PG8_MMA(1, 0, At, B0); PG8_MMA(1, 1, At, B1); PG8_BAR; PG8_SCHED;
            } else {
            PG8_LDB(B0, 0, 0); PG8_SCHED; PG8_LDA(At, 0, 0); PG8_STAGEA(PG8_SA(1, 1), a1 + hstep, voffA);
            PG8_WAIT_L(8); PG8_BAR; PG8_WAIT_L(0); PG8_MMA(0, 0, At, B0); PG8_BAR; PG8_SCHED;
            PG8_LDB(B1, 0, 1); PG8_STAGE(PG8_SB(0, 0), b2, voffB);
            PG8_BAR; PG8_WAIT_L(0); PG8_MMA(0, 1, At, B1); PG8_BAR;
            PG8_LDA(At, 0, 1); PG8_STAGEA(PG8_SA(0, 0), a2, voffA);
            PG8_BAR; PG8_WAIT_L(0); PG8_MMA(1, 0, At, B0); PG8_BAR; PG8_SCHED;
            PG8_STAGE(PG8_SB(0, 1), b2 + hstep, voffB);
            PG8_WAIT_V(6); PG8_BAR; PG8_MMA(1, 1, At, B1); PG8_BAR;
            PG8_LDB(B0, 1, 0); PG8_SCHED; PG8_LDA(At, 1, 0); PG8_STAGEA(PG8_SA(0, 1), a2 + hstep, voffA);
            PG8_WAIT_L(8); PG8_BAR; PG8_WAIT_L(0); PG8_MMA(0, 0, At, B0); PG8_BAR; PG8_SCHED;
            PG8_LDB(B1, 1, 1); PG8_STAGE(PG8_SB(1, 0), b3, voffB);
            PG8_BAR; PG8_WAIT_L(0); PG8_MMA(0, 1, At, B1); PG8_BAR;
            PG8_LDA(At, 1, 1); PG8_STAGEA(PG8_SA(1, 0), a3, voffA);
            PG8_BAR; PG8_WAIT_L(0); PG8_MMA(1, 0, At, B0); PG8_BAR; PG8_SCHED;
            PG8_STAGE(PG8_SB(1, 1), b3 + hstep, voffB);
            PG8_WAIT_V(6); PG8_BAR; PG8_MMA(1, 1, At, B1); PG8_BAR;
            }
        }
        if constexpr (ALIGN_EPI) { if (wr == 0) PG8_BAR; }
#ifdef PROBE_EPI
        const unsigned long long e0_ = __builtin_amdgcn_s_memrealtime();
#endif
        if constexpr (!Epi::AFTER_DRAIN) { E(acc, cur, wr, wc, fr, fq, pre_); S.done(cur); }
#ifdef PROBE_EPI
        if ((PROBE_EPI == 1 || PROBE_EPI == 10 + Epi::KIND) && blockIdx.x == 0 && threadIdx.x == 0) { const unsigned dt_ = (unsigned)(__builtin_amdgcn_s_memrealtime() - e0_); *(volatile PG8_LAS unsigned*)(lds + 143744) += dt_; }
#endif
        if (!has_next) break;
#pragma unroll
        for (int a = 0; a < 2; ++a)
#pragma unroll
            for (int b = 0; b < 2; ++b)
#pragma unroll
                for (int m = 0; m < 4; ++m)
#pragma unroll
                    for (int n = 0; n < 2; ++n) acc[a][b][m][n] = (f32x4){0.f, 0.f, 0.f, 0.f};
        cur = nxt; cA = nA; cB = nB; ++ui;
        if constexpr (ALIGN_EPI) { if (wr == 1) PG8_BAR; }
    }
    PG8_WAIT_V(0);
    if constexpr (!ALIGN_EPI) { if (wr == 0) PG8_BAR; }
    PG8_BAR;
    if constexpr (Epi::AFTER_DRAIN) { E.fused(acc, cur, wr, wc, fr, fq, lds, wid, lane); S.done(cur); }
#undef PG8_SA
#undef PG8_SB
#undef PG8_STAGE
#undef PG8_STAGEA
#undef PG8_LDA
#undef PG8_LDB
#undef PG8_MMA
#undef PG8_WAIT_V
#undef PG8_WAIT_L
#undef PG8_BAR
#undef PG8_SCHED
}
}
#define GAS __attribute__((address_space(1)))
#define LAS __attribute__((address_space(3)))
typedef unsigned short bf16;
typedef unsigned v4u __attribute__((ext_vector_type(4)));
typedef float f32x4 __attribute__((ext_vector_type(4)));
typedef short bf16x8 __attribute__((ext_vector_type(8)));
typedef GAS unsigned gu32;
typedef GAS unsigned long long gu64;
#define RLX_AGENT __ATOMIC_RELAXED, __HIP_MEMORY_SCOPE_AGENT
#define LDS_WAIT() asm volatile("s_waitcnt lgkmcnt(0)" ::: "memory")
#define VM_WAIT() asm volatile("s_waitcnt vmcnt(0)" ::: "memory")
__device__ __forceinline__ unsigned long long rt() { return __builtin_amdgcn_s_memrealtime(); }
__device__ __forceinline__ unsigned f2bf(float f) { unsigned u = __builtin_bit_cast(unsigned, f); return (u + 0x7fffu + ((u >> 16) & 1u)) >> 16; }
__device__ __forceinline__ unsigned pk2(float lo, float hi) { return f2bf(lo) | (f2bf(hi) << 16); }

#define XB_TMO      128
#define XB_XCNT(j)  (256  + 64 * (j))
#define XB_XSUB(j)  (1280 + 64 * (j))
#define XB_XGEN(j)  (2304 + 64 * (j))
#define XB_TOP      3328
#define XB_TOPGEN   3392
#define XCD_BAR_WORDS 3456
#define XB_SPIN_CAP (1u << 18)

__device__ __forceinline__ unsigned xb_ld(unsigned* p)              { return __hip_atomic_load(p, __ATOMIC_RELAXED, __HIP_MEMORY_SCOPE_AGENT); }
__device__ __forceinline__ unsigned xb_add(unsigned* p, unsigned v) { return __hip_atomic_fetch_add(p, v, __ATOMIC_RELAXED, __HIP_MEMORY_SCOPE_AGENT); }
__device__ __forceinline__ unsigned xb_xcc_id() { return (unsigned)__builtin_amdgcn_s_getreg((3 << 11) | 20) & 0xFu; }
#define XB_SPIN(cond, bar) do { unsigned _sp = 0; while (cond) { __builtin_amdgcn_s_sleep(1); \
    if ((++_sp & 255u) == 0u) { if (xb_ld(&(bar)[XB_TMO])) break; if (_sp > XB_SPIN_CAP) { atomicAdd(&(bar)[XB_TMO], 1u); break; } } } } while (0)

struct XcdBarrier {
    unsigned* bar; unsigned x;
    volatile LAS unsigned* st;
};

__device__ __forceinline__ XcdBarrier xcd_barrier_post(unsigned* bar, volatile LAS unsigned* st) {
    XcdBarrier b; b.bar = bar; b.x = xb_xcc_id(); b.st = st;
    if (threadIdx.x == 0) (void)xb_add(&bar[XB_XCNT(b.x)], 1u);
    return b;
}
__device__ __forceinline__ void xcd_barrier_complete(unsigned* bar, unsigned x, unsigned& nloc, unsigned& nx) {
    const unsigned G = gridDim.x * gridDim.y * gridDim.z;
    unsigned sum, cnt, mine, sp = 0u;
    for (;;) {
        sum = 0u; cnt = 0u; mine = 0u;
#pragma unroll
        for (unsigned j = 0; j < 16; ++j) { const unsigned c = xb_ld(&bar[XB_XCNT(j)]); sum += c; cnt += (c > 0u) ? 1u : 0u; mine = (j == x) ? c : mine; }
        if (sum == G) break;
        __builtin_amdgcn_s_sleep(1);
        if ((++sp & 255u) == 0u) { if (xb_ld(&bar[XB_TMO])) break; if (sp > XB_SPIN_CAP) { atomicAdd(&bar[XB_TMO], 1u); break; } }
    }
    nloc = mine > 0u ? mine : 1u; nx = cnt > 0u ? cnt : 1u;
}

__device__ __forceinline__ void xcd_barrier(const XcdBarrier& b) {
    asm volatile("s_waitcnt vmcnt(0)" ::: "memory");
    __syncthreads();
    if (threadIdx.x == 0) {
        unsigned* bar = b.bar;
        __builtin_amdgcn_s_waitcnt(0);
        unsigned nloc = b.st[0], nx = b.st[1];
        if (nloc == 0u) { xcd_barrier_complete(bar, b.x, nloc, nx); b.st[0] = nloc; b.st[1] = nx; }
#ifndef XB_EARLY_WB
#define XB_EARLY_WB 0
#endif
        if (XB_EARLY_WB) asm volatile("buffer_wbl2 sc1" ::: "memory");
        const unsigned old = xb_add(&bar[XB_XSUB(b.x)], 1u);
        const unsigned gen = old / nloc;
        if (old + 1u == (gen + 1u) * nloc) {
            __builtin_amdgcn_fence(__ATOMIC_RELEASE, "agent");
            asm volatile("s_waitcnt vmcnt(0)" ::: "memory");
            const unsigned og = xb_add(&bar[XB_TOP], 1u);
            const unsigned tg = og / nx;
            asm volatile("buffer_inv sc1" ::: "memory");
            if (og + 1u == (tg + 1u) * nx) xb_add(&bar[XB_TOPGEN], 1u);
            else XB_SPIN(xb_ld(&bar[XB_TOPGEN]) == tg, bar);
            xb_add(&bar[XB_XGEN(b.x)], 1u);
            asm volatile("s_waitcnt vmcnt(0)" ::: "memory");
        } else {
            asm volatile("buffer_inv sc1" ::: "memory");
            XB_SPIN(xb_ld(&bar[XB_XGEN(b.x)]) == gen, bar);
            asm volatile("s_waitcnt vmcnt(0)" ::: "memory");
        }
    }
    __syncthreads();
}

constexpr int NWAVES = 8;
constexpr int NB = 2, SEQ = 4096, NTOK = NB * SEQ, DM = 2048, INA = 5120, INB = 3072, DFF = 8192, MEML = 256, MEMR = NB * MEML;
constexpr int NH = 12, NMH = 4, MIXW = 1536, MEMW = 512, KVW = 512;
constexpr int A_K = 1536, A_V = 3072, A_QM = 4608;
constexpr int B_K = 1536, B_V = 2048, B_QM = 2560;
constexpr float RMS_EPS = 1e-6f;
constexpr float LOG2E = 1.4426950408889634f;
constexpr float QS64 = 0.125f * LOG2E;
constexpr float QS128 = 0.08838834764831845f * LOG2E;
constexpr float LAM_INIT0 = 0.2f;
constexpr int N_PHASES = 11;
constexpr unsigned CONV_P0 = 0x10D, CONV_P1 = 0x052, CONV_P6 = 0x2A0;
#ifndef CONV_DEPTH
#define CONV_DEPTH 3
#endif
#ifndef CONV_P1Y_N
#define CONV_P1Y_N 0
#endif
constexpr int CONV_P1Y_ITEMS = CONV_P1Y_N;
#ifndef CONV_P1X_N
#define CONV_P1X_N 0
#endif
constexpr int CONV_P1X_ITEMS = CONV_P1X_N;
#ifndef CONV_P7_N
#define CONV_P7_N 0
#endif
constexpr int CONV_P7_ITEMS = CONV_P7_N;
#ifndef CONV_P1_BACK
#define CONV_P1_BACK 768
#endif
constexpr int CONV_P1_BACK_ITEMS = CONV_P1_BACK;
#ifndef CONV_P2_N
#define CONV_P2_N 3072
#endif
constexpr int CONV_P2_ITEMS = CONV_P2_N;
constexpr int GEMM_CUS_P1 = 224, GEMM_CUS_P6 = 192;
static_assert((CONV_P0 | CONV_P1 | CONV_P6) == 0x3FF && (CONV_P0 & CONV_P1) == 0 && (CONV_P0 & CONV_P6) == 0 && (CONV_P1 & CONV_P6) == 0, "every weight matrix is converted exactly once");

constexpr size_t MiB = 1u << 20;
constexpr size_t WS_CTL = 0, CTL_ZERO_BYTES = 256 * 1024;
constexpr size_t WS_WA = 2 * MiB, WS_WB = 22 * MiB, WS_WMKV = 34 * MiB, WS_WOUT = 42 * MiB, WS_WUP = 58 * MiB, WS_WDN = 122 * MiB;
constexpr size_t WS_HN = 186 * MiB;
constexpr size_t WS_PROJ = 218 * MiB;
constexpr size_t WS_HEADS = 298 * MiB;
constexpr size_t WS_U = 330 * MiB;
constexpr size_t WS_MN = 458 * MiB;
constexpr size_t WS_MKVRAW = 462 * MiB;
constexpr size_t WS_KM = 466 * MiB;
constexpr size_t WS_VM = 467 * MiB;
constexpr size_t WS_POSMM = 468 * MiB;
constexpr size_t WS_END = 469 * MiB;
constexpr int CW_TMO = 0, CW_CODE = 1, CW_BAR = 4096;
constexpr int CW_RSQ_MLP0 = 16384, CW_RSQ_ATT1 = CW_RSQ_MLP0 + NTOK, CW_RSQ_MLP1 = CW_RSQ_ATT1 + NTOK, CW_RSQ_X = CW_RSQ_MLP1 + NTOK, CW_RSQ_M = CW_RSQ_X + NTOK;
constexpr int CW_PANEL = CW_RSQ_M + 2 * MEMR + 64;
constexpr int CW_XCC = CW_PANEL + 32 * 64;
constexpr int CW_CONVDONE = CW_XCC + 256;
static_assert((CW_CONVDONE + 64) * 4 <= (int)CTL_ZERO_BYTES, "control words inside the memset region");

constexpr int RING_OFF = 0, RING_BYTES = 131072;
constexpr int EXTRA_OFF = RING_BYTES, EXTRA_BYTES = 12288;
constexpr int LDSCTL_OFF = EXTRA_OFF + EXTRA_BYTES, MISC_OFF = LDSCTL_OFF + 320;
constexpr int LDS_BYTES = 147456;
static_assert(MISC_OFF + 128 <= LDS_BYTES, "LDS map");

struct Frame {
    LAS unsigned char* lds; unsigned char* ldsg;
    volatile LAS unsigned* MISC;
    gu32* ctl;
    int wave;
    int vcu, G, xl;
    const float* in[25]; float* out; unsigned char* ws;
};
__device__ __forceinline__ int cur_lane() { int l = (int)__builtin_amdgcn_mbcnt_hi(~0u, __builtin_amdgcn_mbcnt_lo(~0u, 0u)); asm volatile("" : "+v"(l)); return l; }
__device__ __forceinline__ float wave_sum(float v) {
#pragma unroll
    for (int o = 1; o < 64; o <<= 1) v += __shfl_xor(v, o);
    return v;
}
__device__ __forceinline__ float wave_max(float v) {
#pragma unroll
    for (int o = 1; o < 64; o <<= 1) v = fmaxf(v, __shfl_xor(v, o));
    return v;
}
__device__ __forceinline__ float bf_lo(unsigned u) { return __uint_as_float(u << 16); }
__device__ __forceinline__ float bf_hi(unsigned u) { return __uint_as_float(u & 0xffff0000u); }

struct TItem { const float* W; bf16* WT; const float* gain; int K, N, item; };
__device__ __forceinline__ void t_load(const TItem& t, f32x4 (&v)[8], float (&g)[8], int lane) {
    const int nblk = t.N / 32, kb = t.item / nblk, nb = t.item % nblk, k0 = 64 * kb, n0 = 32 * nb, r = lane >> 3, c4 = lane & 7;
#pragma unroll
    for (int i = 0; i < 8; ++i) v[i] = __builtin_nontemporal_load((const GAS f32x4*)(t.W + (size_t)(k0 + 8 * i + r) * t.N + n0 + 4 * c4));
    if (t.gain) {
#pragma unroll
        for (int i = 0; i < 8; ++i) g[i] = t.gain[k0 + 8 * i + r]; }
}
template <bool WT = false> __device__ __forceinline__ void t_store(const TItem& t, f32x4 (&v)[8], const float (&g)[8], LAS float* scr, int lane) {
    const int nblk = t.N / 32, kb = t.item / nblk, nb = t.item % nblk, k0 = 64 * kb, n0 = 32 * nb, r = lane >> 3, c4 = lane & 7;
    if (t.gain) {
#pragma unroll
        for (int i = 0; i < 8; ++i) v[i] = v[i] * g[i]; }
#pragma unroll
    for (int i = 0; i < 8; ++i) { LAS float* p = scr + (8 * i + r) * 33 + 4 * c4; p[0] = v[i].x; p[1] = v[i].y; p[2] = v[i].z; p[3] = v[i].w; }
    LDS_WAIT(); asm volatile("" ::: "memory");
    const int c = lane & 7;
#pragma unroll
    for (int j = 0; j < 4; ++j) { const int n = (lane >> 3) + 8 * j; const LAS float* s = scr + (8 * c) * 33 + n;
        v4u o; o.x = pk2(s[0 * 33], s[1 * 33]); o.y = pk2(s[2 * 33], s[3 * 33]); o.z = pk2(s[4 * 33], s[5 * 33]); o.w = pk2(s[6 * 33], s[7 * 33]);
#ifndef CONV_NT_ST
#define CONV_NT_ST 0
#endif
        if (WT || CONV_NT_ST == 2) { const bf16* p_ = t.WT + (size_t)(n0 + n) * t.K + k0 + 8 * c; asm volatile("global_store_dwordx4 %0, %1, off sc1\n\ts_nop 1" :: "v"(p_), "v"(o) : "memory"); }
        else if (CONV_NT_ST) __builtin_nontemporal_store(o, (GAS v4u*)(t.WT + (size_t)(n0 + n) * t.K + k0 + 8 * c)); else *(GAS v4u*)(t.WT + (size_t)(n0 + n) * t.K + k0 + 8 * c) = o; }
    LDS_WAIT(); asm volatile("" ::: "memory");
}
__device__ __forceinline__ void row_to_bf16(const float* xrow, bf16* orow, float* rowsq, int lane) {
    const GAS f32x4* xr = (const GAS f32x4*)xrow + lane;
    f32x4 v[8]; float s = 0.f;
#pragma unroll
    for (int j = 0; j < 8; ++j) { v[j] = xr[64 * j]; s += (v[j].x * v[j].x + v[j].y * v[j].y) + (v[j].z * v[j].z + v[j].w * v[j].w); }
    s = wave_sum(s); if (lane == 0) *rowsq = s;
    GAS unsigned long long* o8 = (GAS unsigned long long*)orow + lane;
#pragma unroll
    for (int j = 0; j < 8; ++j) o8[64 * j] = (unsigned long long)pk2(v[j].x, v[j].y) | ((unsigned long long)pk2(v[j].z, v[j].w) << 32);
}
__device__ __forceinline__ void row2_to_bf16(const float* x0, const float* x1, bf16* o0, bf16* o1, float* rq0, float* rq1, int lane) {
    const GAS f32x4* xa = (const GAS f32x4*)x0 + lane; const GAS f32x4* xb = (const GAS f32x4*)x1 + lane;
    f32x4 v[8], w[8]; float s = 0.f, t = 0.f;
#pragma unroll
    for (int j = 0; j < 8; ++j) v[j] = __builtin_nontemporal_load(xa + 64 * j);
#pragma unroll
    for (int j = 0; j < 8; ++j) w[j] = __builtin_nontemporal_load(xb + 64 * j);
#pragma unroll
    for (int j = 0; j < 8; ++j) { s += (v[j].x * v[j].x + v[j].y * v[j].y) + (v[j].z * v[j].z + v[j].w * v[j].w); t += (w[j].x * w[j].x + w[j].y * w[j].y) + (w[j].z * w[j].z + w[j].w * w[j].w); }
    s = wave_sum(s); t = wave_sum(t); if (lane == 0) { *rq0 = s; *rq1 = t; }
    GAS unsigned long long* p0 = (GAS unsigned long long*)o0 + lane; GAS unsigned long long* p1 = (GAS unsigned long long*)o1 + lane;
#pragma unroll
    for (int j = 0; j < 8; ++j) { p0[64 * j] = (unsigned long long)pk2(v[j].x, v[j].y) | ((unsigned long long)pk2(v[j].z, v[j].w) << 32);
                                  p1[64 * j] = (unsigned long long)pk2(w[j].x, w[j].y) | ((unsigned long long)pk2(w[j].z, w[j].w) << 32); }
}
__device__ __forceinline__ void phase_rows_bf16(Frame& F, const float* x, bf16* out, float* rowsq, int nrows) {
    const int gw = F.vcu * NWAVES + F.wave, NGW = F.G * NWAVES;
    for (int m = 2 * gw; m < nrows; m += 2 * NGW) row2_to_bf16(x + (size_t)m * DM, x + (size_t)(m + 1) * DM, out + (size_t)m * DM, out + (size_t)(m + 1) * DM, rowsq + m, rowsq + m + 1, cur_lane());
}
#ifndef CONV_PIPE
#define CONV_PIPE 3
#endif
template <unsigned MASK, int DEPTH = CONV_PIPE, bool WT = false> __device__ __forceinline__ void convert_weights(Frame& F, int gw, int NGW, int from_end0 = -1, int from_end1 = 0) {
    LAS float* scr = (LAS float*)(F.lds + RING_OFF + F.wave * 16384);
    bf16* const wa = (bf16*)(F.ws + WS_WA); bf16* const wb = (bf16*)(F.ws + WS_WB); bf16* const wm = (bf16*)(F.ws + WS_WMKV);
    bf16* const wo = (bf16*)(F.ws + WS_WOUT); bf16* const wu = (bf16*)(F.ws + WS_WUP); bf16* const wd = (bf16*)(F.ws + WS_WDN);
    constexpr int I_A = (DM / 64) * (INA / 32), I_B = (DM / 64) * (INB / 32), I_M = (DM / 64) * (1024 / 32), I_O = (DM / 64) * (DM / 32), I_U = (DM / 64) * (DFF / 32), I_D = (DFF / 64) * (DM / 32);
    constexpr int NITEMS = ((MASK >> 0) & 1) * I_A + ((MASK >> 1) & 1) * I_B + (((MASK >> 2) & 1) + ((MASK >> 3) & 1)) * I_M + (((MASK >> 4) & 1) + ((MASK >> 5) & 1)) * I_O
                         + (((MASK >> 6) & 1) + ((MASK >> 7) & 1)) * I_U + (((MASK >> 8) & 1) + ((MASK >> 9) & 1)) * I_D;
#define CW_TRY(bit, items, W_, K_, N_, WT_, G_) if ((MASK >> (bit)) & 1u) { if (!done && r < (items)) { t.W = (W_); t.K = (K_); t.N = (N_); t.WT = (WT_); t.gain = (G_); t.item = r; done = true; } r -= (items); }
#define CW_DECODE(IT, T) do { int r = (IT); bool done = false; TItem t{}; \
        CW_TRY(0, I_A, F.in[7], DM, INA, wa, F.in[4]) CW_TRY(1, I_B, F.in[15], DM, INB, wb, F.in[4] + DM) \
        CW_TRY(2, I_M, F.in[19], DM, 1024, wm, F.in[5]) CW_TRY(3, I_M, F.in[19] + (size_t)DM * 1024, DM, 1024, wm + (size_t)1024 * DM, F.in[5] + DM) \
        CW_TRY(4, I_O, F.in[22], DM, DM, wo, (const float*)nullptr) CW_TRY(5, I_O, F.in[22] + (size_t)DM * DM, DM, DM, wo + (size_t)DM * DM, (const float*)nullptr) \
        CW_TRY(6, I_U, F.in[23], DM, DFF, wu, F.in[6]) CW_TRY(7, I_U, F.in[23] + (size_t)DM * DFF, DM, DFF, wu + (size_t)DFF * DM, F.in[6] + DM) \
        CW_TRY(8, I_D, F.in[24], DFF, DM, wd, (const float*)nullptr) CW_TRY(9, I_D, F.in[24] + (size_t)DFF * DM, DFF, DM, wd + (size_t)DM * DFF, (const float*)nullptr) \
        T = t; } while (0)
    const int it0 = from_end0 < 0 ? 0 : NITEMS - from_end0, it1 = NITEMS - from_end1;
    if constexpr (DEPTH == 3) {
        const int lane = cur_lane(); const int step = 2 * NGW; int it = it0 + gw;
        if (it < it1) {
            f32x4 va[8], vb[8], vc[8], vd[8]; float ga[8], gb[8], gc[8], gd[8]; TItem ta, tb_, tc, td; bool twoA = it + NGW < it1, twoB = false;
            CW_DECODE(it, ta); CW_DECODE(twoA ? it + NGW : it, tb_); t_load(ta, va, ga, lane); if (twoA) t_load(tb_, vb, gb, lane);
            for (;;) {
                const int nb = it + step; const bool hasB = nb < it1;
                if (hasB) { twoB = nb + NGW < it1; CW_DECODE(nb, tc); CW_DECODE(twoB ? nb + NGW : nb, td); t_load(tc, vc, gc, lane); if (twoB) t_load(td, vd, gd, lane); }
                t_store(ta, va, ga, scr, lane); if (twoA) t_store(tb_, vb, gb, scr, lane);
                if (!hasB) break;
                it = nb;
                const int na = it + step; const bool hasA = na < it1;
                if (hasA) { twoA = na + NGW < it1; CW_DECODE(na, ta); CW_DECODE(twoA ? na + NGW : na, tb_); t_load(ta, va, ga, lane); if (twoA) t_load(tb_, vb, gb, lane); }
                t_store(tc, vc, gc, scr, lane); if (twoB) t_store(td, vd, gd, scr, lane);
                if (!hasA) break;
                it = na;
            }
        }
    } else if constexpr (DEPTH == 4) {
    for (int it = it0 + gw; it < it1; it += 4 * NGW) {
        const int lane = cur_lane(); const bool h1 = it + NGW < it1, h2 = it + 2 * NGW < it1, h3 = it + 3 * NGW < it1;
        TItem ta, tb_, tc, td; CW_DECODE(it, ta); CW_DECODE(h1 ? it + NGW : it, tb_); CW_DECODE(h2 ? it + 2 * NGW : it, tc); CW_DECODE(h3 ? it + 3 * NGW : it, td);
        f32x4 va[8], vb[8], vc[8], vd[8]; float ga[8], gb[8], gc[8], gd[8];
        t_load(ta, va, ga, lane); if (h1) t_load(tb_, vb, gb, lane); if (h2) t_load(tc, vc, gc, lane); if (h3) t_load(td, vd, gd, lane);
        t_store(ta, va, ga, scr, lane); if (h1) t_store(tb_, vb, gb, scr, lane); if (h2) t_store(tc, vc, gc, scr, lane); if (h3) t_store(td, vd, gd, scr, lane);
    }
    } else {
    for (int it = it0 + gw; it < it1; it += 2 * NGW) {
        const int lane = cur_lane(); const bool two = it + NGW < it1;
        TItem ta, tb_; CW_DECODE(it, ta); CW_DECODE(two ? it + NGW : it, tb_);
        f32x4 va[8], vb[8]; float ga[8], gb[8];
        t_load(ta, va, ga, lane); if (two) t_load(tb_, vb, gb, lane);
        t_store<WT>(ta, va, ga, scr, lane); if (two) t_store<WT>(tb_, vb, gb, scr, lane);
    }
    }
#undef CW_TRY
#undef CW_DECODE
}
__device__ __forceinline__ void p0_prologue(Frame& F) {
    const int gw = F.vcu * NWAVES + F.wave, NGW = F.G * NWAVES;
    convert_weights<CONV_P0>(F, gw, NGW, -1, F.G == 256 ? CONV_P2_ITEMS + CONV_P1X_ITEMS + CONV_P1Y_ITEMS : 0);
    if (F.G >= 256 && CONV_P1_BACK_ITEMS > 0) convert_weights<CONV_P1>(F, gw, NGW, CONV_P1_BACK_ITEMS, 0);
#ifndef REP_ROWS
#define REP_ROWS 1
#endif
    for (int rr_ = 0; rr_ < REP_ROWS; ++rr_)
    phase_rows_bf16(F, F.in[0], (bf16*)(F.ws + WS_HN), (float*)(F.ctl + CW_RSQ_X), NTOK);
    phase_rows_bf16(F, F.in[1], (bf16*)(F.ws + WS_MN), (float*)(F.ctl + CW_RSQ_M), MEMR);
}

__device__ __forceinline__ int t5_bucket(int rel) {
    const int n = rel < 0 ? -rel : rel; const int side = rel > 0 ? 16 : 0;
    const int large = 8 + (n >= 12) + (n >= 16) + (n >= 23) + (n >= 32) + (n >= 46) + (n >= 64) + (n >= 91);
    return side + (n < 8 ? n : large);
}

namespace att {
typedef short bf16x8 __attribute__((ext_vector_type(8)));
typedef short s16x4 __attribute__((ext_vector_type(4)));
typedef float f32x16 __attribute__((ext_vector_type(16)));
typedef unsigned u32x4 __attribute__((ext_vector_type(4)));
typedef int i32x4 __attribute__((ext_vector_type(4)));
enum { M_DIFF = 0, M_WIN = 1, M_MEM = 2 };
#define KSWZ(row, colB) ((row) * 256 + ((colB) ^ (((row) & 15) << 4)))
#define SBAR() __builtin_amdgcn_sched_barrier(0)
constexpr int SHM_V = 16384, SHM_K = 16384;
constexpr int L_V = 0, L_K = 32768, L_XCH = 65536;
constexpr int X_FLG = 5632, X_TBM = 6144, TBM_OFF = 512;
constexpr int X_WS = 0, X_POS = 2048, X_TB = 4096, X_TMM = 5120;
constexpr int NREL = 91;
__device__ __forceinline__ int crow(int r, int hi) { return (r & 3) + 8 * (r >> 2) + 4 * hi; }
__device__ __forceinline__ unsigned cvtpk(float lo, float hi) { unsigned r; asm volatile("v_cvt_pk_bf16_f32 %0, %1, %2" : "=v"(r) : "v"(lo), "v"(hi)); return r; }
template <int K> __device__ __forceinline__ int xor_i(int v) {
  if (K < 32) return __builtin_amdgcn_ds_swizzle(v, (K << 10) | 0x1f);
  else { auto r = __builtin_amdgcn_permlane32_swap((unsigned)v, (unsigned)v, false, false); return (int)r[0] == v ? (int)r[1] : (int)r[0]; }
}
template <int K> __device__ __forceinline__ float xor_f(float v) { return __int_as_float(xor_i<K>(__float_as_int(v))); }
__device__ __forceinline__ int v_st(int k, int c) { const int kk = k; return ((kk >> 3) * 4 + (c >> 5)) * 512 + ((kk & 7) * 32 + (c & 31)) * 2; }
__device__ __forceinline__ int v_rd_base(int lane) { return ((lane & 3) << 3) | (((lane >> 2) & 3) << 6) | (((lane >> 4) & 1) << 5) | (((lane >> 5) & 1) << 8); }
constexpr int v_rd_off(int d0, int ks, int half) { return d0 * 512 + ks * 4096 + half * 2048; }
template <int OFF> __device__ __forceinline__ s16x4 tr_read(int vb) { s16x4 r; asm volatile("ds_read_b64_tr_b16 %0, %1 offset:%2" : "=&v"(r) : "v"(vb), "i"(OFF) : "memory"); return r; }
template <int D0> __device__ __forceinline__ void pv_one(f32x16& od, int vb, bf16x8 pa0, bf16x8 pa1, bf16x8 pa2, bf16x8 pa3) {
  const s16x4 l0 = tr_read<v_rd_off(D0, 0, 0)>(vb), h0 = tr_read<v_rd_off(D0, 0, 1)>(vb), l1 = tr_read<v_rd_off(D0, 1, 0)>(vb), h1 = tr_read<v_rd_off(D0, 1, 1)>(vb);
  const s16x4 l2 = tr_read<v_rd_off(D0, 2, 0)>(vb), h2 = tr_read<v_rd_off(D0, 2, 1)>(vb), l3 = tr_read<v_rd_off(D0, 3, 0)>(vb), h3 = tr_read<v_rd_off(D0, 3, 1)>(vb);
  asm volatile("s_waitcnt lgkmcnt(0)" ::: "memory"); SBAR();
#define PK(L, H) (bf16x8){L[0], L[1], L[2], L[3], H[0], H[1], H[2], H[3]}
  od = __builtin_amdgcn_mfma_f32_32x32x16_bf16(pa0, PK(l0, h0), od, 0, 0, 0);
  od = __builtin_amdgcn_mfma_f32_32x32x16_bf16(pa1, PK(l1, h1), od, 0, 0, 0);
  od = __builtin_amdgcn_mfma_f32_32x32x16_bf16(pa2, PK(l2, h2), od, 0, 0, 0);
  od = __builtin_amdgcn_mfma_f32_32x32x16_bf16(pa3, PK(l3, h3), od, 0, 0, 0);
#undef PK
}
__device__ __forceinline__ void pv_d0(f32x16* o, int vb, bf16x8 pa0, bf16x8 pa1, bf16x8 pa2, bf16x8 pa3) {
  pv_one<0>(o[0], vb, pa0, pa1, pa2, pa3); pv_one<1>(o[1], vb, pa0, pa1, pa2, pa3); pv_one<2>(o[2], vb, pa0, pa1, pa2, pa3); pv_one<3>(o[3], vb, pa0, pa1, pa2, pa3);
}
template <int ND0> __device__ __forceinline__ void qkt(f32x16& p0, f32x16& p1, const char* Ks, const bf16x8* qr, int r32, int hi, int kcolB) {
  p0 = f32x16{}; p1 = f32x16{};
#pragma unroll
  for (int d0 = 0; d0 < ND0; ++d0) { const int cb = kcolB + (d0 * 16 + hi * 8) * 2;
    const bf16x8 b0 = *reinterpret_cast<const bf16x8*>(Ks + KSWZ(r32, cb));
    const bf16x8 b1 = *reinterpret_cast<const bf16x8*>(Ks + KSWZ(32 + r32, cb));
    p0 = __builtin_amdgcn_mfma_f32_32x32x16_bf16(b0, qr[d0], p0, 0, 0, 0);
    p1 = __builtin_amdgcn_mfma_f32_32x32x16_bf16(b1, qr[d0], p1, 0, 0, 0); }
}
__device__ __forceinline__ void add_bias(f32x16& p0, f32x16& p1, const int* kp, const float* tb, int qpos, int hi) {
#pragma unroll
  for (int g = 0; g < 4; ++g) { const i32x4 ka = *reinterpret_cast<const i32x4*>(kp + 8 * g + 4 * hi), kb = *reinterpret_cast<const i32x4*>(kp + 32 + 8 * g + 4 * hi);
#pragma unroll
    for (int i = 0; i < 4; ++i) { int ia = ka[i] - qpos + NREL, ib = kb[i] - qpos + NREL; ia = ia < 0 ? 0 : (ia > 2 * NREL ? 2 * NREL : ia); ib = ib < 0 ? 0 : (ib > 2 * NREL ? 2 * NREL : ib);
      p0[4 * g + i] += tb[ia]; p1[4 * g + i] += tb[ib]; } }
}
__device__ __forceinline__ void win_mask(f32x16& p0, f32x16& p1, int dq) {
#pragma unroll
  for (int r = 0; r < 16; ++r) { const int d = dq + (r & 3) + 8 * (r >> 2);
    if ((unsigned)(d + 128) > 256u) p0[r] = -INFINITY;
    if ((unsigned)(d + 160) > 256u) p1[r] = -INFINITY; }
}
__device__ __forceinline__ void add_bias_fast(f32x16& p0, f32x16& p1, const float* tp) {
#pragma unroll
  for (int r = 0; r < 16; ++r) { p0[r] += tp[(r & 3) + 8 * (r >> 2)]; p1[r] += tp[32 + (r & 3) + 8 * (r >> 2)]; }
}
__device__ __forceinline__ void exp_half(f32x16& p) {
#pragma unroll
  for (int r = 0; r < 16; ++r) p[r] = __builtin_amdgcn_exp2f(p[r]);
}
__device__ __forceinline__ void finishSM(f32x16& p0, f32x16& p1, float& l_reg, bf16x8& pa0, bf16x8& pa1, bf16x8& pa2, bf16x8& pa3) {
  exp_half(p1);
  float ps = 0.f;
#pragma unroll
  for (int r = 0; r < 16; ++r) ps += p0[r];
#pragma unroll
  for (int r = 0; r < 16; ++r) ps += p1[r];
  l_reg += ps;
#define PK4(P, BASE, OUT) do { unsigned a0 = cvtpk(P[BASE + 0], P[BASE + 1]), a1 = cvtpk(P[BASE + 2], P[BASE + 3]);   \
    unsigned b0 = cvtpk(P[BASE + 4], P[BASE + 5]), b1 = cvtpk(P[BASE + 6], P[BASE + 7]);                              \
    u32x4 w = {a0, a1, b0, b1}; OUT = *reinterpret_cast<bf16x8*>(&w); } while (0)
  PK4(p0, 0, pa0); PK4(p0, 8, pa1); PK4(p1, 0, pa2); PK4(p1, 8, pa3);
#undef PK4
}

struct UnitArgs {
  const bf16* Q; int ldq;
  const bf16* K; const bf16* V;
  bf16* O;
  const int* posb;
  const float* relb; int h;
  int q0;
  const bf16* nQ; const bf16* nK; const bf16* nV; int nq0;
  int ntov;
  float sinkl2;
  float lam; const float* subln;
};

template <int MODE>
__device__ __forceinline__ void attn_epilogue(f32x16 (&o)[4], float l_reg, const UnitArgs& A, char* ring, char* extra, const float (&gsub)[4]) {
  int tid = threadIdx.x; asm volatile("" : "+v"(tid));
  const int wid = __builtin_amdgcn_readfirstlane(tid >> 6), lane = tid & 63, r32 = lane & 31, hi = lane >> 5;
  const int wq = (MODE == M_DIFF) ? (wid & 3) : wid, half = (MODE == M_DIFF) ? (wid >> 2) : 0;
  float* wsf = (float*)(extra + X_WS) + wid * 64;
  { auto rr = __builtin_amdgcn_permlane32_swap(__float_as_uint(l_reg), __float_as_uint(l_reg), false, false); l_reg = __uint_as_float(rr[0]) + __uint_as_float(rr[1]); }
  if (MODE == M_WIN) l_reg += __builtin_amdgcn_exp2f(A.sinkl2);
  if (hi == 0) wsf[r32] = l_reg; asm volatile("s_waitcnt lgkmcnt(0)" ::: "memory");
  float rli[16];
#pragma unroll
  for (int r = 0; r < 16; ++r) rli[r] = __builtin_amdgcn_rcpf(wsf[crow(r, hi)]);
  if (MODE == M_DIFF) {
    float* xch = (float*)(ring + L_XCH);
    __syncthreads();
    if (half == 1) {
#pragma unroll
      for (int r = 0; r < 16; ++r)
#pragma unroll
        for (int d0 = 0; d0 < 4; ++d0) xch[(wq * 32 + crow(r, hi)) * 128 + d0 * 32 + r32] = o[d0][r] * rli[r] * A.lam;
    }
    __syncthreads();
    if (half == 0) {
      float ss[16], xv[4][16];
      __builtin_amdgcn_sched_barrier(0);
#pragma unroll
      for (int r = 0; r < 16; ++r)
#pragma unroll
        for (int d0 = 0; d0 < 4; ++d0) xv[d0][r] = xch[(wq * 32 + crow(r, hi)) * 128 + d0 * 32 + r32];
      __builtin_amdgcn_sched_barrier(0);
#pragma unroll
      for (int r = 0; r < 16; ++r) { ss[r] = 0.f;
#pragma unroll
        for (int d0 = 0; d0 < 4; ++d0) { const float v = o[d0][r] * rli[r] - xv[d0][r]; o[d0][r] = v; ss[r] += v * v; } }
#pragma unroll
#define SS_STEP(K) do { float t_[16]; __builtin_amdgcn_sched_barrier(0); _Pragma("unroll") for (int r = 0; r < 16; ++r) t_[r] = xor_f<K>(ss[r]); __builtin_amdgcn_sched_barrier(0); _Pragma("unroll") for (int r = 0; r < 16; ++r) ss[r] += t_[r]; __builtin_amdgcn_sched_barrier(0); } while (0)
      SS_STEP(1); SS_STEP(2); SS_STEP(4); SS_STEP(8); SS_STEP(16);
#undef SS_STEP
#pragma unroll
      for (int r = 0; r < 16; ++r) ss[r] = (1.f - LAM_INIT0) * __builtin_amdgcn_rsqf(ss[r] * (1.f / 128.f) + RMS_EPS);
      bf16* stg = (bf16*)(ring + wq * 8192);
#pragma unroll
      for (int d0 = 0; d0 < 4; ++d0) { const float g = gsub[d0];
#pragma unroll
        for (int r = 0; r < 16; r += 2) { const unsigned w_ = cvtpk(o[d0][r] * ss[r] * g, o[d0][r + 1] * ss[r + 1] * g);
          stg[crow(r, hi) * 128 + d0 * 32 + r32] = (bf16)(w_ & 0xffffu); stg[crow(r + 1, hi) * 128 + d0 * 32 + r32] = (bf16)(w_ >> 16); } }
      asm volatile("s_waitcnt lgkmcnt(0)" ::: "memory");
      u32x4 rb[8];
#pragma unroll
      for (int i = 0; i < 8; ++i) { const int row = i * 4 + (lane >> 4), ch = lane & 15; rb[i] = *(const u32x4*)(stg + row * 128 + ch * 8); }
      __builtin_amdgcn_sched_barrier(0);
#pragma unroll
      for (int i = 0; i < 8; ++i) { const int row = i * 4 + (lane >> 4), ch = lane & 15; *(u32x4*)(A.O + (size_t)(wq * 32 + row) * DM + ch * 8) = rb[i]; }
    }
  } else {
    __syncthreads();
    bf16* stg = (bf16*)(ring + wq * 8192);
#pragma unroll
    for (int d0 = 0; d0 < 4; ++d0)
#pragma unroll
      for (int r = 0; r < 16; r += 2) { const unsigned w_ = cvtpk(o[d0][r] * rli[r], o[d0][r + 1] * rli[r + 1]);
        stg[crow(r, hi) * 128 + d0 * 32 + r32] = (bf16)(w_ & 0xffffu); stg[crow(r + 1, hi) * 128 + d0 * 32 + r32] = (bf16)(w_ >> 16); }
    asm volatile("s_waitcnt lgkmcnt(0)" ::: "memory");
    u32x4 rb[8];
#pragma unroll
    for (int i = 0; i < 8; ++i) { const int row = i * 4 + (lane >> 4), ch = lane & 15; rb[i] = *(const u32x4*)(stg + row * 128 + ch * 8); }
    __builtin_amdgcn_sched_barrier(0);
#pragma unroll
    for (int i = 0; i < 8; ++i) { const int row = i * 4 + (lane >> 4), ch = lane & 15; *(u32x4*)(A.O + (size_t)(wq * 32 + row) * DM + ch * 8) = rb[i]; }
  }
}
constexpr int DSLOT = 32768, D_POS = 3 * DSLOT;
typedef short v4i16_t __attribute__((ext_vector_type(4)));
typedef __attribute__((address_space(3))) const char* lds_cptr;
__device__ __forceinline__ s16x4 vtr(lds_cptr p) { return __builtin_bit_cast(s16x4, __builtin_amdgcn_ds_read_tr16_b64_v4i16((__attribute__((address_space(3))) v4i16_t*)p)); }
#ifndef ATT_PRIO
#define ATT_PRIO 0
#endif
#ifndef ATT_VD
#define ATT_VD 4
#endif
constexpr int VD = ATT_VD;
template <int MODE>
__device__ __forceinline__ void attn_unit_pipe(char* ring, char* extra, const UnitArgs& A) {
  constexpr int ND0 = (MODE == M_DIFF) ? 4 : 8, LDK = (MODE == M_DIFF) ? INA : INB, NF = 2 * ND0;
  int NT = (MODE == M_DIFF) ? SEQ / 64 : 8;
#if defined(PROBE_EXTRA) || defined(PROBE_EXTRAW)
  if (A.ntov & 255) NT = A.ntov & 255;
#endif
  asm volatile("" : "+s"(NT));
  int tid = threadIdx.x; asm volatile("" : "+v"(tid));
  const int wid = __builtin_amdgcn_readfirstlane(tid >> 6), lane = tid & 63, r32 = lane & 31, hi = lane >> 5;
  const int wq = (MODE == M_DIFF) ? (wid & 3) : wid, half = (MODE == M_DIFF) ? (wid >> 2) : 0;
  const int kt0 = (MODE == M_WIN) ? A.q0 - 128 : 0;
#define KEYC(k) ((MODE == M_WIN) ? ((k) < 0 ? 0 : ((k) > SEQ - 1 ? SEQ - 1 : (k))) : (k))
  const int sr = tid >> 4, sc = (tid & 15) * 8, vst0 = v_st(sr, sc), vst1 = v_st(32 + sr, sc);
  struct { bf16x8 vs0, vs1, ks0, ks1; } sr_[1];
#define SLOADV(i, t) do { const int ka_ = KEYC(kt0 + (t) * 64 + sr), kb_ = KEYC(kt0 + (t) * 64 + 32 + sr); \
    sr_[i].vs0 = *reinterpret_cast<const bf16x8*>(A.V + (size_t)ka_ * LDK + sc); sr_[i].vs1 = *reinterpret_cast<const bf16x8*>(A.V + (size_t)kb_ * LDK + sc); } while (0)
#define SLOADK(i, t) do { const int ka_ = KEYC(kt0 + (t) * 64 + sr), kb_ = KEYC(kt0 + (t) * 64 + 32 + sr); \
    sr_[i].ks0 = *reinterpret_cast<const bf16x8*>(A.K + (size_t)ka_ * LDK + sc); sr_[i].ks1 = *reinterpret_cast<const bf16x8*>(A.K + (size_t)kb_ * LDK + sc); } while (0)
  SLOADV(0, 0); SLOADK(0, 0);
#ifndef WIN_WARM
#define WIN_WARM 0
#endif
  unsigned ww0_ = 0, ww1_ = 0, ww2_ = 0;
  if (MODE == M_WIN && WIN_WARM) { const int part_ = tid & 3; const bf16* b_ = (part_ < 2 ? A.K : A.V) + (part_ & 1) * 64;
    ww0_ = *reinterpret_cast<const unsigned*>(b_ + (size_t)KEYC(kt0 + 128 + (tid >> 2)) * LDK);
    ww1_ = *reinterpret_cast<const unsigned*>(b_ + (size_t)KEYC(kt0 + 256 + (tid >> 2)) * LDK);
    ww2_ = *reinterpret_cast<const unsigned*>(b_ + (size_t)KEYC(kt0 + 384 + (tid >> 2)) * LDK); }
  int* posl = (int*)(ring + D_POS); float* tb = (float*)(extra + X_TB); int* tmm = (int*)(extra + X_TMM); float* tbm = (float*)(extra + X_TBM); int* flg = (int*)(extra + X_FLG);
  const float tbraw_ = A.relb[t5_bucket((tid < 2 * NREL + 1 ? tid : 2 * NREL) - NREL) * NH + A.h];
  float tbmraw_[3] = {0.f, 0.f, 0.f};
  if constexpr (MODE == M_WIN) {
#pragma unroll
    for (int j = 0; j < 3; ++j) { const int i = tid + 512 * j, ic = i < 2 * TBM_OFF + 1 ? i : 2 * TBM_OFF; const int dd = ic - TBM_OFF, dc = dd < -NREL ? -NREL : (dd > NREL ? NREL : dd); tbmraw_[j] = A.relb[t5_bucket(dc) * NH + A.h]; } }
  i32x4 pa_ = {0, 0, 0, 0}, pb_ = {0, 0, 0, 0}; int pw0_ = 0, pw1_ = 0;
  if constexpr (MODE == M_DIFF) { pa_ = *reinterpret_cast<const i32x4*>(A.posb + tid * 8); pb_ = *reinterpret_cast<const i32x4*>(A.posb + tid * 8 + 4); }
  else { const int k_ = kt0 + tid; pw0_ = A.posb[KEYC(k_)]; pw1_ = A.posb[KEYC(k_ + 1)]; }
  bf16x8 qr[ND0];
  { const bf16* Qw = A.Q + (size_t)(wq * 32 + r32) * A.ldq + half * 64 + hi * 8;
#pragma unroll
    for (int d0 = 0; d0 < ND0; ++d0) qr[d0] = *reinterpret_cast<const bf16x8*>(Qw + d0 * 16); }
  const int qpos = A.posb[A.q0 + wq * 32 + r32];
  __builtin_amdgcn_sched_barrier(0);
  if (tid < 2 * NREL + 1) tb[tid] = tbraw_ * LOG2E;
  if constexpr (MODE == M_WIN) {
#pragma unroll
    for (int j = 0; j < 3; ++j) { const int i = tid + 512 * j; if (i < 2 * TBM_OFF + 1) { const int dd = i - TBM_OFF; float v = tbmraw_[j] * LOG2E; if (dd < -128 || dd > 128) v = -INFINITY; tbm[i] = v; } } }
  int qmin = 0, qmax = 0;
  if constexpr (MODE == M_DIFF) {
    *reinterpret_cast<i32x4*>(posl + tid * 8) = pa_; *reinterpret_cast<i32x4*>(posl + tid * 8 + 4) = pb_;
    int mn = min(min(min(pa_[0], pa_[1]), min(pa_[2], pa_[3])), min(min(pb_[0], pb_[1]), min(pb_[2], pb_[3]))), mx = max(max(max(pa_[0], pa_[1]), max(pa_[2], pa_[3])), max(max(pb_[0], pb_[1]), max(pb_[2], pb_[3])));
    int a = qpos, b = qpos;
#define MM4(K) do { __builtin_amdgcn_sched_barrier(0); const int t0_ = xor_i<K>(mn), t1_ = xor_i<K>(mx), t2_ = xor_i<K>(a), t3_ = xor_i<K>(b); __builtin_amdgcn_sched_barrier(0); mn = min(mn, t0_); mx = max(mx, t1_); a = min(a, t2_); b = max(b, t3_); } while (0)
#define MM2(K) do { __builtin_amdgcn_sched_barrier(0); const int t2_ = xor_i<K>(a), t3_ = xor_i<K>(b); __builtin_amdgcn_sched_barrier(0); a = min(a, t2_); b = max(b, t3_); } while (0)
    MM4(1); MM4(2); MM4(4); MM2(8); MM2(16);
#undef MM4
#undef MM2
    if ((tid & 7) == 0) { tmm[2 * (tid >> 3)] = mn; tmm[2 * (tid >> 3) + 1] = mx; }
    { auto ra = __builtin_amdgcn_permlane32_swap((unsigned)a, (unsigned)a, false, false); a = min((int)ra[0], (int)ra[1]); auto rb = __builtin_amdgcn_permlane32_swap((unsigned)b, (unsigned)b, false, false); b = max((int)rb[0], (int)rb[1]); }
    qmin = __builtin_amdgcn_readfirstlane(a); qmax = __builtin_amdgcn_readfirstlane(b);
  } else {
    const int k_ = kt0 + tid; posl[tid] = pw0_;
    const bool ok_ = (k_ < 0 || k_ + 1 >= SEQ || tid == 511) ? true : (pw1_ - pw0_ == 1);
    const bool w_ = __all(ok_); if (lane == 0) flg[wid] = w_ ? 1 : 0;
  }
  const int kcolB = half * 128;
  float l_reg = 0.f; f32x16 o[4];
#pragma unroll
  for (int d = 0; d < 4; ++d)
#pragma unroll
    for (int r = 0; r < 16; ++r) o[d][r] = 0.f;
  const lds_cptr ring3 = (lds_cptr)ring;
  const lds_cptr vp0 = ring3 + v_rd_base(lane);
  const lds_cptr kp0 = ring3 + SHM_V + r32 * 256;
  const int kx0 = (kcolB + hi * 16) ^ ((r32 & 15) << 4);
#define SWRITEV(so, i) do { char* v_ = ring + (so); *(bf16x8*)(v_ + vst0) = sr_[i].vs0; *(bf16x8*)(v_ + vst1) = sr_[i].vs1; } while (0)
#define SWRITEK(so, i) do { char* k_ = ring + (so) + SHM_V; const int kc_ = sc * 2; *(bf16x8*)(k_ + KSWZ(sr, kc_)) = sr_[i].ks0; *(bf16x8*)(k_ + KSWZ(32 + sr, kc_)) = sr_[i].ks1; } while (0)
#define TILE_SETUP(t, CI, NEAR) do { NEAR = true; CI = 0.f; if constexpr (MODE == M_DIFF) { const int kmn_ = __builtin_amdgcn_readfirstlane(tmm[2 * (t)]), kmx_ = __builtin_amdgcn_readfirstlane(tmm[2 * (t) + 1]); \
    if (kmn_ - qmax >= NREL) { CI = cfar_pos; NEAR = false; } else if (kmx_ - qmin <= -NREL) { CI = cfar_neg; NEAR = false; } } } while (0)
#define RESC(CI) do { if constexpr (MODE == M_DIFF) if ((CI) != ccur) { const float f_ = __builtin_amdgcn_exp2f(ccur - (CI)); ccur = (CI); l_reg *= f_; \
      _Pragma("unroll") for (int d_ = 0; d_ < 4; ++d_) _Pragma("unroll") for (int r_ = 0; r_ < 16; ++r_) o[d_][r_] *= f_; } } while (0)
#define BIAS(C0, C1, t, NEAR) do { const int k0_ = kt0 + (t) * 64; \
    if (contig && k0_ >= 0 && k0_ < SEQ) { add_bias_fast(C0, C1, tbq + (t) * 64); } \
    else { if (NEAR) add_bias(C0, C1, posl + (t) * 64, tb, qpos, hi); \
      if constexpr (MODE == M_WIN) { win_mask(C0, C1, (k0_ < 0 || k0_ >= SEQ) ? 100000 : k0_ - (A.q0 + wq * 32 + r32) + 4 * hi); } } } while (0)
#define ROT() do { const int t_ = s_prev; s_prev = s_cur; s_cur = s_next; s_next = t_; } while (0)
#define KFRAG(SO, i) (*reinterpret_cast<const __attribute__((address_space(3))) bf16x8*>(kp0 + (SO) + ((i) & 1) * 8192 + (kx0 ^ (((i) >> 1) * 32))))
#define MF(a, b, c) __builtin_amdgcn_mfma_f32_32x32x16_bf16(a, b, c, 0, 0, 0)
#define PK4A(P, B) const unsigned a0_ = cvtpk(P[B + 0], P[B + 1]), a1_ = cvtpk(P[B + 2], P[B + 3])
#define PK4B(P, B, OUT) do { const unsigned b0_ = cvtpk(P[B + 4], P[B + 5]), b1_ = cvtpk(P[B + 6], P[B + 7]); u32x4 w_ = {a0_, a1_, b0_, b1_}; OUT = *reinterpret_cast<bf16x8*>(&w_); } while (0)
#define KR(i) (*((i) % 4 == 0 ? &ka_ : (i) % 4 == 1 ? &kb_ : (i) % 4 == 2 ? &kc_ : &kd_))
#define XS_N(s, C0, C1, SO) do { if (2 * (s) + 3 < NF) KR(2 * (s) + 3) = KFRAG(SO, 2 * (s) + 3); C0 = MF(KR(2 * (s)), qr[s], (s) == 0 ? z_ : C0); SBAR(); \
    if (2 * (s) + 4 < NF) KR(2 * (s) + 4) = KFRAG(SO, 2 * (s) + 4); C1 = MF(KR(2 * (s) + 1), qr[s], (s) == 0 ? z_ : C1); SBAR(); } while (0)
#define XS_F(s, C0, C1, SO, P, B, OUT) do { if (2 * (s) + 3 < NF) KR(2 * (s) + 3) = KFRAG(SO, 2 * (s) + 3); C0 = MF(KR(2 * (s)), qr[s], (s) == 0 ? z_ : C0); PK4A(P, B); SBAR(); \
    if (2 * (s) + 4 < NF) KR(2 * (s) + 4) = KFRAG(SO, 2 * (s) + 4); C1 = MF(KR(2 * (s) + 1), qr[s], (s) == 0 ? z_ : C1); PK4B(P, B, OUT); SBAR(); } while (0)
#define XPART(C0, C1, P0, P1, SO, FIN) do { const f32x16 z_ = {}; bf16x8 ka_ = KFRAG(SO, 0), kb_ = KFRAG(SO, 1), kc_ = KFRAG(SO, 2), kd_; SBAR(); \
    if constexpr (MODE == M_DIFF) { \
      if (FIN) { XS_F(0, C0, C1, SO, P0, 0, pa0); XS_F(1, C0, C1, SO, P0, 8, pa1); XS_F(2, C0, C1, SO, P1, 0, pa2); XS_F(3, C0, C1, SO, P1, 8, pa3); } \
      else { XS_N(0, C0, C1, SO); XS_N(1, C0, C1, SO); XS_N(2, C0, C1, SO); XS_N(3, C0, C1, SO); } \
    } else { \
      if (FIN) { XS_F(0, C0, C1, SO, P0, 0, pa0); XS_N(1, C0, C1, SO); XS_F(2, C0, C1, SO, P0, 8, pa1); XS_N(3, C0, C1, SO); XS_F(4, C0, C1, SO, P1, 0, pa2); XS_N(5, C0, C1, SO); XS_F(6, C0, C1, SO, P1, 8, pa3); XS_N(7, C0, C1, SO); } \
      else { XS_N(0, C0, C1, SO); XS_N(1, C0, C1, SO); XS_N(2, C0, C1, SO); XS_N(3, C0, C1, SO); XS_N(4, C0, C1, SO); XS_N(5, C0, C1, SO); XS_N(6, C0, C1, SO); XS_N(7, C0, C1, SO); } \
    } } while (0)
#define VLO(VP, i) vtr((VP) + v_rd_off((i) >> 2, (i) & 3, 0))
#define VHI(VP, i) vtr((VP) + v_rd_off((i) >> 2, (i) & 3, 1))
#define VPK(L, H) (bf16x8){L[0], L[1], L[2], L[3], H[0], H[1], H[2], H[3]}
#define PAK(i) (((i) & 3) == 0 ? pa0 : ((i) & 3) == 1 ? pa1 : ((i) & 3) == 2 ? pa2 : pa3)
#define FADD(a, b) ({ float r_; asm("v_add_f32_e32 %0, %1, %2" : "=v"(r_) : "v"(a), "v"(b)); r_; })
#define YG(i, C0, C1, VP, DOEXP, EXTRA) do { if ((i) + VD - 1 < 16) { vl_[((i) + VD - 1) % VD] = VLO(VP, (i) + VD - 1); vh_[((i) + VD - 1) % VD] = VHI(VP, (i) + VD - 1); } \
    o[(i) >> 2] = MF(PAK(i), VPK(vl_[(i) % VD], vh_[(i) % VD]), o[(i) >> 2]); \
    if (DOEXP) { C0[i] = __builtin_amdgcn_exp2f(C0[i]); C1[i] = __builtin_amdgcn_exp2f(C1[i]); if ((i) > 0) { sA_ = FADD(sA_, C0[(i) - 1]); sB_ = FADD(sB_, C1[(i) - 1]); } } \
    EXTRA; SBAR(); } while (0)
#define NOP_ do { } while (0)
#define YPART(C0, C1, PSN, SOV, DOEXP, STG) do { const lds_cptr vp_ = vp0 + (SOV); float sA_ = 0.f, sB_ = 0.f; s16x4 vl_[VD], vh_[VD]; \
    _Pragma("unroll") for (int q_ = 0; q_ < VD - 1; ++q_) { vl_[q_] = vtr(vp_ + v_rd_off(q_ >> 2, q_ & 3, 0)); vh_[q_] = vtr(vp_ + v_rd_off(q_ >> 2, q_ & 3, 1)); } SBAR(); \
    YG(0, C0, C1, vp_, DOEXP, NOP_); YG(1, C0, C1, vp_, DOEXP, NOP_); YG(2, C0, C1, vp_, DOEXP, NOP_); YG(3, C0, C1, vp_, DOEXP, NOP_); \
    YG(4, C0, C1, vp_, DOEXP, NOP_); YG(5, C0, C1, vp_, DOEXP, NOP_); YG(6, C0, C1, vp_, DOEXP, NOP_); YG(7, C0, C1, vp_, DOEXP, NOP_); \
    YG(8, C0, C1, vp_, DOEXP, STG(0)); YG(9, C0, C1, vp_, DOEXP, STG(1)); YG(10, C0, C1, vp_, DOEXP, STG(2)); YG(11, C0, C1, vp_, DOEXP, STG(3)); \
    YG(12, C0, C1, vp_, DOEXP, STG(4)); YG(13, C0, C1, vp_, DOEXP, STG(5)); YG(14, C0, C1, vp_, DOEXP, STG(6)); YG(15, C0, C1, vp_, DOEXP, STG(7)); \
    if (DOEXP) { sA_ = FADD(sA_, C0[15]); sB_ = FADD(sB_, C1[15]); PSN = sA_ + sB_; } } while (0)
  f32x16 pA0, pA1, pB0, pB1; bf16x8 pa0, pa1, pa2, pa3; float ciA, ciB, psA = 0.f, psB = 0.f; bool nearA, nearB;
  int ta = 0; if constexpr (MODE == M_WIN) { ta = wq >> 1; asm volatile("" : "+s"(ta)); }
  const int tend = (MODE == M_WIN) ? ta + 6 : NT;
#define STAGE_STEP(t) do { SWRITEV(s_next, 0); SLOADV(0, ((t) + 2 < NT ? (t) + 2 : NT - 1)); SWRITEK(s_next, 0); SLOADK(0, ((t) + 2 < NT ? (t) + 2 : NT - 1)); __syncthreads(); ROT(); } while (0)
  int s_prev = 2 * DSLOT, s_cur = 0, s_next = DSLOT;
  SWRITEV(0, 0); SWRITEK(0, 0); SLOADV(0, 1); SLOADK(0, 1);
  __syncthreads();
  if (MODE == M_WIN && WIN_WARM) asm volatile("" :: "v"(ww0_), "v"(ww1_), "v"(ww2_));
  const float cfar_pos = (MODE == M_DIFF) ? tb[2 * NREL] : 0.f, cfar_neg = (MODE == M_DIFF) ? tb[0] : 0.f;
#ifndef PROBE_NOCONTIG
#define PROBE_NOCONTIG 0
#endif
  const bool contig = (MODE == M_WIN) && !PROBE_NOCONTIG && __builtin_amdgcn_readfirstlane(flg[0] & flg[1] & flg[2] & flg[3] & flg[4] & flg[5] & flg[6] & flg[7]) != 0;
  const float* tbq = tbm + (TBM_OFF + kt0 - (A.q0 + wq * 32 + r32) + 4 * hi);
  float ccur = 0.f;
  if constexpr (MODE == M_WIN) { _Pragma("nounroll") for (int t = 0; t < ta; ++t) STAGE_STEP(t); }
  TILE_SETUP(ta, ciA, nearA); XPART(pA0, pA1, pA0, pA1, s_cur, false);
  BIAS(pA0, pA1, ta, nearA);
  exp_half(pA0); exp_half(pA1);
  { float t_ = 0.f;
#pragma unroll
    for (int r = 0; r < 16; ++r) t_ += pA0[r] + pA1[r];
    psA = t_; }
  SWRITEV(s_next, 0); SWRITEK(s_next, 0); SLOADV(0, (ta + 2 < NT ? ta + 2 : NT - 1)); SLOADK(0, (ta + 2 < NT ? ta + 2 : NT - 1)); __syncthreads(); ROT();
#define STG_(SI, TW, TL, k) do { if ((k) == 0) SWRITEV(s_next, SI); if ((k) == 1) SLOADV(SI, TL); if ((k) == 2) SWRITEK(s_next, SI); if ((k) == 3) SLOADK(SI, TL); } while (0)
#define STG_A(k) STG_(0, j + 1, (j + 2 < NT ? j + 2 : NT - 1), k)
#define STG_B(k) STG_(0, j + 2, (j + 3 < NT ? j + 3 : NT - 1), k)
#define STG_N(k) NOP_
  if (ATT_PRIO && wid >= 4) __builtin_amdgcn_s_setprio(1);
  _Pragma("nounroll") for (int j = ta + 1; j + 1 < tend; j += 2) {
    TILE_SETUP(j, ciB, nearB); XPART(pB0, pB1, pA0, pA1, s_cur, true);
    RESC(ciA); l_reg += psA; BIAS(pB0, pB1, j, nearB);
    YPART(pB0, pB1, psB, s_prev, true, STG_A);
    __syncthreads(); ROT();
    TILE_SETUP(j + 1, ciA, nearA); XPART(pA0, pA1, pB0, pB1, s_cur, true);
    RESC(ciB); l_reg += psB; BIAS(pA0, pA1, j + 1, nearA);
    YPART(pA0, pA1, psA, s_prev, true, STG_B);
    __syncthreads(); ROT();
  }
  TILE_SETUP(tend - 1, ciB, nearB); XPART(pB0, pB1, pA0, pA1, s_cur, true);
  RESC(ciA); l_reg += psA; BIAS(pB0, pB1, tend - 1, nearB);
  YPART(pB0, pB1, psB, s_prev, true, STG_N);
  { PK4A(pB0, 0); PK4B(pB0, 0, pa0); } { PK4A(pB0, 8); PK4B(pB0, 8, pa1); } { PK4A(pB1, 0); PK4B(pB1, 0, pa2); } { PK4A(pB1, 8); PK4B(pB1, 8, pa3); }
  RESC(ciB); l_reg += psB;
  YPART(pA0, pA1, psA, s_cur, false, STG_N);
  if constexpr (MODE == M_WIN) { _Pragma("nounroll") for (int t = tend - 1; t < NT; ++t) STAGE_STEP(t); }
  if (ATT_PRIO && wid >= 4) __builtin_amdgcn_s_setprio(0);
  float gsub[4] = {1.f, 1.f, 1.f, 1.f};
  unsigned pf0_ = 0, pf1_ = 0;
  { int t2 = threadIdx.x; asm volatile("" : "+v"(t2));
    const int w2 = t2 >> 6, l2 = t2 & 63, r2 = l2 & 31, h2 = l2 >> 5, wq2 = (MODE == M_DIFF) ? (w2 & 3) : w2, half2 = (MODE == M_DIFF) ? (w2 >> 2) : 0;
    if constexpr (MODE == M_DIFF) {
#pragma unroll
      for (int d0 = 0; d0 < 4; ++d0) gsub[d0] = A.subln[d0 * 32 + r2]; }
    if (A.nQ != nullptr) {
      const int nk0_ = (MODE == M_WIN) ? A.nq0 - 128 : 0, kk_ = nk0_ + (t2 >> 2), part_ = t2 & 3;
      const int kc_ = (MODE == M_WIN) ? (kk_ < 0 ? 0 : (kk_ > SEQ - 1 ? SEQ - 1 : kk_)) : kk_;
      pf0_ = *reinterpret_cast<const unsigned*>((part_ < 2 ? A.nK : A.nV) + (size_t)kc_ * LDK + (part_ & 1) * 64);
      pf1_ = *reinterpret_cast<const unsigned*>(A.nQ + (size_t)(wq2 * 32 + r2) * A.ldq + half2 * 64 + h2 * 64);
    } }
#if defined(PROBE_EXTRA) || defined(PROBE_EXTRAW)
  if (!(A.ntov & 256))
#endif
  attn_epilogue<MODE>(o, l_reg, A, ring, extra, gsub);
  asm volatile("" :: "v"(pf0_), "v"(pf1_));
#if defined(PROBE_EXTRA) || defined(PROBE_EXTRAW)
  if (A.ntov & 256) { if (o[0][0] + o[1][3] + o[2][5] + o[3][7] + l_reg == 12345.678f) A.O[0] = (bf16)1; }
#endif
  asm volatile("s_waitcnt lgkmcnt(0)" ::: "memory");
  __syncthreads();
#undef KEYC
#undef BIAS
#undef KR
#undef XS_N
#undef XS_F
#undef SLOADV
#undef SLOADK
#undef SWRITEV
#undef SWRITEK
#undef TILE_SETUP
#undef STAGE_STEP
#undef RESC
#undef ROT
#undef KFRAG
#undef MF
#undef PK4A
#undef PK4B
#undef XPART
#undef VLO
#undef VHI
#undef VPK
#undef PAK
#undef YG
#undef FADD
#undef NOP_
#undef YPART
#undef STG_
#undef STG_A
#undef STG_B
#undef STG_N
}
template <int MODE>
__device__ __forceinline__ void attn_unit_simple(char* ring, char* extra, const UnitArgs& A) {
  constexpr int ND0 = 8, LDK = (MODE == M_WIN) ? INB : 512;
  int NT = (MODE == M_WIN) ? 8 : MEML / 64; asm volatile("" : "+s"(NT));
  int tid = threadIdx.x; asm volatile("" : "+v"(tid));
  const int wid = __builtin_amdgcn_readfirstlane(tid >> 6), lane = tid & 63, r32 = lane & 31, hi = lane >> 5;
  const int wq = wid;
  char* V_lds = ring + L_V; char* K_lds = ring + L_K;
  int* posl = (int*)(extra + X_POS); float* tb = (float*)(extra + X_TB);
  const int kt0 = (MODE == M_WIN) ? A.q0 - 128 : 0;
#define KEYC(k) ((MODE == M_WIN) ? ((k) < 0 ? 0 : ((k) > SEQ - 1 ? SEQ - 1 : (k))) : (k))
  if (MODE == M_WIN) { if (tid < 2 * NREL + 1) tb[tid] = A.relb[t5_bucket(tid - NREL) * NH + A.h] * LOG2E; posl[tid] = A.posb[KEYC(kt0 + tid)]; }
  bf16x8 qr[ND0];
  { const bf16* Qw = A.Q + (size_t)(wq * 32 + r32) * A.ldq + hi * 8;
#pragma unroll
    for (int d0 = 0; d0 < ND0; ++d0) qr[d0] = *reinterpret_cast<const bf16x8*>(Qw + d0 * 16); }
  int qpos = 0; if (MODE == M_WIN) qpos = A.posb[A.q0 + wq * 32 + r32];
  float l_reg = 0.f; f32x16 o[4];
#pragma unroll
  for (int d = 0; d < 4; ++d)
#pragma unroll
    for (int r = 0; r < 16; ++r) o[d][r] = 0.f;
  const int sr = tid >> 4, sc = (tid & 15) * 8, vst0 = v_st(sr, sc), vst1 = v_st(32 + sr, sc);
  const int vb0 = (int)(uintptr_t)V_lds + v_rd_base(lane);
  bf16x8 vs0, vs1, ks0, ks1;
#define SLOAD(t) do { const int k0_ = kt0 + (t) * 64; const int ka_ = KEYC(k0_ + sr), kb_ = KEYC(k0_ + 32 + sr); \
    vs0 = *reinterpret_cast<const bf16x8*>(A.V + (size_t)ka_ * LDK + sc); vs1 = *reinterpret_cast<const bf16x8*>(A.V + (size_t)kb_ * LDK + sc); \
    ks0 = *reinterpret_cast<const bf16x8*>(A.K + (size_t)ka_ * LDK + sc); ks1 = *reinterpret_cast<const bf16x8*>(A.K + (size_t)kb_ * LDK + sc); } while (0)
#define SWRITE(b) do { *(bf16x8*)(V_lds + (b) * SHM_V + vst0) = vs0; *(bf16x8*)(V_lds + (b) * SHM_V + vst1) = vs1; const int kc_ = sc * 2; \
    *(bf16x8*)(K_lds + (b) * SHM_K + KSWZ(sr, kc_)) = ks0; *(bf16x8*)(K_lds + (b) * SHM_K + KSWZ(32 + sr, kc_)) = ks1; } while (0)
  SLOAD(0); SWRITE(0); __syncthreads();
#pragma unroll
  for (int d0 = 0; d0 < ND0; ++d0) asm volatile("" :: "v"(qr[d0]));
  _Pragma("nounroll") for (int t = 0; t < NT; ++t) {
    const int b = t & 1;
    if (t + 1 < NT) SLOAD(t + 1);
    f32x16 p0, p1; bf16x8 pa0, pa1, pa2, pa3;
    qkt<ND0>(p0, p1, K_lds + b * SHM_K, qr, r32, hi, 0);
    if (MODE == M_WIN) { add_bias(p0, p1, posl + t * 64, tb, qpos, hi);
      const int k0_ = kt0 + t * 64; const int dq = (k0_ < 0 || k0_ >= SEQ) ? 100000 : k0_ - (A.q0 + wq * 32 + r32) + 4 * hi; win_mask(p0, p1, dq); }
    exp_half(p0); finishSM(p0, p1, l_reg, pa0, pa1, pa2, pa3); SBAR();
    pv_d0(o, vb0 + b * SHM_V, pa0, pa1, pa2, pa3);
    if (t + 1 < NT) SWRITE(b ^ 1);
    __syncthreads();
  }
  { const float g1_[4] = {1.f, 1.f, 1.f, 1.f}; attn_epilogue<MODE>(o, l_reg, A, ring, extra, g1_); }
  asm volatile("s_waitcnt lgkmcnt(0)" ::: "memory");
  __syncthreads();
#undef KEYC
#undef SLOAD
#undef SWRITE
}
#undef KSWZ
#undef SBAR
}
__device__ __forceinline__ int panel_of(int c) { return 4 * (c % 8) + (c / 8) % 4; }
__device__ __forceinline__ bool panel_same_xcd(gu32* ctl) {
    const int c = (int)blockIdx.x; bool same = true; const unsigned mine = xb_ld((unsigned*)(ctl + CW_XCC + c));
#pragma unroll
    for (int m = 0; m < 8; ++m) { const unsigned o = xb_ld((unsigned*)(ctl + CW_XCC + (c % 8) + 8 * ((c / 8) % 4 + 4 * m))); same = same && (o == mine) && (o != 0u); }
    return __builtin_amdgcn_readfirstlane(same ? 1 : 0) != 0;
}
__device__ __forceinline__ void panel_barrier(gu32* ctl, unsigned target, bool same_xcd) {
    asm volatile("s_waitcnt vmcnt(0)" ::: "memory");
    __syncthreads();
    if (threadIdx.x == 0) {
        unsigned* cnt = (unsigned*)(ctl + CW_PANEL + 64 * panel_of((int)blockIdx.x));
        if (same_xcd) {
            asm volatile("buffer_inv sc1" ::: "memory");
            (void)xb_add(cnt, 1u);
            unsigned sp = 0;
#ifndef PB_SLEEP
#define PB_SLEEP 1
#endif
            while (xb_ld(cnt) < target) { if (PB_SLEEP) __builtin_amdgcn_s_sleep(1); if (++sp > (1u << 22)) break; }
            asm volatile("s_waitcnt vmcnt(0)" ::: "memory");
        } else {
            __builtin_amdgcn_fence(__ATOMIC_RELEASE, "agent");
            asm volatile("s_waitcnt vmcnt(0)" ::: "memory");
            (void)xb_add(cnt, 1u);
            unsigned sp = 0;
            while (xb_ld(cnt) < target) { __builtin_amdgcn_s_sleep(1); if (++sp > (1u << 22)) break; }
            __builtin_amdgcn_fence(__ATOMIC_ACQUIRE, "agent");
            asm volatile("s_waitcnt vmcnt(0)" ::: "memory");
        }
    }
    __syncthreads();
}


__device__ __forceinline__ void mem_units(Frame& F, int layer, int ldq, int qm_col, int cu_off, int xl = 0) {
    char* ring = (char*)F.ldsg + RING_OFF; char* extra = (char*)F.ldsg + EXTRA_OFF;
    const bf16* proj = (const bf16*)(F.ws + WS_PROJ); bf16* heads = (bf16*)(F.ws + WS_HEADS);
#ifndef REP_MEM
#define REP_MEM 1
#endif
    const int pc_ = panel_of((int)blockIdx.x), mm_ = (int)blockIdx.x / 32;
    for (int uu = xl ? (mm_ >= 4 ? 0 : REP_MEM * NB * NMH * (SEQ / 256)) : (F.vcu + F.G - cu_off % F.G) % F.G; uu < REP_MEM * NB * NMH * (SEQ / 256); uu += xl ? REP_MEM * NB * NMH * (SEQ / 256) : F.G) { const int u = uu % (NB * NMH * (SEQ / 256));
        int qb = u % (SEQ / 256), bh = u / (SEQ / 256), b = bh / NMH, hm = bh % NMH; if (xl) { b = pc_ / (SEQ / 256); qb = pc_ % (SEQ / 256); hm = mm_ - 4; } const size_t tok0 = (size_t)b * SEQ + qb * 256;
        att::UnitArgs A{};
        A.Q = proj + tok0 * ldq + qm_col + hm * 128; A.ldq = ldq;
        A.K = (const bf16*)(F.ws + WS_KM) + (size_t)(layer * MEMR + b * MEML) * 512 + hm * 128; A.V = (const bf16*)(F.ws + WS_VM) + (size_t)(layer * MEMR + b * MEML) * 512 + hm * 128;
        A.O = heads + tok0 * DM + MIXW + hm * 128; A.posb = nullptr; A.relb = nullptr; A.h = 0; A.q0 = qb * 256; A.sinkl2 = 0.f; A.lam = 0.f; A.subln = nullptr;
        att::attn_unit_simple<att::M_MEM>(ring, extra, A);
    }
}
__device__ __forceinline__ void phase_attn_a(Frame& F) {
    char* ring = (char*)F.ldsg + RING_OFF; char* extra = (char*)F.ldsg + EXTRA_OFF;
    const bf16* proj = (const bf16*)(F.ws + WS_PROJ); bf16* heads = (bf16*)(F.ws + WS_HEADS);
    {
        float lam; { const float a = wave_sum(F.in[10][cur_lane()] * F.in[11][cur_lane()]), b = wave_sum(F.in[12][cur_lane()] * F.in[13][cur_lane()]); lam = expf(a) - expf(b) + LAM_INIT0; }
#ifndef REP_DIFF
#define REP_DIFF 1
#endif
        const int pc_ = panel_of((int)blockIdx.x), mm_ = (int)blockIdx.x / 32, nU_ = REP_DIFF * NB * NH * (SEQ / 128);
        for (int uu = F.xl ? 0 : F.vcu; uu < nU_; uu += F.xl ? nU_ / 3 : F.G) { const int u = uu % (NB * NH * (SEQ / 128));
            int qb = u % (SEQ / 128), bh = u / (SEQ / 128), b = bh / NH, h = bh % NH; if (F.xl) { b = pc_ / (SEQ / 256); qb = 2 * (pc_ % (SEQ / 256)) + (mm_ >> 2); h = (mm_ & 3) + 4 * (uu / (nU_ / 3)); }
            const size_t tok0 = (size_t)b * SEQ + qb * 128;
            att::UnitArgs A{};
            A.Q = proj + tok0 * INA + h * 128; A.ldq = INA;
            A.K = proj + (size_t)b * SEQ * INA + A_K + h * 128; A.V = proj + (size_t)b * SEQ * INA + A_V + h * 128;
            A.O = heads + tok0 * DM + h * 128; A.posb = (const int*)F.in[2] + b * SEQ; A.relb = F.in[3]; A.h = h; A.q0 = qb * 128;
            A.sinkl2 = 0.f; A.lam = lam; A.subln = F.in[14];
            { const int un_ = uu + (F.xl ? nU_ / 3 : F.G);
              if (un_ < nU_) { const int u2 = un_ % (NB * NH * (SEQ / 128)); int qb2 = u2 % (SEQ / 128), bh2 = u2 / (SEQ / 128), b2 = bh2 / NH, h2 = bh2 % NH;
                if (F.xl) { b2 = b; qb2 = qb; h2 = (mm_ & 3) + 4 * (un_ / (nU_ / 3)); }
                A.nQ = proj + ((size_t)b2 * SEQ + qb2 * 128) * INA + h2 * 128; A.nK = proj + (size_t)b2 * SEQ * INA + A_K + h2 * 128; A.nV = proj + (size_t)b2 * SEQ * INA + A_V + h2 * 128; A.nq0 = qb2 * 128; } }
            att::attn_unit_pipe<att::M_DIFF>(ring, extra, A);
        }
    }
#ifdef PROBE_EXTRA
    { const float lam = 0.5f; const int b = 0, h = (int)blockIdx.x % NH, qb = (int)blockIdx.x % (SEQ / 128); const size_t tok0 = (size_t)b * SEQ + qb * 128;
      att::UnitArgs A{};
      A.Q = proj + tok0 * INA + h * 128; A.ldq = INA; A.K = proj + (size_t)b * SEQ * INA + A_K + h * 128; A.V = proj + (size_t)b * SEQ * INA + A_V + h * 128;
      A.O = (bf16*)(F.ws + WS_U) + (size_t)blockIdx.x * 128 * DM; A.posb = (const int*)F.in[2] + b * SEQ; A.relb = F.in[3]; A.h = h; A.q0 = qb * 128;
      A.sinkl2 = 0.f; A.lam = lam; A.subln = F.in[14]; A.ntov = PROBE_EXTRA;
      att::attn_unit_pipe<att::M_DIFF>(ring, extra, A); }
#endif
    mem_units(F, 0, INA, A_QM, (NB * NH * (SEQ / 128)) % F.G, F.xl);
#ifndef P2_CONV_WT
#define P2_CONV_WT 1
#endif
    if (F.G == 256 && (F.xl ? (int)blockIdx.x < 128 : F.vcu >= 128)) {
        if (P2_CONV_WT && F.xl) {
            convert_weights<CONV_P0, 2, true>(F, (int)blockIdx.x * NWAVES + F.wave, 128 * NWAVES, CONV_P2_ITEMS, 0);
            asm volatile("s_waitcnt vmcnt(0)" ::: "memory"); __syncthreads();
            if (threadIdx.x == 0) (void)xb_add((unsigned*)(F.ctl + CW_CONVDONE), 1u);
        } else {
            convert_weights<CONV_P0>(F, (F.xl ? (int)blockIdx.x : F.vcu - 128) * NWAVES + F.wave, 128 * NWAVES, CONV_P2_ITEMS, 0);
            if (F.xl) { asm volatile("s_waitcnt vmcnt(0)" ::: "memory"); __syncthreads();
                if (threadIdx.x == 0) { __builtin_amdgcn_fence(__ATOMIC_RELEASE, "agent"); asm volatile("s_waitcnt vmcnt(0)" ::: "memory"); (void)xb_add((unsigned*)(F.ctl + CW_CONVDONE), 1u); } } } }
}
__device__ __forceinline__ void phase_attn_b(Frame& F) {
    char* ring = (char*)F.ldsg + RING_OFF; char* extra = (char*)F.ldsg + EXTRA_OFF;
    const bf16* proj = (const bf16*)(F.ws + WS_PROJ); bf16* heads = (bf16*)(F.ws + WS_HEADS);
    {
#ifndef REP_WIN
#define REP_WIN 1
#endif
        const int pc_ = panel_of((int)blockIdx.x), mm_ = (int)blockIdx.x / 32, nU_ = REP_WIN * NB * NH * (SEQ / 256);
        for (int uu = F.xl ? (mm_ < 4 ? 0 : nU_ / 2) : F.vcu; uu < nU_; uu += F.xl ? nU_ / 2 : F.G) { const int u = uu % (NB * NH * (SEQ / 256));
            int qb = u % (SEQ / 256), bh = u / (SEQ / 256), b = bh / NH, h = bh % NH; if (F.xl) { b = pc_ / (SEQ / 256); qb = pc_ % (SEQ / 256); h = mm_ + (uu == 0 ? 8 : 0); }
            const int kvh = h / 3; const size_t tok0 = (size_t)b * SEQ + qb * 256;
            att::UnitArgs A{};
            A.Q = proj + tok0 * INB + h * 128; A.ldq = INB;
            A.K = proj + (size_t)b * SEQ * INB + B_K + kvh * 128; A.V = proj + (size_t)b * SEQ * INB + B_V + kvh * 128;
            A.O = heads + tok0 * DM + h * 128; A.posb = (const int*)F.in[2] + b * SEQ; A.relb = F.in[3]; A.h = h; A.q0 = qb * 256;
            A.sinkl2 = F.in[18][h] * LOG2E; A.lam = 0.f; A.subln = nullptr;
            { const int un_ = uu + (F.xl ? nU_ / 2 : F.G);
              if (un_ < nU_) { const int u2 = un_ % (NB * NH * (SEQ / 256)); int qb2 = u2 % (SEQ / 256), bh2 = u2 / (SEQ / 256), b2 = bh2 / NH, h2 = bh2 % NH;
                if (F.xl) { b2 = b; qb2 = qb; h2 = mm_; }
                const int kv2 = h2 / 3;
                A.nQ = proj + ((size_t)b2 * SEQ + qb2 * 256) * INB + h2 * 128; A.nK = proj + (size_t)b2 * SEQ * INB + B_K + kv2 * 128; A.nV = proj + (size_t)b2 * SEQ * INB + B_V + kv2 * 128; A.nq0 = qb2 * 256; } }
            att::attn_unit_pipe<att::M_WIN>(ring, extra, A);
        }
    }
#ifdef PROBE_EXTRAW
    { const int b = 0, h = (int)blockIdx.x % NH, qb = (int)blockIdx.x % (SEQ / 256), kvh = h / 3; const size_t tok0 = (size_t)b * SEQ + qb * 256;
      att::UnitArgs A{};
      A.Q = proj + tok0 * INB + h * 128; A.ldq = INB; A.K = proj + (size_t)b * SEQ * INB + B_K + kvh * 128; A.V = proj + (size_t)b * SEQ * INB + B_V + kvh * 128;
      A.O = (bf16*)(F.ws + WS_U) + (size_t)(blockIdx.x % 128) * 256 * DM; A.posb = (const int*)F.in[2] + b * SEQ; A.relb = F.in[3]; A.h = h; A.q0 = qb * 256;
      A.sinkl2 = 0.f; A.lam = 0.f; A.subln = nullptr; A.ntov = PROBE_EXTRAW;
      att::attn_unit_pipe<att::M_WIN>(ring, extra, A); }
#endif
    mem_units(F, 1, INB, B_QM, (NB * NH * (SEQ / 256)) % F.G, F.xl);
    if (F.G == 256 && F.vcu >= 128) convert_weights<CONV_P6>(F, (F.vcu - 128) * NWAVES + F.wave, 128 * NWAVES, CONV_P7_ITEMS, 0);
}

struct Args { const float* in[25]; float* out; unsigned char* ws; int ph_lo, ph_hi, li, pad; };
__global__ void __launch_bounds__(NWAVES * 64, 2) mk_fwd(Args args) {
    extern __shared__ __attribute__((aligned(16))) unsigned char lds[];
#ifdef PADN
    asm volatile(".rept " "%0" "\n\ts_nop 0\n\t.endr" :: "n"(PADN));
#endif
    Frame F;
    F.lds = (LAS unsigned char*)lds; F.ldsg = lds;
    F.MISC = (volatile LAS unsigned*)(F.lds + MISC_OFF);
    F.wave = __builtin_amdgcn_readfirstlane((int)threadIdx.x >> 6);
    F.G = gridDim.x; { const int bx = blockIdx.x; F.vcu = (F.G % 8 == 0) ? (bx % 8) * (F.G / 8) + bx / 8 : bx; }
    F.ws = args.ws; F.out = args.out; F.ctl = (gu32*)(args.ws + WS_CTL);
#pragma unroll
    for (int i = 0; i < 25; ++i) F.in[i] = args.in[i];
    for (int u = (F.wave * 64 + cur_lane()); u < (LDS_BYTES - LDSCTL_OFF) / 4; u += NWAVES * 64) ((LAS unsigned*)(F.lds + LDSCTL_OFF))[u] = 0u;
    if (threadIdx.x == 0 && blockIdx.x < 256) __hip_atomic_store((unsigned*)(F.ctl + CW_XCC + blockIdx.x), 1u + xb_xcc_id(), __ATOMIC_RELAXED, __HIP_MEMORY_SCOPE_AGENT);
    __syncthreads();
    const bool single = (args.ph_hi - args.ph_lo) > 1;
    XcdBarrier bar; bar.bar = (unsigned*)(F.ctl + CW_BAR); bar.x = 0; bar.st = nullptr;
    if (single) bar = xcd_barrier_post((unsigned*)(F.ctl + CW_BAR), F.MISC + 8);
    const int lo = args.ph_lo, hi = args.ph_hi;
#define IN(k) (lo <= (k) && (k) < hi)
#ifndef REP_PHASE
#define REP_PHASE -1
#endif
#define REPS(k) for (int rep_ = 0; rep_ < ((REP_PHASE) == (k) ? 2 : 1); ++rep_)
#ifndef PROBE_PHASE
#define PROBE_PHASE -1
#endif
    unsigned long long tpa_ = 0, tpb_ = 0;
#ifndef PROBE_CLK
#define PROBE_CLK 0
#endif
    unsigned long long tca_ = 0, tcb_ = 0;
#define TP_A(k) do { if ((PROBE_PHASE) == (k)) { tpa_ = rt(); if (PROBE_CLK) tca_ = __builtin_amdgcn_s_memtime(); } } while (0)
#define TP_B(k) do { if ((PROBE_PHASE) == (k)) { tpb_ = rt(); if (PROBE_CLK) tcb_ = __builtin_amdgcn_s_memtime(); } } while (0)
#ifndef RES_ALIGN
#define RES_ALIGN false
#endif
#ifndef UP_ALIGN
#define UP_ALIGN true
#endif
#ifndef PROBE_2BAR
#define PROBE_2BAR 0
#endif
#define SEAM(k) do { if (IN(k) && IN((k) + 1)) { xcd_barrier(bar); if (PROBE_2BAR) xcd_barrier(bar); } } while (0)
#ifndef PANEL_SEAMS
#define PANEL_SEAMS 1
#endif
#define PSEAM(k, target) do { if (IN(k) && IN((k) + 1)) { if (XL) panel_barrier(F.ctl, target, same_xcd); else xcd_barrier(bar); } } while (0)
    bf16* const XB = (bf16*)(F.ws + WS_HN);
    bf16* const PROJ = (bf16*)(F.ws + WS_PROJ); bf16* const HEADS = (bf16*)(F.ws + WS_HEADS); bf16* const U = (bf16*)(F.ws + WS_U);
    bf16* const WA = (bf16*)(F.ws + WS_WA); bf16* const WB = (bf16*)(F.ws + WS_WB); bf16* const WM = (bf16*)(F.ws + WS_WMKV);
    bf16* const WO = (bf16*)(F.ws + WS_WOUT); bf16* const WU = (bf16*)(F.ws + WS_WUP); bf16* const WD = (bf16*)(F.ws + WS_WDN);

    float* const RSQ_X = (float*)(F.ctl + CW_RSQ_X); float* const RSQ_M = (float*)(F.ctl + CW_RSQ_M);
    float* const RSQ_MLP0 = (float*)(F.ctl + CW_RSQ_MLP0); float* const RSQ_ATT1 = (float*)(F.ctl + CW_RSQ_ATT1); float* const RSQ_MLP1 = (float*)(F.ctl + CW_RSQ_MLP1);
    LAS float* const XB_LDS = (LAS float*)(F.lds + EXTRA_OFF);
    LAS float* const XG = (LAS float*)(F.lds + EXTRA_OFF + 8192);
    constexpr float INVK = 1.f / DM;
    const int XL = (PANEL_SEAMS && F.G == 256 && single && lo == 0) ? 1 : 0; F.xl = XL;
    TP_A(0); if (IN(0)) REPS(0) { p0_prologue(F); } SEAM(0); TP_B(0);
#ifndef PROBE_FORCE_NOTSAME
#define PROBE_FORCE_NOTSAME 0
#endif
    const bool same_xcd = (XL && !PROBE_FORCE_NOTSAME) ? panel_same_xcd(F.ctl) : false;
    TP_A(1); if (IN(1)) REPS(1) {
        const int ncu = F.G >= 256 ? GEMM_CUS_P1 : F.G;
        if ((int)blockIdx.x >= ncu) { convert_weights<CONV_P1, CONV_DEPTH>(F, ((int)blockIdx.x - ncu) * NWAVES + F.wave, (F.G - ncu) * NWAVES, -1, CONV_P1_BACK_ITEMS);
                                      if (CONV_P1Y_ITEMS > 0) convert_weights<CONV_P0, CONV_DEPTH>(F, ((int)blockIdx.x - ncu) * NWAVES + F.wave, (F.G - ncu) * NWAVES, CONV_P2_ITEMS + CONV_P1X_ITEMS + CONV_P1Y_ITEMS, CONV_P2_ITEMS + CONV_P1X_ITEMS);
                                      } else {
        pg8::Gemm g{XB, WA, NTOK, INA, DM}; pg8::ComboOrder S; S.init(NTOK, INA, ncu, (int)blockIdx.x); S.A2 = (const bf16*)(F.ws + WS_MN); S.B2 = WM; S.nx = 16;
        if ((F.wave * 64 + cur_lane()) < 128) { const int t = (F.wave * 64 + cur_lane()); XG[t] = F.in[8][t & 63]; XG[128 + t] = F.in[9][t & 63]; XG[256 + t] = 1.f; XG[384 + t] = F.in[20][t]; XG[512 + t] = F.in[21][t]; XG[640 + t] = F.in[21][128 + t]; }
        __syncthreads();
        pg8::EpiProj<0> E{PROJ, INA, RSQ_X, INVK, (bf16*)(F.ws + WS_KM), (bf16*)(F.ws + WS_VM), RSQ_M, XB_LDS, XG, QS64, QS128};
        pg8::gemm_phase<pg8::EpiProj<0>, pg8::ComboOrder, true, true>(F.lds + RING_OFF, g, S, E);
        { const int nu = (NTOK / 256) * (INA / 256) + 16, nfull = nu % ncu;
          if (F.G >= 256 && CONV_P1X_ITEMS > 0 && nfull > 0 && (int)blockIdx.x >= nfull) { asm volatile("s_waitcnt vmcnt(0)" ::: "memory"); __syncthreads();
              convert_weights<CONV_P0>(F, ((int)blockIdx.x - nfull) * NWAVES + F.wave, (ncu - nfull) * NWAVES, CONV_P2_ITEMS + CONV_P1X_ITEMS, CONV_P2_ITEMS); } } }
        if (F.G < 256) convert_weights<CONV_P1>(F, F.vcu * NWAVES + F.wave, F.G * NWAVES);
    } SEAM(1); TP_B(1);
    TP_A(2); if (IN(2)) REPS(2) { phase_attn_a(F); } PSEAM(2, 8u); TP_B(2);
    TP_A(3); if (IN(3)) REPS(3) {
        pg8::Gemm g{HEADS, WO, NTOK, DM, DM}; pg8::StaticOrder S; S.init(NTOK, DM, F.G, (int)blockIdx.x, XL);
        pg8::EpiRes<false, false> E{XB, XB, DM, RSQ_MLP0};
        pg8::gemm_phase<pg8::EpiRes<false, false>, pg8::StaticOrder, RES_ALIGN, true>(F.lds + RING_OFF, g, S, E);
    } PSEAM(3, 16u); TP_B(3);
    TP_A(4); if (IN(4)) REPS(4) {
        pg8::Gemm g{XB, WU, NTOK, DFF, DM}; pg8::StaticOrder S; S.init(NTOK, DFF, F.G, (int)blockIdx.x, XL);
        pg8::EpiUp E{U, DFF, RSQ_MLP0, INVK};
        pg8::gemm_phase<pg8::EpiUp, pg8::StaticOrder, UP_ALIGN, true>(F.lds + RING_OFF, g, S, E);
    }
    if (XL && IN(4) && IN(5) && threadIdx.x == 0) {
        unsigned sp = 0; while (xb_ld((unsigned*)(F.ctl + CW_CONVDONE)) < 128u) { __builtin_amdgcn_s_sleep(1); if (++sp > (1u << 22)) break; } }
    PSEAM(4, 24u); TP_B(4);
    TP_A(5); if (IN(5)) REPS(5) {
        pg8::Gemm g{U, WD, NTOK, DM, DFF}; pg8::StaticOrder S; S.init(NTOK, DM, F.G, (int)blockIdx.x, XL);
        pg8::EpiRes<false, false> E{XB, XB, DM, RSQ_ATT1};
        pg8::gemm_phase<pg8::EpiRes<false, false>, pg8::StaticOrder, RES_ALIGN, true>(F.lds + RING_OFF, g, S, E);
    } PSEAM(5, 32u); TP_B(5);
    TP_A(6); if (IN(6)) REPS(6) {
        const int ncu = F.G >= 256 ? GEMM_CUS_P6 : F.G;
        if ((int)blockIdx.x >= ncu) { convert_weights<CONV_P6, CONV_DEPTH>(F, ((int)blockIdx.x - ncu) * NWAVES + F.wave, (F.G - ncu) * NWAVES, -1, F.G == 256 ? CONV_P7_ITEMS : 0); } else {
        pg8::Gemm g{XB, WB, NTOK, INB, DM}; pg8::ComboOrder S; S.init(NTOK, INB, ncu, (int)blockIdx.x, XL); S.A2 = (const bf16*)(F.ws + WS_MN); S.B2 = WM; S.nx = 0;
        if ((F.wave * 64 + cur_lane()) < 128) { const int t = (F.wave * 64 + cur_lane()); XG[t] = F.in[16][t]; XG[128 + t] = F.in[17][t]; XG[256 + t] = 1.f; XG[384 + t] = F.in[20][128 + t]; XG[512 + t] = F.in[21][t]; XG[640 + t] = F.in[21][128 + t]; }
        __syncthreads();
        pg8::EpiProj<1> E{PROJ, INB, RSQ_ATT1, INVK, (bf16*)(F.ws + WS_KM), (bf16*)(F.ws + WS_VM), RSQ_M, XB_LDS, XG, QS64, QS128};
        pg8::gemm_phase<pg8::EpiProj<1>, pg8::ComboOrder, true, true>(F.lds + RING_OFF, g, S, E); }
        if (F.G < 256) convert_weights<CONV_P6>(F, F.vcu * NWAVES + F.wave, F.G * NWAVES);
    } SEAM(6); TP_B(6);
    TP_A(7); if (IN(7)) REPS(7) { phase_attn_b(F); } PSEAM(7, 40u); TP_B(7);
    TP_A(8); if (IN(8)) REPS(8) {
        pg8::Gemm g{HEADS, WO + (size_t)DM * DM, NTOK, DM, DM}; pg8::StaticOrder S; S.init(NTOK, DM, F.G, (int)blockIdx.x, XL);
        pg8::EpiRes<false, false> E{XB, XB, DM, RSQ_MLP1};
        pg8::gemm_phase<pg8::EpiRes<false, false>, pg8::StaticOrder, RES_ALIGN, true>(F.lds + RING_OFF, g, S, E);
    } PSEAM(8, 48u); TP_B(8);
    TP_A(9); if (IN(9)) REPS(9) {
        pg8::Gemm g{XB, WU + (size_t)DFF * DM, NTOK, DFF, DM}; pg8::StaticOrder S; S.init(NTOK, DFF, F.G, (int)blockIdx.x, XL);
        pg8::EpiUp E{U, DFF, RSQ_MLP1, INVK};
        pg8::gemm_phase<pg8::EpiUp, pg8::StaticOrder, UP_ALIGN, true>(F.lds + RING_OFF, g, S, E);
    } PSEAM(9, 56u); TP_B(9);
    TP_A(10); if (IN(10)) REPS(10) {
        pg8::Gemm g{U, WD + (size_t)DM * DFF, NTOK, DM, DFF}; pg8::StaticOrder S; S.init(NTOK, DM, F.G, (int)blockIdx.x, XL);
        pg8::EpiRes<false, true> E{XB, F.out, DM, nullptr};
        pg8::gemm_phase<pg8::EpiRes<false, true>, pg8::StaticOrder, RES_ALIGN, true>(F.lds + RING_OFF, g, S, E);
    }
    if ((PROBE_PHASE) >= 0) { if ((PROBE_PHASE) == N_PHASES - 1) tpb_ = rt(); if (blockIdx.x == 0) { const unsigned long long t0_ = rt(), d_ = PROBE_CLK ? (tcb_ - tca_) * 1000ull / (tpb_ - tpa_) : 8ull * (tpb_ - tpa_); while (rt() - t0_ < d_) __builtin_amdgcn_s_sleep(8); } }
#ifdef PROBE_EPI
    if (blockIdx.x == 0) { const unsigned long long t0_ = rt(), d_ = 8ull * F.MISC[16]; while (rt() - t0_ < d_) __builtin_amdgcn_s_sleep(8); }
#endif
#undef IN
#undef SEAM
}

#ifndef MK_ONE_LAUNCH
#define MK_ONE_LAUNCH 1
#endif
extern "C" void kernel_launch(void* const* d_in, const int* in_sizes, int n_in, void* d_out, int out_size, void* d_ws, size_t ws_size, hipStream_t stream) {
    static int grid = 0;
    if (grid == 0) {
        if (n_in != 25 || in_sizes[0] != NTOK * DM || out_size != NTOK * DM || ws_size < WS_END) { fprintf(stderr, "kernel_launch: unexpected shapes: n_in %d in0 %d out %d ws %zu (need %zu)\n", n_in, n_in > 0 ? in_sizes[0] : -1, out_size, ws_size, (size_t)WS_END); grid = -1; return; }
        int dev = 0, cus = 0;
        if (hipGetDevice(&dev) != hipSuccess || hipDeviceGetAttribute(&cus, hipDeviceAttributeMultiprocessorCount, dev) != hipSuccess) { fprintf(stderr, "kernel_launch: device query failed\n"); grid = -1; return; }
        if (hipFuncSetAttribute((const void*)mk_fwd, hipFuncAttributeMaxDynamicSharedMemorySize, LDS_BYTES) != hipSuccess) { fprintf(stderr, "kernel_launch: hipFuncSetAttribute failed\n"); grid = -1; return; }
        int per_cu = 0;
        if (hipOccupancyMaxActiveBlocksPerMultiprocessor(&per_cu, (const void*)mk_fwd, NWAVES * 64, LDS_BYTES) != hipSuccess || per_cu < 1) fprintf(stderr, "kernel_launch: note: occupancy query reports %d workgroups per CU\n", per_cu);
        (void)hipGetLastError();
        grid = cus;
    }
    if (grid < 0) return;
    if (hipMemsetAsync((char*)d_ws + WS_CTL, 0, CTL_ZERO_BYTES, stream) != hipSuccess) { fprintf(stderr, "kernel_launch: hipMemsetAsync failed\n"); return; }
    Args a{};
    for (int i = 0; i < 25; ++i) a.in[i] = (const float*)d_in[i];
    a.out = (float*)d_out; a.ws = (unsigned char*)d_ws;
#if MK_ONE_LAUNCH
    a.ph_lo = 0; a.ph_hi = N_PHASES; a.li = 0;
    hipLaunchKernelGGL(mk_fwd, dim3(grid), dim3(NWAVES * 64), LDS_BYTES, stream, a);
#else
    for (int p = 0; p < N_PHASES; ++p) { a.ph_lo = p; a.ph_hi = p + 1; a.li = p; hipLaunchKernelGGL(mk_fwd, dim3(grid), dim3(NWAVES * 64), LDS_BYTES, stream, a); }
#endif
    const hipError_t le = hipPeekAtLastError();
    if (le != hipSuccess) fprintf(stderr, "kernel_launch: launch failed: %s\n", hipGetErrorName(le));
}
```
